# Optimizing an MI355X kernel written in HIP

```python
import math
import jax, jax.numpy as jnp
from jax import lax
import numpy as np

D_MODEL = 1024
BATCH = 4
SEQ = 4096
DEPTH = 4

CHUNK = 64
Q_BLOCK = 128
N_A_LAYERS = DEPTH // 2
N_B_LAYERS = DEPTH - N_A_LAYERS
D_FF = 2816
D_RNN = D_MODEL
N_LRU_BLOCKS = 8
LRU_BLOCK = D_RNN // N_LRU_BLOCKS
CONV_WIDTH = 4
LRU_C = 8.0
N_HEADS = 8
HEAD_DIM = D_MODEL // (2 * N_HEADS)
ROPE_THETA = 10000.0
EPS = 1e-6
SUBLN_EPS = 1e-5

kernel_name = "hybrid_rglru_diffattn_yoco_macaron"


def rmsnorm(x, g, eps=EPS):
    xf = x.astype(jnp.float32)
    y = xf * lax.rsqrt(jnp.mean(xf * xf, axis=-1, keepdims=True) + eps)
    return (y * g.astype(jnp.float32)).astype(x.dtype)


def swiglu(h, w_gate, w_up, w_down):
    return (jax.nn.silu(h @ w_gate) * (h @ w_up)) @ w_down


def causal_depthwise_conv(x, w, b):
    S = x.shape[1]
    xp = jnp.pad(x, ((0, 0), (CONV_WIDTH - 1, 0), (0, 0)))
    out = b
    for k in range(CONV_WIDTH):
        out = out + xp[:, k:k + S, :] * w[k]
    return out


def _lru_combine(c1, c2):
    a1, b1 = c1
    a2, b2 = c2
    return a1 * a2, a2 * b1 + b2


def rg_lru(x, w_a, b_a, w_x, b_x, lam):
    B, S, _ = x.shape
    xb = x.reshape(B, S, N_LRU_BLOCKS, LRU_BLOCK)
    gate_a = jnp.einsum('bsnh,nhk->bsnk', xb, w_a).reshape(B, S, D_RNN) + b_a
    gate_x = jnp.einsum('bsnh,nhk->bsnk', xb, w_x).reshape(B, S, D_RNN) + b_x
    r = jax.nn.sigmoid(gate_a.astype(jnp.float32))
    i = jax.nn.sigmoid(gate_x.astype(jnp.float32))
    log_a = -LRU_C * r * jax.nn.softplus(-lam.astype(jnp.float32))
    a = jnp.exp(log_a)
    mult = jnp.sqrt(-jnp.expm1(2.0 * log_a))
    bx = mult * (i * x.astype(jnp.float32))
    _, h = lax.associative_scan(_lru_combine, (a, bx), axis=1)
    return h.astype(x.dtype)


def recurrent_block(h, w_in, conv_w, conv_b, w_a, b_a, w_x, b_x, lam, w_out):
    proj = h @ w_in
    gate, rec = proj[..., :D_RNN], proj[..., D_RNN:]
    rec = causal_depthwise_conv(rec, conv_w, conv_b)
    rec = rg_lru(rec, w_a, b_a, w_x, b_x, lam)
    return (jax.nn.gelu(gate) * rec) @ w_out


def rope_tables(S):
    pos = jnp.arange(S, dtype=jnp.float32)
    inv_freq = ROPE_THETA ** (-jnp.arange(0, HEAD_DIM, 2, dtype=jnp.float32) / HEAD_DIM)
    ang = pos[:, None] * inv_freq[None, :]
    ang = jnp.concatenate([ang, ang], axis=-1)
    return jnp.cos(ang), jnp.sin(ang)


def apply_rope(t, cos, sin):
    tf = t.astype(jnp.float32)
    half = HEAD_DIM // 2
    rot = jnp.concatenate([-tf[..., half:], tf[..., :half]], axis=-1)
    c = cos[None, :, None, None, :]
    s = sin[None, :, None, None, :]
    return (tf * c + rot * s).astype(t.dtype)


def shared_kv(x, kv_norm, w_k, w_v, k_norm, cos, sin):
    B, S, _ = x.shape
    h = rmsnorm(x, kv_norm)
    k = (h @ w_k).reshape(B, S, N_HEADS, 2, HEAD_DIM)
    k = apply_rope(rmsnorm(k, k_norm), cos, sin)
    k = k.transpose(0, 2, 3, 1, 4)
    v = (h @ w_v).reshape(B, S, N_HEADS, 2 * HEAD_DIM).transpose(0, 2, 1, 3)
    return k, v


def diff_attention(h, k, v, w_q, q_norm, lq1, lq2, lk1, lk2, sub_norm, w_o, cos, sin, lambda_init):
    B, S, _ = h.shape
    nb = S // Q_BLOCK
    q = (h @ w_q).reshape(B, S, N_HEADS, 2, HEAD_DIM)
    q = apply_rope(rmsnorm(q, q_norm), cos, sin) * (HEAD_DIM ** -0.5)
    q_blocks = q.reshape(B, nb, Q_BLOCK, N_HEADS, 2, HEAD_DIM).transpose(1, 0, 3, 4, 2, 5)
    lam = (jnp.exp(jnp.sum((lq1 * lk1).astype(jnp.float32)))
           - jnp.exp(jnp.sum((lq2 * lk2).astype(jnp.float32))) + lambda_init)
    key_chunk = jnp.arange(S) // CHUNK
    vf = v.astype(jnp.float32)

    def one_block(args):
        qb, bi = args
        scores = jnp.einsum('bhcqd,bhckd->bhcqk', qb, k, preferred_element_type=jnp.float32)
        q_chunk = (bi * Q_BLOCK + jnp.arange(Q_BLOCK)) // CHUNK
        mask = key_chunk[None, :] <= q_chunk[:, None]
        p = jax.nn.softmax(jnp.where(mask, scores, -jnp.inf), axis=-1)
        attn = p[:, :, 0] - lam * p[:, :, 1]
        return jnp.einsum('bhqk,bhkd->bhqd', attn, vf)

    o = lax.map(one_block, (q_blocks, jnp.arange(nb)))
    o = o.transpose(1, 0, 3, 2, 4).reshape(B, S, N_HEADS, 2 * HEAD_DIM)
    o = rmsnorm(o, sub_norm, SUBLN_EPS) * (1.0 - lambda_init)
    return o.reshape(B, S, D_MODEL).astype(h.dtype) @ w_o


def setup_inputs(seed: int = 0) -> dict:
    key = jax.random.key(seed)
    ks = iter(jax.random.split(key, 64))
    f32 = jnp.float32

    def dense(shape, fan_in):
        return jax.random.normal(next(ks), shape, f32) * (fan_in ** -0.5)

    def gain(shape):
        return 1.0 + 0.02 * jax.random.normal(next(ks), shape, f32)

    def bias(shape):
        return 0.01 * jax.random.normal(next(ks), shape, f32)

    nA, nB = N_A_LAYERS, N_B_LAYERS
    u = jax.random.uniform(next(ks), (nA, D_RNN), f32, 0.9, 0.999)
    a0 = u ** (1.0 / LRU_C)
    rec_lambda = jnp.log(a0) - jnp.log1p(-a0)
    return {
        'x': jax.random.normal(next(ks), (BATCH, SEQ, D_MODEL), f32),
        'ffn1_norm': gain((DEPTH, D_MODEL)),
        'ffn1_w_gate': dense((DEPTH, D_MODEL, D_FF), D_MODEL),
        'ffn1_w_up': dense((DEPTH, D_MODEL, D_FF), D_MODEL),
        'ffn1_w_down': dense((DEPTH, D_FF, D_MODEL), D_FF),
        'ffn2_norm': gain((DEPTH, D_MODEL)),
        'ffn2_w_gate': dense((DEPTH, D_MODEL, D_FF), D_MODEL),
        'ffn2_w_up': dense((DEPTH, D_MODEL, D_FF), D_MODEL),
        'ffn2_w_down': dense((DEPTH, D_FF, D_MODEL), D_FF),
        'mix_norm': gain((DEPTH, D_MODEL)),
        'rec_w_in': dense((nA, D_MODEL, 2 * D_RNN), D_MODEL),
        'rec_conv_w': dense((nA, CONV_WIDTH, D_RNN), CONV_WIDTH),
        'rec_conv_b': bias((nA, D_RNN)),
        'rec_w_a': dense((nA, N_LRU_BLOCKS, LRU_BLOCK, LRU_BLOCK), LRU_BLOCK),
        'rec_b_a': bias((nA, D_RNN)),
        'rec_w_x': dense((nA, N_LRU_BLOCKS, LRU_BLOCK, LRU_BLOCK), LRU_BLOCK),
        'rec_b_x': bias((nA, D_RNN)),
        'rec_lambda': rec_lambda,
        'rec_w_out': dense((nA, D_RNN, D_MODEL), D_RNN),
        'kv_norm': gain((D_MODEL,)),
        'w_k': dense((D_MODEL, 2 * N_HEADS * HEAD_DIM), D_MODEL),
        'w_v': dense((D_MODEL, 2 * N_HEADS * HEAD_DIM), D_MODEL),
        'k_norm': gain((HEAD_DIM,)),
        'lambda_k1': 0.1 * jax.random.normal(next(ks), (HEAD_DIM,), f32),
        'lambda_k2': 0.1 * jax.random.normal(next(ks), (HEAD_DIM,), f32),
        'attn_w_q': dense((nB, D_MODEL, 2 * N_HEADS * HEAD_DIM), D_MODEL),
        'q_norm': gain((nB, HEAD_DIM)),
        'lambda_q1': 0.1 * jax.random.normal(next(ks), (nB, HEAD_DIM), f32),
        'lambda_q2': 0.1 * jax.random.normal(next(ks), (nB, HEAD_DIM), f32),
        'sub_norm': gain((nB, 2 * HEAD_DIM)),
        'attn_w_o': dense((nB, 2 * N_HEADS * HEAD_DIM, D_MODEL), 2 * N_HEADS * HEAD_DIM),
    }


def reference(x, ffn1_norm, ffn1_w_gate, ffn1_w_up, ffn1_w_down,
              ffn2_norm, ffn2_w_gate, ffn2_w_up, ffn2_w_down, mix_norm,
              rec_w_in, rec_conv_w, rec_conv_b, rec_w_a, rec_b_a, rec_w_x, rec_b_x,
              rec_lambda, rec_w_out, kv_norm, w_k, w_v, k_norm, lambda_k1, lambda_k2,
              attn_w_q, q_norm, lambda_q1, lambda_q2, sub_norm, attn_w_o):
    S = x.shape[1]
    cos, sin = rope_tables(S)
    k_shared, v_shared = None, None
    for layer in range(DEPTH):
        if layer == N_A_LAYERS:
            k_shared, v_shared = shared_kv(x, kv_norm, w_k, w_v, k_norm, cos, sin)
        x = x + 0.5 * swiglu(rmsnorm(x, ffn1_norm[layer]), ffn1_w_gate[layer],
                             ffn1_w_up[layer], ffn1_w_down[layer])
        h = rmsnorm(x, mix_norm[layer])
        if layer < N_A_LAYERS:
            a = layer
            x = x + recurrent_block(h, rec_w_in[a], rec_conv_w[a], rec_conv_b[a], rec_w_a[a],
                                    rec_b_a[a], rec_w_x[a], rec_b_x[a], rec_lambda[a], rec_w_out[a])
        else:
            j = layer - N_A_LAYERS
            lambda_init = 0.8 - 0.6 * math.exp(-0.3 * layer)
            x = x + diff_attention(h, k_shared, v_shared, attn_w_q[j], q_norm[j], lambda_q1[j],
                                   lambda_q2[j], lambda_k1, lambda_k2, sub_norm[j], attn_w_o[j],
                                   cos, sin, lambda_init)
        x = x + 0.5 * swiglu(rmsnorm(x, ffn2_norm[layer]), ffn2_w_gate[layer],
                             ffn2_w_up[layer], ffn2_w_down[layer])
    return x
```

```cpp
#include <hip/hip_runtime.h>
#include <hip/hip_cooperative_groups.h>
#include <cstdio>
#include <cstdint>
#include <cmath>
namespace cg = cooperative_groups;
__device__ __forceinline__ float shx(float v, int k, int lane) { return __int_as_float(__builtin_amdgcn_ds_bpermute((lane ^ k) << 2, __float_as_int(v))); }
__device__ __forceinline__ float shl_from(float v, int src) { return __int_as_float(__builtin_amdgcn_ds_bpermute(src << 2, __float_as_int(v))); }
__device__ __forceinline__ unsigned lo4_enc(float x, float hif, unsigned e) { const float inv = (e >= 12u) ? __uint_as_float((265u - e) << 23) : 0.f; float q = rintf((x - hif) * inv) + 8.f; q = fminf(fmaxf(q, 0.f), 15.f); return (unsigned)q; }
__device__ __forceinline__ float lo4_dec(unsigned nib, unsigned e) { const float sc = (e >= 12u) ? __uint_as_float((e - 11u) << 23) : 0.f; return ((float)nib - 8.f) * sc; }
namespace pg8 {
#define PG8_LAS __attribute__((address_space(3)))
typedef unsigned short bf16_t;
typedef short bf16x8 __attribute__((ext_vector_type(8)));
typedef float f32x4 __attribute__((ext_vector_type(4)));
typedef unsigned u32x4 __attribute__((ext_vector_type(4)));
constexpr int BM = 256, BK = 64, HALF = 128, HTB = HALF * BK * 2  , STAGE_BYTES = 8 * HTB, NXCD = 8, WGM = 8;

__host__ __device__ __forceinline__ int lds_byte(int r, int c) { const int st = (r >> 4) * 2 + (c >> 5), rr = r & 15, cc = c & 31, ob = rr * 64 + cc * 2; return st * 1024 + (ob ^ (((ob >> 9) & 1) << 5)); }
__host__ __device__ __forceinline__ void stage_rc(int b, int& R, int& C) { const int st = b / 1024, sb = b % 1024, swz = sb ^ (((sb >> 9) & 1) << 5); R = (st >> 1) * 16 + swz / 64; C = (st & 1) * 32 + (swz % 64) / 2; }
__host__ __device__ __forceinline__ int perm32(int rho) { const int n = rho >> 4, i = rho & 15; return 8 * (i >> 2) + 4 * n + (i & 3); }

struct Unit { int pm, pn; };
struct Gemm { const bf16_t* A; const bf16_t* Bt; int M, N, K; };

struct StaticOrder {
    int nM, nN, nwg, G, c;
    __host__ __device__ void init(int M, int N, int G_, int c_) { nM = M / BM; nN = N / BM; nwg = nM * nN; G = G_; c = c_; }
    __host__ __device__ bool next(int i, Unit& u) const {
        const long L = (long)i * G + c; if (L >= nwg) return false;
        int wgid = (int)L; { const int q = nwg / NXCD, r = nwg % NXCD, xcd = wgid % NXCD, off = wgid / NXCD; wgid = (xcd < r ? xcd * (q + 1) : r * (q + 1) + (xcd - r) * q) + off; }
        const int nig = WGM * nN, gid = wgid / nig, fm = gid * WGM, gsz = (nM - fm) < WGM ? (nM - fm) : WGM;
        u.pm = fm + ((wgid % nig) % gsz); u.pn = (wgid % nig) / gsz; return true;
    }
    __device__ __forceinline__ void a_ready(const Unit&) const {}
    __device__ __forceinline__ void done(const Unit&) const {}
};
typedef unsigned u32x4 __attribute__((ext_vector_type(4)));
__device__ __forceinline__ unsigned cvt_pk_bf16(float lo, float hi) { unsigned r; asm volatile("v_cvt_pk_bf16_f32 %0, %1, %2" : "=v"(r) : "v"(lo), "v"(hi)); return r; }
__device__ __forceinline__ unsigned short cvt_bf16(float v) { return (unsigned short)(cvt_pk_bf16(v, 0.f) & 0xffffu); }
__device__ __forceinline__ u32x4 pack8(const f32x4 a, const f32x4 b) { u32x4 w; w.x = cvt_pk_bf16(a[0], a[1]); w.y = cvt_pk_bf16(a[2], a[3]); w.z = cvt_pk_bf16(b[0], b[1]); w.w = cvt_pk_bf16(b[2], b[3]); return w; }
__device__ __forceinline__ float row_rs(const float* ss, int row) {
    const f32x4* p = (const f32x4*)(ss + (size_t)row * 16);
    const f32x4 a = p[0], b = p[1], c = p[2], d = p[3];
    const float s = (((a[0] + a[1]) + (a[2] + a[3])) + ((b[0] + b[1]) + (b[2] + b[3]))) + (((c[0] + c[1]) + (c[2] + c[3])) + ((d[0] + d[1]) + (d[2] + d[3])));
    return __builtin_amdgcn_rsqf(s * (1.0f / 1024.0f) + 1e-6f);
}
__device__ __forceinline__ float silu_f(float g) { return g * __builtin_amdgcn_rcpf(1.0f + __builtin_amdgcn_exp2f(-1.4426950408889634f * g)); }
__device__ __forceinline__ float gelu_tanh_f(float v) { const float t = 0.7978845608028654f * (v + 0.044715f * v * v * v); return v * __builtin_amdgcn_rcpf(1.0f + __builtin_amdgcn_exp2f(-2.0f * 1.4426950408889634f * t)); }

struct RsCache { const PG8_LAS float* tab; int pm0; const float* ss;
    __device__ __forceinline__ float get(int pm, int lrow) const { return (pm == pm0) ? tab[lrow] : row_rs(ss, pm * BM + lrow); } };
struct EpiSwiglu {
    static constexpr bool PERM = true, AFTER_DRAIN = false;
    bf16_t* H; RsCache rc;
    typedef float f32x2 __attribute__((ext_vector_type(2)));
    static __device__ __forceinline__ f32x2 sw2(f32x2 g, f32x2 u, float c1, float rs2) {
        const f32x2 t = g * c1; f32x2 e; e.x = __builtin_amdgcn_exp2f(t.x); e.y = __builtin_amdgcn_exp2f(t.y);
        const f32x2 d = e + 1.0f; f32x2 r; r.x = __builtin_amdgcn_rcpf(d.x); r.y = __builtin_amdgcn_rcpf(d.y);
        return (g * u) * (r * rs2);
    }
    __device__ __forceinline__ void operator()(const f32x4 (&acc)[2][2][4][2], const Unit& u, int wr, int wc, int fr, int fq) const {
        const int col0 = u.pn * 128 + wc * 32 + 8 * fq;
        float rsv[2][4];
#pragma unroll
        for (int ai = 0; ai < 2; ++ai)
#pragma unroll
            for (int m = 0; m < 4; ++m) rsv[ai][m] = rc.get(u.pm, ai * HALF + wr * 64 + m * 16 + fr);
#pragma unroll
        for (int ai = 0; ai < 2; ++ai)
#pragma unroll
            for (int m = 0; m < 4; ++m) {
                const int row = u.pm * BM + ai * HALF + wr * 64 + m * 16 + fr; const float rs = rsv[ai][m], c1 = -1.4426950408889634f * rs, rs2 = rs * rs;
                const f32x4 g0 = acc[ai][0][m][0], g1 = acc[ai][0][m][1], u0 = acc[ai][1][m][0], u1 = acc[ai][1][m][1];
                const f32x2 a = sw2((f32x2){g0[0], g0[1]}, (f32x2){u0[0], u0[1]}, c1, rs2), b = sw2((f32x2){g0[2], g0[3]}, (f32x2){u0[2], u0[3]}, c1, rs2);
                const f32x2 c = sw2((f32x2){g1[0], g1[1]}, (f32x2){u1[0], u1[1]}, c1, rs2), d = sw2((f32x2){g1[2], g1[3]}, (f32x2){u1[2], u1[3]}, c1, rs2);
                u32x4 w; w.x = cvt_pk_bf16(a.x, a.y); w.y = cvt_pk_bf16(b.x, b.y); w.z = cvt_pk_bf16(c.x, c.y); w.w = cvt_pk_bf16(d.x, d.y);
                *(u32x4*)(H + (size_t)row * 2816 + col0) = w;
            }
    }
};
struct EpiResid {
    static constexpr bool PERM = true, AFTER_DRAIN = false;
    typedef unsigned u32x2 __attribute__((ext_vector_type(2)));
    float* OUT; bf16_t* XB; unsigned char* XL; float* ss; float alpha;
    __device__ __forceinline__ void operator()(const f32x4 (&acc)[2][2][4][2], const Unit& u, int wr, int wc, int fr, int fq) const {
        const int col0 = u.pn * BM + wc * 32 + 8 * fq;
        const size_t off0 = (size_t)(u.pm * BM + wr * 64 + fr) * 1024 + col0;
#pragma unroll
        for (int ai = 0; ai < 2; ++ai) {
            u32x4 hin[4][2]; unsigned lin[4][2];
#pragma unroll
            for (int m = 0; m < 4; ++m)
#pragma unroll
                for (int bj = 0; bj < 2; ++bj) { const size_t o = off0 + (size_t)(ai * HALF + m * 16) * 1024 + bj * HALF; hin[m][bj] = *(const u32x4*)(XB + o); lin[m][bj] = *(const unsigned*)(XL + (o >> 1)); }
            __builtin_amdgcn_sched_barrier(0);
#pragma unroll
            for (int m = 0; m < 4; ++m) {
                const int row = u.pm * BM + ai * HALF + wr * 64 + m * 16 + fr; float sq = 0.f;
#pragma unroll
                for (int bj = 0; bj < 2; ++bj) {
                    const size_t o = off0 + (size_t)(ai * HALF + m * 16) * 1024 + bj * HALF;
                    const u32x4 h = hin[m][bj]; const unsigned l = lin[m][bj];
                    float xv[8];
#pragma unroll
                    for (int k = 0; k < 8; ++k) { const unsigned wd = h[k >> 1]; const float hif = (k & 1) ? __uint_as_float(wd & 0xffff0000u) : __uint_as_float(wd << 16);
                        const unsigned ex = (k & 1) ? ((wd >> 23) & 0xffu) : ((wd >> 7) & 0xffu); const unsigned by = (l >> (4 * k)) & 0xfu;
                        xv[k] = hif + lo4_dec(by, ex) + acc[ai][bj][m][k >> 2][k & 3] * alpha; }
                    const f32x4 x0 = (f32x4){xv[0], xv[1], xv[2], xv[3]}, x1 = (f32x4){xv[4], xv[5], xv[6], xv[7]};
                    if (OUT) { *(f32x4*)(OUT + o) = x0; *(f32x4*)(OUT + o + 4) = x1; }
                    else {
#pragma unroll
                        for (int k = 0; k < 8; ++k) sq += xv[k] * xv[k];
                        const u32x4 hn = pack8(x0, x1);
                        unsigned ln = 0u;
#pragma unroll
                        for (int k = 0; k < 8; ++k) { const unsigned wd = hn[k >> 1]; const float hif = (k & 1) ? __uint_as_float(wd & 0xffff0000u) : __uint_as_float(wd << 16);
                            const unsigned ex = (k & 1) ? ((wd >> 23) & 0xffu) : ((wd >> 7) & 0xffu); ln |= lo4_enc(xv[k], hif, ex) << (4 * k); }
                        *(u32x4*)(XB + o) = hn; *(unsigned*)(XL + (o >> 1)) = ln;
                    }
                }
                if (!OUT) { { const int ln_ = fr + 16 * fq; sq += shx(sq, 16, ln_); sq += shx(sq, 32, ln_); }
                    if (fq == 0) ss[(size_t)row * 16 + u.pn * 4 + wc] = sq; }
            }
        }
    }
};
struct EpiRecIn {
    static constexpr bool PERM = true, AFTER_DRAIN = false;
    bf16_t* GG; bf16_t* REC; RsCache rc;
    __device__ __forceinline__ void operator()(const f32x4 (&acc)[2][2][4][2], const Unit& u, int wr, int wc, int fr, int fq) const {
        const bool isgate = u.pn < 4; bf16_t* dst = isgate ? GG : REC; const int col0 = (u.pn & 3) * BM + wc * 32 + 8 * fq;
#pragma unroll
        for (int ai = 0; ai < 2; ++ai)
#pragma unroll
            for (int m = 0; m < 4; ++m) {
                const int row = u.pm * BM + ai * HALF + wr * 64 + m * 16 + fr; const float rs = rc.get(u.pm, ai * HALF + wr * 64 + m * 16 + fr);
#pragma unroll
                for (int bj = 0; bj < 2; ++bj) {
                    f32x4 v0 = acc[ai][bj][m][0] * rs, v1 = acc[ai][bj][m][1] * rs;
                    if (isgate) {
#pragma unroll
                        for (int j = 0; j < 4; ++j) { v0[j] = gelu_tanh_f(v0[j]); v1[j] = gelu_tanh_f(v1[j]); }
                    }
                    *(u32x4*)(dst + (size_t)row * 1024 + col0 + bj * HALF) = pack8(v0, v1);
                }
            }
    }
};
struct EpiQK {
    static constexpr bool PERM = true, AFTER_DRAIN = false;
    bf16_t* QK; bf16_t* VT; RsCache rc; const float* gain; const float* cosT; const float* sinT; float oscale;
    __device__ __forceinline__ void operator()(const f32x4 (&acc)[2][2][4][2], const Unit& u, int wr, int wc, int fr, int fq) const {
        if (u.pn < 4) {
            const int hh = u.pn * 4 + wc;
            f32x4 glo[2], ghi[2];
#pragma unroll
            for (int n = 0; n < 2; ++n) { glo[n] = *(const f32x4*)(gain + 8 * fq + 4 * n); ghi[n] = *(const f32x4*)(gain + 32 + 8 * fq + 4 * n); }
#pragma unroll
            for (int ai = 0; ai < 2; ++ai)
#pragma unroll
                for (int m = 0; m < 4; ++m) {
                    const int row = u.pm * BM + ai * HALF + wr * 64 + m * 16 + fr; const float rs = rc.get(u.pm, ai * HALF + wr * 64 + m * 16 + fr); const int pos = row & 4095;
                    f32x4 v[2][2]; float sq = 0.f;
#pragma unroll
                    for (int bj = 0; bj < 2; ++bj)
#pragma unroll
                        for (int n = 0; n < 2; ++n) { v[bj][n] = acc[ai][bj][m][n] * rs; const f32x4 t = v[bj][n]; sq += (t[0] * t[0] + t[1] * t[1]) + (t[2] * t[2] + t[3] * t[3]); }
                    { const int ln_ = fr + 16 * fq; sq += shx(sq, 16, ln_); sq += shx(sq, 32, ln_); }
                    const float rinv = __builtin_amdgcn_rsqf(sq * (1.0f / 64.0f) + 1e-6f);
                    f32x4 olo[2], ohi[2];
#pragma unroll
                    for (int n = 0; n < 2; ++n) {
                        const f32x4 c = *(const f32x4*)(cosT + (size_t)pos * 32 + 8 * fq + 4 * n), s = *(const f32x4*)(sinT + (size_t)pos * 32 + 8 * fq + 4 * n);
                        const f32x4 ylo = v[0][n] * rinv * glo[n], yhi = v[1][n] * rinv * ghi[n];
                        olo[n] = (ylo * c - yhi * s) * oscale; ohi[n] = (yhi * c + ylo * s) * oscale;
                    }
                    bf16_t* dp = QK + (size_t)row * 1024 + hh * 64 + 8 * fq;
                    *(u32x4*)dp = pack8(olo[0], olo[1]); *(u32x4*)(dp + 32) = pack8(ohi[0], ohi[1]);
                }
        } else {
#pragma unroll
            for (int ai = 0; ai < 2; ++ai)
#pragma unroll
                for (int m = 0; m < 4; ++m) {
                    const int row = u.pm * BM + ai * HALF + wr * 64 + m * 16 + fr; const float rs = rc.get(u.pm, ai * HALF + wr * 64 + m * 16 + fr); const int b = row >> 12, s = row & 4095;
#pragma unroll
                    for (int bj = 0; bj < 2; ++bj)
#pragma unroll
                        for (int n = 0; n < 2; ++n)
#pragma unroll
                            for (int j = 0; j < 4; ++j) {
                                const int col = (u.pn - 4) * BM + bj * HALF + wc * 32 + 8 * fq + 4 * n + j;
                                VT[((size_t)(b * 1024 + col)) * 4096 + s] = cvt_bf16(acc[ai][bj][m][n][j] * rs);
                            }
                }
        }
    }
};

template <class Epi, class Sched, bool ALIGN_EPI = false, bool SP2 = false>
__device__ __forceinline__ void gemm_phase(PG8_LAS unsigned char* lds, const Gemm g, const Sched& S, const Epi& E, const int tid) {
    const int wid = __builtin_amdgcn_readfirstlane(tid >> 6), lane = tid & 63, wr = wid >> 2, wc = wid & 3, fr = lane & 15, fq = lane >> 4;
    const int K = g.K, nt = K / BK;
    unsigned voffA[2], voffB[2];
#pragma unroll
    for (int i = 0; i < 2; ++i) { int R, C; stage_rc(tid * 16 + i * 8192, R, C); const int Rb = Epi::PERM ? ((R & ~31) + perm32(R & 31)) : R;
        voffA[i] = (unsigned)(R * K + C) * 2u; voffB[i] = (unsigned)(Rb * K + C) * 2u; }
    const size_t kstep = (size_t)(BK * 2);
    const size_t hstep = (size_t)HALF * K * 2;
    const size_t tstep = 2 * hstep;
    const unsigned ldsw = (unsigned)wid * 1024u;
    const int aoff = lds_byte(wr * 64 + fr, fq * 8), boff = lds_byte(wc * 32 + fr, fq * 8);
#define PG8_SA(b, h) (((b) * 2 + (h)) * HTB)
#define PG8_SB(b, h) ((4 + (b) * 2 + (h)) * HTB)
#define PG8_STAGE(bufoff, gbase, voff) do { _Pragma("unroll") for (int _i = 0; _i < 2; ++_i) \
        __builtin_amdgcn_global_load_lds((const unsigned*)((const char*)(gbase) + (voff)[_i]), (PG8_LAS unsigned*)(lds + (bufoff) + ldsw + _i * 8192), 16, 0, 0); } while (0)
#define PG8_LDA(dst, b, h) do { _Pragma("unroll") for (int m = 0; m < 4; ++m) _Pragma("unroll") for (int k = 0; k < 2; ++k) dst[m][k] = *(const PG8_LAS bf16x8*)(lds + PG8_SA(b, h) + aoff + m * 2048 + k * 1024); } while (0)
#define PG8_LDB(dst, b, h) do { _Pragma("unroll") for (int n = 0; n < 2; ++n) _Pragma("unroll") for (int k = 0; k < 2; ++k) dst[n][k] = *(const PG8_LAS bf16x8*)(lds + PG8_SB(b, h) + boff + n * 2048 + k * 1024); } while (0)
#define PG8_MMA(ai, bj, At, Bt) do { __builtin_amdgcn_s_setprio(1); _Pragma("unroll") for (int m = 0; m < 4; ++m) _Pragma("unroll") for (int n = 0; n < 2; ++n) _Pragma("unroll") for (int k = 0; k < 2; ++k) \
        acc[ai][bj][m][n] = __builtin_amdgcn_mfma_f32_16x16x32_bf16(Bt[n][k], At[m][k], acc[ai][bj][m][n], 0, 0, 0); __builtin_amdgcn_s_setprio(0); } while (0)
#define PG8_WAIT_V(n) asm volatile("s_waitcnt vmcnt(" #n ")" ::: "memory")
#define PG8_WAIT_L(n) asm volatile("s_waitcnt lgkmcnt(" #n ")" ::: "memory")
#define PG8_BAR __builtin_amdgcn_s_barrier()
#define PG8_SCHED __builtin_amdgcn_sched_barrier(0)
    Unit cur, nxt; int ui = 0;
    if (!S.next(0, cur)) return;
    f32x4 acc[2][2][4][2];
#pragma unroll
    for (int a = 0; a < 2; ++a)
#pragma unroll
        for (int b = 0; b < 2; ++b)
#pragma unroll
            for (int m = 0; m < 4; ++m)
#pragma unroll
                for (int n = 0; n < 2; ++n) acc[a][b][m][n] = (f32x4){0.f, 0.f, 0.f, 0.f};
    bf16x8 At[4][2], B0[2][2], B1[2][2];
    const char* cA = (const char*)g.A + (size_t)cur.pm * tstep; const char* cB = (const char*)g.Bt + (size_t)cur.pn * tstep;
    S.a_ready(cur);
    if constexpr (SP2) {
        PG8_STAGE(PG8_SB(0, 0), cB, voffB); PG8_STAGE(PG8_SB(0, 1), cB + hstep, voffB); PG8_STAGE(PG8_SA(0, 0), cA, voffA); PG8_STAGE(PG8_SA(0, 1), cA + hstep, voffA);
        if (wr == 1) PG8_BAR;
        PG8_WAIT_V(2); PG8_BAR;
        PG8_STAGE(PG8_SB(1, 0), cB + kstep, voffB); PG8_STAGE(PG8_SA(1, 0), cA + kstep, voffA); PG8_STAGE(PG8_SB(1, 1), cB + hstep + kstep, voffB);
        PG8_WAIT_V(6); PG8_BAR;
    } else {
        PG8_STAGE(PG8_SB(0, 0), cB, voffB); PG8_STAGE(PG8_SA(0, 0), cA, voffA); PG8_STAGE(PG8_SB(0, 1), cB + hstep, voffB); PG8_STAGE(PG8_SA(0, 1), cA + hstep, voffA);
        if (wr == 1) PG8_BAR;
        PG8_WAIT_V(4); PG8_BAR;
        PG8_STAGE(PG8_SB(1, 0), cB + kstep, voffB); PG8_STAGE(PG8_SA(1, 0), cA + kstep, voffA); PG8_STAGE(PG8_SB(1, 1), cB + hstep + kstep, voffB);
        PG8_WAIT_V(6); PG8_BAR;
    }
    for (;;) {
        const bool has_next = S.next(ui + 1, nxt);
        const char* nA = has_next ? (const char*)g.A + (size_t)nxt.pm * tstep : cA; const char* nB = has_next ? (const char*)g.Bt + (size_t)nxt.pn * tstep : cB;
        for (int t = 0; t < nt; t += 2) {
            const bool last = (t == nt - 2);
            const char* a1 = cA + (size_t)(t + 1) * kstep;
            const char* a2 = last ? nA : cA + (size_t)(t + 2) * kstep; const char* b2 = last ? nB : cB + (size_t)(t + 2) * kstep;
            const char* a3 = a2 + kstep; const char* b3 = b2 + kstep;
            if (last && has_next) S.a_ready(nxt);
            if constexpr (SP2) {
            PG8_LDB(B0, 0, 0); PG8_LDB(B1, 0, 1); PG8_SCHED; PG8_LDA(At, 0, 0); PG8_STAGE(PG8_SA(1, 1), a1 + hstep, voffA);
            PG8_WAIT_V(8); PG8_WAIT_L(0); PG8_BAR; PG8_MMA(0, 0, At, B0); PG8_MMA(0, 1, At, B1); PG8_BAR; PG8_SCHED;
            PG8_LDA(At, 0, 1); PG8_STAGE(PG8_SB(0, 0), b2, voffB); PG8_STAGE(PG8_SB(0, 1), b2 + hstep, voffB); PG8_STAGE(PG8_SA(0, 0), a2, voffA);
            PG8_WAIT_V(8); PG8_WAIT_L(0); PG8_BAR; PG8_MMA(1, 0, At, B0); PG8_MMA(1, 1, At, B1); PG8_BAR; PG8_SCHED;
            PG8_LDB(B0, 1, 0); PG8_LDB(B1, 1, 1); PG8_SCHED; PG8_LDA(At, 1, 0); PG8_STAGE(PG8_SA(0, 1), a2 + hstep, voffA);
            PG8_WAIT_V(8); PG8_WAIT_L(0); PG8_BAR; PG8_MMA(0, 0, At, B0); PG8_MMA(0, 1, At, B1); PG8_BAR; PG8_SCHED;
            PG8_LDA(At, 1, 1); PG8_STAGE(PG8_SB(1, 0), b3, voffB); PG8_STAGE(PG8_SB(1, 1), b3 + hstep, voffB); PG8_STAGE(PG8_SA(1, 0), a3, voffA);
            PG8_WAIT_V(8); PG8_WAIT_L(0); PG8_BAR; PG8_MMA(1, 0, At, B0); PG8_MMA(1, 1, At, B1); PG8_BAR; PG8_SCHED;
            } else {
            PG8_LDB(B0, 0, 0); PG8_SCHED; PG8_LDA(At, 0, 0); PG8_STAGE(PG8_SA(1, 1), a1 + hstep, voffA);
            PG8_WAIT_L(8); PG8_BAR; PG8_WAIT_L(0); PG8_MMA(0, 0, At, B0); PG8_BAR; PG8_SCHED;
            PG8_LDB(B1, 0, 1); PG8_STAGE(PG8_SB(0, 0), b2, voffB);
            PG8_BAR; PG8_WAIT_L(0); PG8_MMA(0, 1, At, B1); PG8_BAR;
            PG8_LDA(At, 0, 1); PG8_STAGE(PG8_SA(0, 0), a2, voffA);
            PG8_BAR; PG8_WAIT_L(0); PG8_MMA(1, 0, At, B0); PG8_BAR; PG8_SCHED;
            PG8_STAGE(PG8_SB(0, 1), b2 + hstep, voffB);
            PG8_WAIT_V(6); PG8_BAR; PG8_MMA(1, 1, At, B1); PG8_BAR;
            PG8_LDB(B0, 1, 0); PG8_SCHED; PG8_LDA(At, 1, 0); PG8_STAGE(PG8_SA(0, 1), a2 + hstep, voffA);
            PG8_WAIT_L(8); PG8_BAR; PG8_WAIT_L(0); PG8_MMA(0, 0, At, B0); PG8_BAR; PG8_SCHED;
            PG8_LDB(B1, 1, 1); PG8_STAGE(PG8_SB(1, 0), b3, voffB);
            PG8_BAR; PG8_WAIT_L(0); PG8_MMA(0, 1, At, B1); PG8_BAR;
            PG8_LDA(At, 1, 1); PG8_STAGE(PG8_SA(1, 0), a3, voffA);
            PG8_BAR; PG8_WAIT_L(0); PG8_MMA(1, 0, At, B0); PG8_BAR; PG8_SCHED;
            PG8_STAGE(PG8_SB(1, 1), b3 + hstep, voffB);
            PG8_WAIT_V(6); PG8_BAR; PG8_MMA(1, 1, At, B1); PG8_BAR;
            }
        }
        if constexpr (ALIGN_EPI) { if (wr == 0) PG8_BAR; }
        if constexpr (!Epi::AFTER_DRAIN) { E(acc, cur, wr, wc, fr, fq); S.done(cur); }
        if (!has_next) break;
#pragma unroll
        for (int a = 0; a < 2; ++a)
#pragma unroll
            for (int b = 0; b < 2; ++b)
#pragma unroll
                for (int m = 0; m < 4; ++m)
#pragma unroll
                    for (int n = 0; n < 2; ++n) acc[a][b][m][n] = (f32x4){0.f, 0.f, 0.f, 0.f};
        cur = nxt; cA = nA; cB = nB; ++ui;
        if constexpr (ALIGN_EPI) { if (wr == 1) PG8_BAR; }
    }
    PG8_WAIT_V(0);
    if constexpr (!ALIGN_EPI) { if (wr == 0) PG8_BAR; }
    PG8_BAR;
    if constexpr (Epi::AFTER_DRAIN) { E.fused(acc, cur, wr, wc, fr, fq, lds, wid, lane); S.done(cur); }
#undef PG8_SA
#undef PG8_SB
#undef PG8_STAGE
#undef PG8_LDA
#undef PG8_LDB
#undef PG8_MMA
#undef PG8_WAIT_V
#undef PG8_WAIT_L
#undef PG8_BAR
#undef PG8_SCHED
}
}
#define LAS __attribute__((address_space(3)))
typedef unsigned short bf16_t;
typedef short bf16x8 __attribute__((ext_vector_type(8)));
typedef short s16x4 __attribute__((ext_vector_type(4)));
typedef float f32x4 __attribute__((ext_vector_type(4)));
typedef float f32x16 __attribute__((ext_vector_type(16)));
typedef unsigned u32x4 __attribute__((ext_vector_type(4)));
typedef unsigned u32x2 __attribute__((ext_vector_type(2)));
using pg8::cvt_pk_bf16; using pg8::cvt_bf16; using pg8::pack8;

constexpr int BATCH = 4, SEQ = 4096, DM = 1024, MROWS = BATCH * SEQ, FF = 2816;
constexpr int NTHREADS = 512, NWAVES = 8;
constexpr int LDS_BYTES = 147456;
constexpr size_t MiB = 1u << 20;
constexpr size_t WS_SS = 0;
constexpr size_t WS_COS = 1 * MiB, WS_SIN = 1 * MiB + 512 * 1024;
constexpr size_t WS_SPAN = 2 * MiB;
constexpr size_t WS_BAR = 3 * MiB;
constexpr size_t WS_W = 4 * MiB;
constexpr size_t W_FFN_STRIDE = 17301504, W_FFN_DN = 11534336;
constexpr size_t W_REC = WS_W + 132 * MiB, W_REC_STRIDE = 6 * MiB + 512 * 1024, W_REC_G = 4 * MiB, W_REC_OUT = 4 * MiB + 512 * 1024;
constexpr size_t W_KV = WS_W + 145 * MiB, W_Q = WS_W + 149 * MiB, W_O = WS_W + 153 * MiB;
constexpr size_t WS_XB = 162 * MiB, WS_K = 194 * MiB, WS_VT = 226 * MiB, WS_H = 258 * MiB;
constexpr size_t WS_GG = WS_H, WS_REC = WS_H + 32 * MiB, WS_Y = WS_K;
constexpr size_t WS_QO = WS_H, WS_ASCR = WS_H + 32 * MiB;
constexpr size_t WS_O = WS_W;
constexpr size_t WS_XL = 346 * MiB;
constexpr size_t WS_END = 378 * MiB;

struct Params { const float* in[31]; float* out; unsigned char* ws; double invfreq[32]; float linit[2]; int ph_lo, ph_hi, rep_mask, pad; };
typedef const __attribute__((address_space(4))) Params CParams;

__device__ __forceinline__ float wave_sum(float v, int lane) {
#pragma unroll
    for (int o = 1; o < 64; o <<= 1) v += shx(v, o, lane);
    return v;
}
#define LDS_WAIT() asm volatile("s_waitcnt lgkmcnt(0)" ::: "memory")
#define LDS_BARRIER() asm volatile("s_waitcnt lgkmcnt(0)\n\ts_barrier" ::: "memory")

__device__ __forceinline__ void tr_item(const float* W, int ldw, const float* gain, bf16_t* WT, int K, int drow0, int k0, int n0, LAS float* scr, int lane) {
    float tv[32];
    const float* wp = W + (size_t)(k0 + (lane >> 5)) * ldw + n0 + (lane & 31);
#pragma unroll
    for (int i = 0; i < 32; ++i) tv[i] = __builtin_nontemporal_load(wp + (size_t)(2 * i) * ldw);
    if (gain) {
#pragma unroll
        for (int i = 0; i < 32; ++i) tv[i] *= gain[k0 + 2 * i + (lane >> 5)];
    }
#pragma unroll
    for (int i = 0; i < 32; ++i) scr[(2 * i + (lane >> 5)) * 33 + (lane & 31)] = tv[i];
    LDS_WAIT(); asm volatile("" ::: "memory");
    const int c = lane & 7;
#pragma unroll
    for (int j = 0; j < 4; ++j) { const int n = (lane >> 3) + 8 * j; const LAS float* s = scr + (8 * c) * 33 + n;
        u32x4 o; o.x = cvt_pk_bf16(s[0 * 33], s[1 * 33]); o.y = cvt_pk_bf16(s[2 * 33], s[3 * 33]); o.z = cvt_pk_bf16(s[4 * 33], s[5 * 33]); o.w = cvt_pk_bf16(s[6 * 33], s[7 * 33]);
        *(u32x4*)(WT + (size_t)(drow0 + n) * K + k0 + 8 * c) = o; }
    LDS_WAIT(); asm volatile("" ::: "memory");
}
__device__ __forceinline__ int headperm_row0(int n0) { const int sb = n0 >> 5, pn = sb >> 3, rem = sb & 7, wc = rem >> 1, bj = rem & 1; return pn * 256 + bj * 128 + wc * 32; }

__device__ __forceinline__ void prologue_item(CParams& P, int it, LAS float* scr, int lane) {
    unsigned char* ws = P.ws;
    if (it < 16 * 1408) {
        const int mi = it / 1408, r = it % 1408, f = mi >> 1, gu = mi & 1, layer = f >> 1, which = f & 1;
        const float* W = (which ? (gu ? P.in[7] : P.in[6]) : (gu ? P.in[3] : P.in[2])) + (size_t)layer * 1024 * 2816;
        const float* g = (which ? P.in[5] : P.in[1]) + layer * 1024;
        const int kb = r / 88, nb = r % 88, n0 = nb * 32;
        tr_item(W, 2816, g, (bf16_t*)(ws + WS_W + (size_t)f * W_FFN_STRIDE), 1024, (n0 >> 7) * 256 + (n0 & 127) + gu * 128, kb * 64, n0, scr, lane); return; }
    it -= 16 * 1408;
    if (it < 8 * 1408) {
        const int f = it / 1408, r = it % 1408, layer = f >> 1, which = f & 1;
        const float* W = (which ? P.in[8] : P.in[4]) + (size_t)layer * 2816 * 1024;
        const int kb = r / 32, nb = r % 32;
        tr_item(W, 1024, nullptr, (bf16_t*)(ws + WS_W + (size_t)f * W_FFN_STRIDE + W_FFN_DN), 2816, nb * 32, kb * 64, nb * 32, scr, lane); return; }
    it -= 8 * 1408;
    if (it < 2 * 1024) {
        const int a = it / 1024, r = it % 1024, kb = r / 64, nb = r % 64;
        tr_item(P.in[10] + (size_t)a * 1024 * 2048, 2048, P.in[9] + a * 1024, (bf16_t*)(ws + W_REC + (size_t)a * W_REC_STRIDE), 1024, nb * 32, kb * 64, nb * 32, scr, lane); return; }
    it -= 2 * 1024;
    if (it < 256) {
        const int mi = it / 8, r = it % 8, a = mi >> 4, g = (mi >> 3) & 1, blk = mi & 7, kb = r / 4, nb = r % 4;
        const float* W = (g ? P.in[15] : P.in[13]) + (size_t)(a * 8 + blk) * 128 * 128;
        tr_item(W, 128, nullptr, (bf16_t*)(ws + W_REC + (size_t)a * W_REC_STRIDE + W_REC_G) + (size_t)(blk * 2 + g) * 128 * 128, 128, nb * 32, kb * 64, nb * 32, scr, lane); return; }
    it -= 256;
    if (it < 2 * 512) {
        const int a = it / 512, r = it % 512, kb = r / 32, nb = r % 32;
        tr_item(P.in[18] + (size_t)a * 1024 * 1024, 1024, nullptr, (bf16_t*)(ws + W_REC + (size_t)a * W_REC_STRIDE + W_REC_OUT), 1024, nb * 32, kb * 64, nb * 32, scr, lane); return; }
    it -= 2 * 512;
    if (it < 2 * 512) {
        const int v = it / 512, r = it % 512, kb = r / 32, nb = r % 32, n0 = nb * 32;
        tr_item(v ? P.in[21] : P.in[20], 1024, P.in[19], (bf16_t*)(ws + W_KV), 1024, v ? 1024 + n0 : headperm_row0(n0), kb * 64, n0, scr, lane); return; }
    it -= 2 * 512;
    if (it < 2 * 512) {
        const int j = it / 512, r = it % 512, kb = r / 32, nb = r % 32, n0 = nb * 32;
        tr_item(P.in[25] + (size_t)j * 1024 * 1024, 1024, P.in[9] + (2 + j) * 1024, (bf16_t*)(ws + W_Q + (size_t)j * 2 * MiB), 1024, headperm_row0(n0), kb * 64, n0, scr, lane); return; }
    it -= 2 * 512;
    {
        const int j = it / 512, r = it % 512, kb = r / 32, nb = r % 32;
        tr_item(P.in[30] + (size_t)j * 1024 * 1024, 1024, nullptr, (bf16_t*)(ws + W_O + (size_t)j * 2 * MiB), 1024, nb * 32, kb * 64, nb * 32, scr, lane); }
}
__device__ __forceinline__ void ffn_item(CParams& P, int f, int j, LAS float* scr, int lane) { prologue_item(P, (j < 2816) ? f * 2816 + j : 16 * 1408 + f * 1408 + (j - 2816), scr, lane); }
constexpr int N_PRO_ITEMS = 16 * 1408 + 8 * 1408 + 2 * 1024 + 256 + 2 * 512 + 2 * 512 + 2 * 512 + 2 * 512;

__device__ __forceinline__ void prologue(CParams& P, LAS unsigned char* lds, int vcu, int G, const int tid) {
    const int lane = tid & 63, wave = __builtin_amdgcn_readfirstlane(tid >> 6);
    LAS float* scr = (LAS float*)(lds + wave * 16384);
    const int gw = vcu * NWAVES + wave, NGW = G * NWAVES;
    for (int it = gw; it < 4224 + (N_PRO_ITEMS - 24 * 1408); it += NGW) { if (it < 4224) ffn_item(P, 0, it, scr, lane); else prologue_item(P, 24 * 1408 + (it - 4224), scr, lane); }
    const float* x = P.in[0]; bf16_t* XB = (bf16_t*)(P.ws + WS_XB); unsigned char* XL = (unsigned char*)(P.ws + WS_XL); float* ss = (float*)(P.ws + WS_SS);
    for (int m = gw; m < MROWS; m += NGW) {
        const f32x4* xr = (const f32x4*)(x + (size_t)m * DM) + lane; u32x2* bo = (u32x2*)(XB + (size_t)m * DM) + lane; unsigned short* lo = (unsigned short*)(XL + (size_t)m * (DM / 2)) + lane;
        float s = 0.f;
#pragma unroll
        for (int j = 0; j < 4; ++j) { const f32x4 v = xr[64 * j]; s += (v[0] * v[0] + v[1] * v[1]) + (v[2] * v[2] + v[3] * v[3]);
            u32x2 w; w.x = cvt_pk_bf16(v[0], v[1]); w.y = cvt_pk_bf16(v[2], v[3]); bo[64 * j] = w;
            const unsigned q0 = lo4_enc(v[0], __uint_as_float(w.x << 16), (w.x >> 7) & 0xffu), q1 = lo4_enc(v[1], __uint_as_float(w.x & 0xffff0000u), (w.x >> 23) & 0xffu);
            const unsigned q2 = lo4_enc(v[2], __uint_as_float(w.y << 16), (w.y >> 7) & 0xffu), q3 = lo4_enc(v[3], __uint_as_float(w.y & 0xffff0000u), (w.y >> 23) & 0xffu);
            lo[64 * j] = (unsigned short)(q0 | (q1 << 4) | (q2 << 8) | (q3 << 12)); }
        s = wave_sum(s, lane);
        if (lane < 16) ss[(size_t)m * 16 + lane] = (lane == 0) ? s : 0.f;
    }
    float* cosT = (float*)(P.ws + WS_COS); float* sinT = (float*)(P.ws + WS_SIN);
    for (int idx = vcu * NTHREADS + tid; idx < SEQ * 32; idx += G * NTHREADS) {
        const int pos = idx >> 5, i = idx & 31; double f = 0.0;
#pragma unroll
        for (int k = 0; k < 32; ++k) f = (i == k) ? P.invfreq[k] : f;
        const double ang = (double)pos * f; const double kq = __builtin_rint(ang * 0.63661977236758134308); const double r = ang - kq * 1.57079632679489661923;
        const float rf = (float)r, rr = rf * rf;
        const float sr = rf * (1.0f + rr * (-1.6666667e-1f + rr * (8.3333333e-3f + rr * (-1.9841270e-4f + rr * 2.7557319e-6f))));
        const float cr = 1.0f + rr * (-0.5f + rr * (4.1666667e-2f + rr * (-1.3888889e-3f + rr * (2.4801587e-5f + rr * -2.7557319e-7f))));
        const int q = ((int)kq) & 3; const float sv = (q == 0) ? sr : (q == 1) ? cr : (q == 2) ? -sr : -cr; const float cv = (q == 0) ? cr : (q == 1) ? -sr : (q == 2) ? -cr : sr;
        cosT[idx] = cv; sinT[idx] = sv;
    }
}

constexpr int SC_XA = 0, SC_X32 = 17408, SC_BUF = 51200;
__device__ __forceinline__ int sc_rho(int t) { return 16 * ((t >> 2) & 3) + 4 * (t >> 4) + (t & 3); }
__device__ __forceinline__ float bf_lo(unsigned u) { return __uint_as_float(u << 16); }
__device__ __forceinline__ float bf_hi(unsigned u) { return __uint_as_float(u & 0xffff0000u); }
template <int PASS> __device__ __forceinline__ void scan_unit(CParams& P, LAS unsigned char* lds, int a, int b, int n, int sp, const int tid) {
    const int lane = tid & 63, w = __builtin_amdgcn_readfirstlane(tid >> 6), chl = lane & 15, fq = lane >> 4;
    const int ch = 128 * n + 16 * w + chl;
    const bf16_t* REC = (const bf16_t*)(P.ws + WS_REC); const bf16_t* GG = (const bf16_t*)(P.ws + WS_GG); bf16_t* Y = (bf16_t*)(P.ws + WS_Y);
    const bf16_t* GW = (const bf16_t*)(P.ws + W_REC + (size_t)a * W_REC_STRIDE + W_REC_G);
    float* spanA = (float*)(P.ws + WS_SPAN); float* spanH = spanA + BATCH * 8 * 1024;
    bf16x8 bfa[4], bfx[4];
#pragma unroll
    for (int ks = 0; ks < 4; ++ks) { bfa[ks] = *(const bf16x8*)(GW + ((size_t)(n * 2 + 0) * 128 + 16 * w + chl) * 128 + 32 * ks + 8 * fq); bfx[ks] = *(const bf16x8*)(GW + ((size_t)(n * 2 + 1) * 128 + 16 * w + chl) * 128 + 32 * ks + 8 * fq); }
    const float ba = P.in[14][a * 1024 + ch], bxb = P.in[16][a * 1024 + ch];
    const float lamv = P.in[17][a * 1024 + ch];
    const float c8 = -8.0f * log1pf(__expf(-lamv));
    float hc = 0.f, Asp = 1.f;
    if (PASS == 2) {
        float A2[7], H2[7];
#pragma unroll
        for (int s2 = 0; s2 < 7; ++s2) { A2[s2] = spanA[(size_t)(b * 8 + s2) * 1024 + ch]; H2[s2] = spanH[(size_t)(b * 8 + s2) * 1024 + ch]; }
#pragma unroll
        for (int s2 = 0; s2 < 7; ++s2) hc = (s2 < sp) ? (A2[s2] * hc + H2[s2]) : hc;
    }
    const int tp = tid >> 4, cg8 = tid & 15;
    const int rho0 = sc_rho(2 * tp), rho1 = sc_rho(2 * tp + 1);
    const float* cwp = P.in[11] + (size_t)a * 4 * 1024 + 128 * n + 8 * cg8; const float* cbp = P.in[12] + a * 1024 + 128 * n + 8 * cg8;
    const bf16_t* rbase = REC + ((size_t)(b * SEQ + sp * 512 + 2 * tp)) * 1024 + 128 * n + 8 * cg8;
    const bf16_t* gbase = GG + ((size_t)(b * SEQ + sp * 512 + 2 * tp)) * 1024 + 128 * n + 8 * cg8;
    bf16_t* ybase = Y + ((size_t)(b * SEQ + sp * 512 + 2 * tp)) * 1024 + 128 * n + 8 * cg8;
    f32x4 cwa[4], cwb[4];
#pragma unroll
    for (int k = 0; k < 4; ++k) { cwa[k] = *(const f32x4*)(cwp + k * 1024); cwb[k] = *(const f32x4*)(cwp + k * 1024 + 4); }
    const f32x4 cb0 = *(const f32x4*)cbp, cb1 = *(const f32x4*)(cbp + 4);
    u32x4 R[5], G0 = (u32x4){0u, 0u, 0u, 0u}, G1 = (u32x4){0u, 0u, 0u, 0u};
#define SC_LOAD(ci_) do { _Pragma("unroll") for (int k = 0; k < 5; ++k) { const int pos = sp * 512 + (ci_) * 64 + 2 * tp - 3 + k; R[k] = (u32x4){0u, 0u, 0u, 0u}; \
            if (pos >= 0) R[k] = *(const u32x4*)(rbase + ((ci_) * 64 - 3 + k) * 1024); } \
        if (PASS == 2) { G0 = *(const u32x4*)(gbase + (ci_) * 64 * 1024); G1 = *(const u32x4*)(gbase + ((ci_) * 64 + 1) * 1024); } } while (0)
    SC_LOAD(0);
    for (int ci = 0; ci < 8; ++ci) {
        LAS unsigned char* buf = lds + (ci & 1) * SC_BUF;
        LAS float* xf = (LAS float*)(buf + SC_X32);
        const u32x4 Gc0 = G0, Gc1 = G1;
        {
            float x0[8], x1[8];
#pragma unroll
            for (int e = 0; e < 4; ++e) { x0[e] = cb0[e]; x0[4 + e] = cb1[e]; x1[e] = cb0[e]; x1[4 + e] = cb1[e]; }
#pragma unroll
            for (int k = 0; k < 4; ++k) {
                const f32x4 wa = cwa[k], wb = cwb[k];
                const u32x4 ra = R[k], rb = R[k + 1];
                x0[0] += wa[0] * bf_lo(ra.x); x0[1] += wa[1] * bf_hi(ra.x); x0[2] += wa[2] * bf_lo(ra.y); x0[3] += wa[3] * bf_hi(ra.y);
                x0[4] += wb[0] * bf_lo(ra.z); x0[5] += wb[1] * bf_hi(ra.z); x0[6] += wb[2] * bf_lo(ra.w); x0[7] += wb[3] * bf_hi(ra.w);
                x1[0] += wa[0] * bf_lo(rb.x); x1[1] += wa[1] * bf_hi(rb.x); x1[2] += wa[2] * bf_lo(rb.y); x1[3] += wa[3] * bf_hi(rb.y);
                x1[4] += wb[0] * bf_lo(rb.z); x1[5] += wb[1] * bf_hi(rb.z); x1[6] += wb[2] * bf_lo(rb.w); x1[7] += wb[3] * bf_hi(rb.w);
            }
            u32x4 p0, p1; p0.x = cvt_pk_bf16(x0[0], x0[1]); p0.y = cvt_pk_bf16(x0[2], x0[3]); p0.z = cvt_pk_bf16(x0[4], x0[5]); p0.w = cvt_pk_bf16(x0[6], x0[7]);
            p1.x = cvt_pk_bf16(x1[0], x1[1]); p1.y = cvt_pk_bf16(x1[2], x1[3]); p1.z = cvt_pk_bf16(x1[4], x1[5]); p1.w = cvt_pk_bf16(x1[6], x1[7]);
            *(LAS u32x4*)(buf + SC_XA + rho0 * 272 + cg8 * 16) = p0; *(LAS u32x4*)(buf + SC_XA + rho1 * 272 + cg8 * 16) = p1;
            *(LAS f32x4*)(xf + rho0 * 132 + cg8 * 8) = (f32x4){x0[0], x0[1], x0[2], x0[3]}; *(LAS f32x4*)(xf + rho0 * 132 + cg8 * 8 + 4) = (f32x4){x0[4], x0[5], x0[6], x0[7]};
            *(LAS f32x4*)(xf + rho1 * 132 + cg8 * 8) = (f32x4){x1[0], x1[1], x1[2], x1[3]}; *(LAS f32x4*)(xf + rho1 * 132 + cg8 * 8 + 4) = (f32x4){x1[4], x1[5], x1[6], x1[7]};
        }
        if (ci + 1 < 8) SC_LOAD(ci + 1);
        LDS_BARRIER();
        f32x4 ga[4], gx[4];
#pragma unroll
        for (int mt = 0; mt < 4; ++mt) { ga[mt] = (f32x4){0.f, 0.f, 0.f, 0.f}; gx[mt] = (f32x4){0.f, 0.f, 0.f, 0.f};
#pragma unroll
            for (int ks = 0; ks < 4; ++ks) { const bf16x8 af = *(const LAS bf16x8*)(buf + SC_XA + (16 * mt + chl) * 272 + (32 * ks + 8 * fq) * 2);
                ga[mt] = __builtin_amdgcn_mfma_f32_16x16x32_bf16(af, bfa[ks], ga[mt], 0, 0, 0); gx[mt] = __builtin_amdgcn_mfma_f32_16x16x32_bf16(af, bfx[ks], gx[mt], 0, 0, 0); } }
        LAS float* xl = xf + (4 * fq) * 132 + 16 * w + chl;
        float Pm[16], hl[16]; float p = 1.f, hh = 0.f;
#pragma unroll
        for (int mt = 0; mt < 4; ++mt)
#pragma unroll
            for (int r = 0; r < 4; ++r) {
                const float xv = xl[(16 * mt + r) * 132];
                const float rg = __builtin_amdgcn_rcpf(1.0f + __expf(-(ga[mt][r] + ba))), ig = __builtin_amdgcn_rcpf(1.0f + __expf(-(gx[mt][r] + bxb)));
                const float la = c8 * rg, t2 = 2.0f * la, av = __expf(la);
                const float poly = -t2 * (1.0f + t2 * (0.5f + t2 * (1.6666667e-1f + t2 * (4.1666667e-2f + t2 * (8.3333333e-3f + t2 * 1.3888889e-3f)))));
                const float om = (t2 > -0.25f) ? poly : (1.0f - av * av);
                const float bxv = __builtin_amdgcn_sqrtf(om) * ig * xv;
                p *= av; hh = av * hh + bxv; Pm[4 * mt + r] = p; hl[4 * mt + r] = hh;
            }
        float IA = p, IH = hh;
        float pA = shl_from(IA, (lane - 16) & 63), pH = shl_from(IH, (lane - 16) & 63); if (fq >= 1) { IH = IA * pH + IH; IA = IA * pA; }
        pA = shl_from(IA, (lane - 32) & 63); pH = shl_from(IH, (lane - 32) & 63); if (fq >= 2) { IH = IA * pH + IH; IA = IA * pA; }
        float EA = shl_from(IA, (lane - 16) & 63), EH = shl_from(IH, (lane - 16) & 63); if (fq == 0) { EA = 1.f; EH = 0.f; }
        const float TA = shl_from(IA, 48 + chl), TH = shl_from(IH, 48 + chl);
        const float hstart = EA * hc + EH;
        hc = TA * hc + TH; Asp *= TA;
        if (PASS == 2) {
#pragma unroll
            for (int mt = 0; mt < 4; ++mt)
#pragma unroll
                for (int r = 0; r < 4; ++r) xl[(16 * mt + r) * 132] = hl[4 * mt + r] + Pm[4 * mt + r] * hstart;
            LDS_BARRIER();
            const f32x4 h00 = *(const LAS f32x4*)(xf + rho0 * 132 + cg8 * 8), h01 = *(const LAS f32x4*)(xf + rho0 * 132 + cg8 * 8 + 4);
            const f32x4 h10 = *(const LAS f32x4*)(xf + rho1 * 132 + cg8 * 8), h11 = *(const LAS f32x4*)(xf + rho1 * 132 + cg8 * 8 + 4);
            u32x4 y0, y1;
            y0.x = cvt_pk_bf16(bf_lo(Gc0.x) * h00[0], bf_hi(Gc0.x) * h00[1]); y0.y = cvt_pk_bf16(bf_lo(Gc0.y) * h00[2], bf_hi(Gc0.y) * h00[3]);
            y0.z = cvt_pk_bf16(bf_lo(Gc0.z) * h01[0], bf_hi(Gc0.z) * h01[1]); y0.w = cvt_pk_bf16(bf_lo(Gc0.w) * h01[2], bf_hi(Gc0.w) * h01[3]);
            y1.x = cvt_pk_bf16(bf_lo(Gc1.x) * h10[0], bf_hi(Gc1.x) * h10[1]); y1.y = cvt_pk_bf16(bf_lo(Gc1.y) * h10[2], bf_hi(Gc1.y) * h10[3]);
            y1.z = cvt_pk_bf16(bf_lo(Gc1.z) * h11[0], bf_hi(Gc1.z) * h11[1]); y1.w = cvt_pk_bf16(bf_lo(Gc1.w) * h11[2], bf_hi(Gc1.w) * h11[3]);
            *(u32x4*)(ybase + (size_t)(ci * 64) * 1024) = y0; *(u32x4*)(ybase + (size_t)(ci * 64 + 1) * 1024) = y1;
        }
    }
#undef SC_LOAD
    if (PASS == 1 && fq == 0) { spanA[(size_t)(b * 8 + sp) * 1024 + ch] = Asp; spanH[(size_t)(b * 8 + sp) * 1024 + ch] = hc; }
    __syncthreads();
}

constexpr int AT_K = 0, AT_V = 9216, AT_BUF = 27648;
__device__ __forceinline__ int crow(int r, int hi) { return (r & 3) + 8 * (r >> 2) + 4 * hi; }
__device__ __forceinline__ void attn_qk(const LAS unsigned char* buf, const bf16x8 (&qf)[4], u32x4 (&pw)[4], float& lsum, const int q, const int hi) {
    const LAS unsigned char* Kb = buf + AT_K;
    f32x16 p0, p1;
#pragma unroll
    for (int r = 0; r < 16; ++r) { p0[r] = 0.f; p1[r] = 0.f; }
    {   bf16x8 kf[4];
        const LAS unsigned char* kq = Kb + q * 144 + hi * 16;
#define AT_KREAD(i) do { kf[(i) & 3] = *(const LAS bf16x8*)(kq + ((i) & 1) * (32 * 144) + ((i) >> 1) * 32); } while (0)
        AT_KREAD(0); AT_KREAD(1); AT_KREAD(2); AT_KREAD(3);
        __builtin_amdgcn_sched_barrier(0);
#pragma unroll
        for (int i = 0; i < 8; ++i) {
            if (i & 1) p1 = __builtin_amdgcn_mfma_f32_32x32x16_bf16(kf[i & 3], qf[i >> 1], p1, 0, 0, 0); else p0 = __builtin_amdgcn_mfma_f32_32x32x16_bf16(kf[i & 3], qf[i >> 1], p0, 0, 0, 0);
            if (i + 4 < 8) AT_KREAD(i + 4);
            __builtin_amdgcn_sched_barrier(0);
        }
#undef AT_KREAD
    }
    __builtin_amdgcn_sched_barrier(0);
    float sa = 0.f, sb = 0.f;
#pragma unroll
    for (int r = 0; r < 16; ++r) { p0[r] = __builtin_amdgcn_exp2f(p0[r]); p1[r] = __builtin_amdgcn_exp2f(p1[r]); sa += p0[r]; sb += p1[r]; }
    lsum += sa + sb;
#pragma unroll
    for (int e = 0; e < 4; ++e) { pw[0][e] = cvt_pk_bf16(p0[2 * e], p0[2 * e + 1]); pw[1][e] = cvt_pk_bf16(p0[8 + 2 * e], p0[8 + 2 * e + 1]); pw[2][e] = cvt_pk_bf16(p1[2 * e], p1[2 * e + 1]); pw[3][e] = cvt_pk_bf16(p1[8 + 2 * e], p1[8 + 2 * e + 1]); }
    __builtin_amdgcn_sched_barrier(0);
}
__device__ __forceinline__ void attn_pv(const LAS unsigned char* buf, const u32x4 (&pw)[4], f32x16 (&o)[4], const int q, const int hi) {
    bf16x8 vf[4];
    const LAS unsigned char* vq = buf + AT_V + q * 144 + hi * 16;
#define AT_VREAD(i) do { vf[(i) & 3] = *(const LAS bf16x8*)(vq + ((i) >> 2) * (32 * 144) + ((i) & 3) * 32); } while (0)
    AT_VREAD(0); AT_VREAD(1); AT_VREAD(2); AT_VREAD(3);
    __builtin_amdgcn_sched_barrier(0);
#pragma unroll
    for (int i = 0; i < 16; ++i) {
        o[i >> 2] = __builtin_amdgcn_mfma_f32_32x32x16_bf16(__builtin_bit_cast(bf16x8, pw[i & 3]), vf[i & 3], o[i >> 2], 0, 0, 0);
        if (i + 4 < 16) AT_VREAD(i + 4);
        __builtin_amdgcn_sched_barrier(0);
    }
#undef AT_VREAD
}
__device__ __forceinline__ void attn_unit(CParams& P, LAS unsigned char* lds, int b, int h, int qb, int j, float lam, float osc, const int tid) {
    const int lane = tid & 63, w = __builtin_amdgcn_readfirstlane(tid >> 6), q = lane & 31, hi = lane >> 5;
    const bf16_t* Q = (const bf16_t*)(P.ws + WS_QO); bf16_t* O = (bf16_t*)(P.ws + WS_O);
    const bf16_t* Kg = (const bf16_t*)(P.ws + WS_K); const bf16_t* VT = (const bf16_t*)(P.ws + WS_VT);
    float* scr = (float*)(P.ws + WS_ASCR) + (size_t)blockIdx.x * 32768;
    const int NT = 4 * qb + 4, mylast = 4 * qb + (w >> 1);
    const int row0 = b * SEQ + qb * 256 + 32 * w;
    const int kr = tid >> 3, kc = tid & 7;
    const int dv0 = tid >> 3, dv1 = (tid + 512) >> 3;
    const int vko = 32 * (kc >> 1) + 8 * (kc & 1);
    f32x16 o[4];
    for (int c = 0; c < 2; ++c) {
        bf16x8 qf[4];
#pragma unroll
        for (int ds = 0; ds < 4; ++ds) qf[ds] = *(const bf16x8*)(Q + (size_t)(row0 + q) * 1024 + h * 128 + c * 64 + 16 * ds + 8 * hi);
#pragma unroll
        for (int d = 0; d < 4; ++d)
#pragma unroll
            for (int r = 0; r < 16; ++r) o[d][r] = 0.f;
        float lsum = 0.f;
        const bf16_t* ksrc = Kg + ((size_t)(b * SEQ + kr)) * 1024 + h * 128 + c * 64 + kc * 8;
        const bf16_t* vsrc0 = VT + ((size_t)((b * 8 + h) * 128 + dv0)) * 4096 + kc * 8;
        const bf16_t* vsrc1 = VT + ((size_t)((b * 8 + h) * 128 + dv1)) * 4096 + kc * 8;
#define AT_LOADSET(S, t) do { rk##S = *(const u32x4*)(ksrc + (size_t)(t) * 65536); rv0##S = *(const u32x4*)(vsrc0 + (t) * 64); rv1##S = *(const u32x4*)(vsrc1 + (t) * 64); } while (0)
#define AT_WRITESET(S, Bp) do { LAS unsigned char* B_ = (Bp); *(LAS u32x4*)(B_ + AT_K + kr * 144 + kc * 16) = rk##S; \
            *(LAS u32x2*)(B_ + AT_V + dv0 * 144 + vko) = (u32x2){rv0##S.x, rv0##S.y}; *(LAS u32x2*)(B_ + AT_V + dv0 * 144 + vko + 16) = (u32x2){rv0##S.z, rv0##S.w}; \
            *(LAS u32x2*)(B_ + AT_V + dv1 * 144 + vko) = (u32x2){rv1##S.x, rv1##S.y}; *(LAS u32x2*)(B_ + AT_V + dv1 * 144 + vko + 16) = (u32x2){rv1##S.z, rv1##S.w}; } while (0)
        u32x4 rkA, rv0A, rv1A, rkB, rv0B, rv1B;
        AT_LOADSET(A, 0); AT_LOADSET(B, 1);
        AT_WRITESET(A, lds);
        LDS_BARRIER();
        u32x4 pw[4];
        int b0 = 0, bm1 = 2 * AT_BUF, bp1 = AT_BUF;
#define AT_HEAD(kt, SL) { const int tn_ = ((kt) + 2 < NT) ? (kt) + 2 : NT - 1; AT_LOADSET(SL, tn_); }
#define AT_TAIL(SW) do { AT_WRITESET(SW, lds + bp1); LDS_BARRIER(); bm1 = b0; b0 = bp1; bp1 = (bp1 == 2 * AT_BUF) ? 0 : bp1 + AT_BUF; } while (0)
        if (w < 4) {
            for (int kt = 0; kt < NT; kt += 2) {
                AT_HEAD(kt, A);
                if (kt <= mylast) { attn_qk(lds + b0, qf, pw, lsum, q, hi); attn_pv(lds + b0, pw, o, q, hi); }
                AT_TAIL(B);
                AT_HEAD(kt + 1, B);
                if (kt + 1 <= mylast) { attn_qk(lds + b0, qf, pw, lsum, q, hi); attn_pv(lds + b0, pw, o, q, hi); }
                AT_TAIL(A); }
        } else {
            for (int kt = 0; kt < NT; kt += 2) {
                AT_HEAD(kt, A);
                if (kt >= 1 && kt - 1 <= mylast) attn_pv(lds + bm1, pw, o, q, hi);
                if (kt <= mylast) attn_qk(lds + b0, qf, pw, lsum, q, hi);
                AT_TAIL(B);
                AT_HEAD(kt + 1, B);
                if (kt <= mylast) attn_pv(lds + bm1, pw, o, q, hi);
                if (kt + 1 <= mylast) attn_qk(lds + b0, qf, pw, lsum, q, hi);
                AT_TAIL(A); }
            if (NT - 1 <= mylast) attn_pv(lds + bm1, pw, o, q, hi);
        }
#undef AT_HEAD
#undef AT_TAIL
#undef AT_LOADSET
#undef AT_WRITESET
        lsum += shx(lsum, 32, lane);
        LAS float* wsf = (LAS float*)(lds + 3 * AT_BUF) + w * 32;
        if (hi == 0) wsf[q] = 1.0f / lsum;
        const LAS float* wl = wsf + 4 * hi;
        float* sp = scr + (size_t)tid * 64;
        if (c == 0) {
#pragma unroll
            for (int r4 = 0; r4 < 4; ++r4) {
                f32x4 li;
#pragma unroll
                for (int e = 0; e < 4; ++e) li[e] = wl[e + 8 * r4];
#pragma unroll
                for (int d = 0; d < 4; ++d) { f32x4 v;
#pragma unroll
                    for (int e = 0; e < 4; ++e) v[e] = o[d][4 * r4 + e] * li[e];
                    *(f32x4*)(sp + d * 16 + 4 * r4) = v; }
            }
        } else {
            const float* gs = P.in[29] + j * 128;
            float gsv[4];
#pragma unroll
            for (int d = 0; d < 4; ++d) gsv[d] = gs[32 * d + q] * osc;
            bf16_t* obase2 = O + (size_t)(row0 + (lane >> 4)) * 1024 + h * 128 + (lane & 15) * 8;
            LAS unsigned char* stg = lds + 84992 + w * 4608;
#pragma unroll
            for (int r4 = 0; r4 < 4; ++r4) {
                f32x4 li, s1[4];
#pragma unroll
                for (int e = 0; e < 4; ++e) li[e] = wl[e + 8 * r4];
#pragma unroll
                for (int d = 0; d < 4; ++d) s1[d] = *(const f32x4*)(sp + d * 16 + 4 * r4);
#pragma unroll
                for (int e = 0; e < 4; ++e) {
                    float df[4]; float sq = 0.f;
#pragma unroll
                    for (int d = 0; d < 4; ++d) { df[d] = s1[d][e] - lam * (o[d][4 * r4 + e] * li[e]); sq += df[d] * df[d]; }
                    sq += shx(sq, 1, lane); sq += shx(sq, 2, lane); sq += shx(sq, 4, lane); sq += shx(sq, 8, lane); sq += shx(sq, 16, lane);
                    const float rinv = __builtin_amdgcn_rsqf(sq * (1.0f / 128.0f) + 1e-5f);
                    LAS unsigned short* sr = (LAS unsigned short*)(stg + ((e + 8 * (r4 & 1) + 4 * hi) * 288) + q * 2);
#pragma unroll
                    for (int d = 0; d < 4; ++d) sr[32 * d] = cvt_bf16(df[d] * rinv * gsv[d]);
                }
                if (r4 & 1) {
                    LDS_WAIT();
#pragma unroll
                    for (int i = 0; i < 4; ++i) {
                        const u32x4 v = *(const LAS u32x4*)(stg + ((lane >> 4) + 4 * i) * 288 + (lane & 15) * 16);
                        bf16_t* op = obase2; asm volatile("" : "+v"(op));
                        *(u32x4*)(op + (size_t)(16 * (r4 >> 1) + 4 * i) * 1024) = v; }
                    LDS_WAIT();
                }
            }
        }
        __syncthreads();
    }
}

#define XB_TMO      128
#define XB_XCNT(j)  (256  + 64 * (j))
#define XB_XSUB(j)  (1280 + 64 * (j))
#define XB_XGEN(j)  (2304 + 64 * (j))
#define XB_TOP      3328
#define XB_TOPGEN   3392
#define XCD_BAR_WORDS 3456
#define XB_SPIN_CAP (1u << 18)

__device__ __forceinline__ unsigned xb_ld(unsigned* p)              { return __hip_atomic_load(p, __ATOMIC_RELAXED, __HIP_MEMORY_SCOPE_AGENT); }
__device__ __forceinline__ unsigned xb_add(unsigned* p, unsigned v) { return __hip_atomic_fetch_add(p, v, __ATOMIC_RELAXED, __HIP_MEMORY_SCOPE_AGENT); }
__device__ __forceinline__ unsigned xb_xcc_id() { return (unsigned)__builtin_amdgcn_s_getreg((3 << 11) | 20) & 0xFu; }
#define XB_SPIN(cond, bar) do { unsigned _sp = 0; while (cond) { __builtin_amdgcn_s_sleep(1); \
    if ((++_sp & 255u) == 0u) { if (xb_ld(&(bar)[XB_TMO])) break; if (_sp > XB_SPIN_CAP) { atomicAdd(&(bar)[XB_TMO], 1u); break; } } } } while (0)

struct XcdBarrier {
    unsigned* bar; unsigned x;
    volatile LAS unsigned* st;
};

__device__ __forceinline__ XcdBarrier xcd_barrier_post(unsigned* bar, volatile LAS unsigned* st) {
    XcdBarrier b; b.bar = bar; b.x = xb_xcc_id(); b.st = st;
    if (threadIdx.x == 0) (void)xb_add(&bar[XB_XCNT(b.x)], 1u);
    return b;
}
__device__ __forceinline__ void xcd_barrier_complete(unsigned* bar, unsigned x, unsigned& nloc, unsigned& nx) {
    const unsigned G = gridDim.x * gridDim.y * gridDim.z;
    unsigned sum, cnt, mine, sp = 0u;
    for (;;) {
        sum = 0u; cnt = 0u; mine = 0u;
#pragma unroll
        for (unsigned j = 0; j < 16; ++j) { const unsigned c = xb_ld(&bar[XB_XCNT(j)]); sum += c; cnt += (c > 0u) ? 1u : 0u; mine = (j == x) ? c : mine; }
        if (sum == G) break;
        __builtin_amdgcn_s_sleep(1);
        if ((++sp & 255u) == 0u) { if (xb_ld(&bar[XB_TMO])) break; if (sp > XB_SPIN_CAP) { atomicAdd(&bar[XB_TMO], 1u); break; } }
    }
    nloc = mine > 0u ? mine : 1u; nx = cnt > 0u ? cnt : 1u;
}

__device__ __forceinline__ void xcd_barrier(const XcdBarrier& b, const bool is_t0) {
    asm volatile("s_waitcnt vmcnt(0)" ::: "memory");
    __syncthreads();
    if (is_t0) {
        unsigned* bar = b.bar;
        __builtin_amdgcn_s_waitcnt(0);
        unsigned nloc = b.st[0], nx = b.st[1];
        if (nloc == 0u) { xcd_barrier_complete(bar, b.x, nloc, nx); b.st[0] = nloc; b.st[1] = nx; }
        const unsigned old = xb_add(&bar[XB_XSUB(b.x)], 1u);
        const unsigned gen = old / nloc;
        if (old + 1u == (gen + 1u) * nloc) {
            __builtin_amdgcn_fence(__ATOMIC_RELEASE, "agent");
            asm volatile("s_waitcnt vmcnt(0)" ::: "memory");
            const unsigned og = xb_add(&bar[XB_TOP], 1u);
            const unsigned tg = og / nx;
            if (og + 1u == (tg + 1u) * nx) xb_add(&bar[XB_TOPGEN], 1u);
            else XB_SPIN(xb_ld(&bar[XB_TOPGEN]) == tg, bar);
            __builtin_amdgcn_fence(__ATOMIC_ACQUIRE, "agent");
            xb_add(&bar[XB_XGEN(b.x)], 1u);
            asm volatile("s_waitcnt vmcnt(0)" ::: "memory");
        } else {
            XB_SPIN(xb_ld(&bar[XB_XGEN(b.x)]) == gen, bar);
            __builtin_amdgcn_fence(__ATOMIC_ACQUIRE, "agent");
            asm volatile("s_waitcnt vmcnt(0)" ::: "memory");
        }
    }
    __syncthreads();
}


__device__ __forceinline__ pg8::RsCache make_rs_cache(LAS unsigned char* lds, const float* ss, int N, const int tid) {
    pg8::StaticOrder S; S.init(MROWS, N, (int)gridDim.x, (int)blockIdx.x); pg8::Unit u0; u0.pm = 0; u0.pn = 0; const bool any = S.next(0, u0);
    LAS float* tab = (LAS float*)(lds + 131072 + 1024);
    if (any && tid < 256) tab[tid] = pg8::row_rs(ss, u0.pm * 256 + tid);
    __syncthreads();
    return pg8::RsCache{tab, any ? u0.pm : -1, ss};
}
template <class Epi> __device__ __forceinline__ void run_gemm(LAS unsigned char* lds, const bf16_t* A, const bf16_t* Bt, int N, int K, const Epi& E, const int tid) {
    pg8::Gemm g{A, Bt, MROWS, N, K}; pg8::StaticOrder S; S.init(MROWS, N, (int)gridDim.x, (int)blockIdx.x);
    pg8::gemm_phase<Epi, pg8::StaticOrder, true, true>(lds, g, S, E, tid);
}
enum { OP_PRO = 0, OP_UP, OP_DOWN, OP_RECIN, OP_SCAN1, OP_SCAN2, OP_RECOUT, OP_KV, OP_QG, OP_ATTN, OP_WO };
constexpr int N_STEPS = 32;

__global__ void __launch_bounds__(NTHREADS) mega_fwd(Params P0) {
    extern __shared__ __attribute__((aligned(16))) unsigned char lds_raw[];
    LAS unsigned char* lds = (LAS unsigned char*)lds_raw;
    cg::grid_group grid = cg::this_grid();
    volatile LAS unsigned* bar_st = (volatile LAS unsigned*)(lds + 131072 + 256);
    if (threadIdx.x < 2) bar_st[threadIdx.x] = 0u;
    __syncthreads();
    XcdBarrier xbar = xcd_barrier_post((unsigned*)(P0.ws + WS_BAR), bar_st);
    const int wave_s = __builtin_amdgcn_readfirstlane(threadIdx.x >> 6);
    auto mk_tid = [&]() -> int { unsigned z = 0u; asm volatile("" : "+v"(z)); return (wave_s << 6) + (int)__builtin_amdgcn_mbcnt_hi(~0u, __builtin_amdgcn_mbcnt_lo(~0u, z)); };
#define MK_TID() mk_tid()
    const int G = gridDim.x, bx = blockIdx.x, vcu = (G % 8 == 0) ? (bx % 8) * (G / 8) + bx / 8 : bx;
    for (int st = P0.ph_lo; st < P0.ph_hi; ++st) {
        int op, layer = 0, f = 0;
        if (st == 0) op = OP_PRO;
        else if (st <= 16) { const int k = (st - 1) & 7; layer = (st - 1) >> 3; f = layer * 2 + (k >= 6);
            op = (k == 0 || k == 6) ? OP_UP : (k == 1 || k == 7) ? OP_DOWN : (k == 2) ? OP_RECIN : (k == 3) ? OP_SCAN1 : (k == 4) ? OP_SCAN2 : OP_RECOUT; }
        else if (st == 17) { op = OP_KV; layer = 2; }
        else { const int q = st - 18, k = q % 7; layer = 2 + q / 7; f = layer * 2 + (k >= 5);
            op = (k == 0 || k == 5) ? OP_UP : (k == 1 || k == 6) ? OP_DOWN : (k == 2) ? OP_QG : (k == 3) ? OP_ATTN : OP_WO; }
        if (st > P0.ph_lo && st != 18) { if (P0.rep_mask & 0x4000) grid.sync(); else xcd_barrier(xbar, MK_TID() == 0); if (P0.rep_mask & 0x8000) { xcd_barrier(xbar, MK_TID() == 0); xcd_barrier(xbar, MK_TID() == 0); } }
        const int a = layer, jl = layer - 2;
#ifndef OPMASK
#define OPMASK 0xFFFF
#endif
#define HAS(o) ((OPMASK >> (o)) & 1)
#ifndef PROBE_REP_MASK
#define PROBE_REP_MASK 0
#endif
        const int nrep = ((P0.rep_mask >> op) & 1) ? 2 : 1;
        for (int rep = 0; rep < nrep; ++rep) {
        if (rep) xcd_barrier(xbar, MK_TID() == 0);
        int tid = MK_TID(); asm volatile("" : "+v"(tid));
        CParams* Pp = (CParams*)__builtin_amdgcn_kernarg_segment_ptr(); asm volatile("" : "+s"(Pp)); CParams& P = *Pp;
        unsigned char* ws = P.ws; asm volatile("" : "+s"(ws));
        bf16_t* XB = (bf16_t*)(ws + WS_XB); float* ss = (float*)(ws + WS_SS); bf16_t* HB = (bf16_t*)(ws + WS_H);
        switch (op) {
        case OP_PRO: if (HAS(0)) prologue(P, lds, vcu, G, tid); break;
        case OP_UP: if (HAS(1)) { pg8::EpiSwiglu E{HB, make_rs_cache(lds, ss, 5632, tid)}; run_gemm(lds, XB, (const bf16_t*)(ws + WS_W + (size_t)f * W_FFN_STRIDE), 5632, 1024, E, tid);
            if (f < 7 && G == 256 && rep == 0) {
                if (bx >= 128) { const int lane = tid & 63, wave = __builtin_amdgcn_readfirstlane(tid >> 6); LAS float* scr = (LAS float*)(lds + wave * 16384);
                    for (int it = (bx - 128) * NWAVES + wave; it < 4224; it += 128 * NWAVES) ffn_item(P, f + 1, it, scr, lane); }
            } else if (f < 7 && rep == 0) { const int lane = tid & 63, wave = __builtin_amdgcn_readfirstlane(tid >> 6); LAS float* scr = (LAS float*)(lds + wave * 16384);
                for (int it = vcu * NWAVES + wave; it < 4224; it += G * NWAVES) ffn_item(P, f + 1, it, scr, lane); }
        } break;
        case OP_DOWN: case OP_RECOUT: case OP_WO: if (HAS(2)) {
            const bf16_t* A = (op == OP_DOWN) ? HB : (op == OP_RECOUT) ? (const bf16_t*)(ws + WS_Y) : (const bf16_t*)(ws + WS_O);
            const bf16_t* Bt = (op == OP_DOWN) ? (const bf16_t*)(ws + WS_W + (size_t)f * W_FFN_STRIDE + W_FFN_DN) : (op == OP_RECOUT) ? (const bf16_t*)(ws + W_REC + (size_t)a * W_REC_STRIDE + W_REC_OUT) : (const bf16_t*)(ws + W_O + (size_t)jl * 2 * MiB);
            pg8::EpiResid E{(st == N_STEPS - 1) ? P.out : nullptr, XB, (unsigned char*)(ws + WS_XL), ss, (op == OP_DOWN) ? 0.5f : 1.0f}; run_gemm(lds, A, Bt, 1024, (op == OP_DOWN) ? 2816 : 1024, E, tid); } break;
        case OP_RECIN: if (HAS(3)) { pg8::EpiRecIn E{(bf16_t*)(ws + WS_GG), (bf16_t*)(ws + WS_REC), make_rs_cache(lds, ss, 2048, tid)}; run_gemm(lds, XB, (const bf16_t*)(ws + W_REC + (size_t)a * W_REC_STRIDE), 2048, 1024, E, tid); } break;
        case OP_SCAN1: if (HAS(4)) for (int u = vcu; u < 256; u += G) scan_unit<1>(P, lds, a, u >> 6, (u >> 3) & 7, u & 7, tid); break;
        case OP_SCAN2: if (HAS(5)) for (int u = vcu; u < 256; u += G) scan_unit<2>(P, lds, a, u >> 6, (u >> 3) & 7, u & 7, tid); break;
        case OP_KV: case OP_QG: if (HAS(7)) {
            const bool kv = (op == OP_KV);
            pg8::EpiQK E{kv ? (bf16_t*)(ws + WS_K) : (bf16_t*)(ws + WS_QO), (bf16_t*)(ws + WS_VT), make_rs_cache(lds, ss, kv ? 2048 : 1024, tid), kv ? P.in[22] : P.in[26] + jl * 64, (const float*)(ws + WS_COS), (const float*)(ws + WS_SIN), kv ? 1.0f : 0.125f * 1.4426950408889634f};
            run_gemm(lds, XB, kv ? (const bf16_t*)(ws + W_KV) : (const bf16_t*)(ws + W_Q + (size_t)jl * 2 * MiB), kv ? 2048 : 1024, 1024, E, tid); } break;
        case OP_ATTN: if (HAS(9)) {
            const int lane = tid & 63;
            const float q1 = P.in[27][jl * 64 + lane], q2 = P.in[28][jl * 64 + lane], k1 = P.in[23][lane], k2 = P.in[24][lane];
            const float linit = jl ? P.linit[1] : P.linit[0];
            const float lam = __uint_as_float(__builtin_amdgcn_readfirstlane(__float_as_uint(__expf(wave_sum(q1 * k1, lane)) - __expf(wave_sum(q2 * k2, lane)) + linit)));
            for (int pr = vcu; pr < 256; pr += G) { const int bh = pr >> 3, s = pr & 7;
                attn_unit(P, lds, bh >> 3, bh & 7, 15 - s, jl, lam, 1.0f - linit, tid);
                attn_unit(P, lds, bh >> 3, bh & 7, s, jl, lam, 1.0f - linit, tid); }
        } break;
        }
        }
    }
}

#ifndef MK_PER_STEP
#define MK_PER_STEP 0
#endif
extern "C" void kernel_launch(void* const* d_in, const int* in_sizes, int n_in, void* d_out, int out_size, void* d_ws, size_t ws_size, hipStream_t stream) {
    static int grid = 0;
    if (grid == 0) {
        int dev = 0, cus = 0, per_cu = 0;
        if (n_in != 31 || out_size != MROWS * DM || ws_size < WS_END) { fprintf(stderr, "kernel_launch: unexpected shapes (n_in %d out %d ws %zu)\n", n_in, out_size, ws_size); grid = -1; return; }
        hipGetDevice(&dev); hipDeviceGetAttribute(&cus, hipDeviceAttributeMultiprocessorCount, dev);
        hipFuncSetAttribute((const void*)mega_fwd, hipFuncAttributeMaxDynamicSharedMemorySize, LDS_BYTES);
        hipOccupancyMaxActiveBlocksPerMultiprocessor(&per_cu, (const void*)mega_fwd, NTHREADS, LDS_BYTES);
        (void)hipGetLastError();
        if (per_cu < 1) per_cu = 1;
        grid = cus * 1;
        if (grid <= 0) grid = 256;
    }
    if (grid < 0) return;
    Params p{};
    for (int i = 0; i < 31; ++i) p.in[i] = (const float*)d_in[i];
    p.out = (float*)d_out; p.ws = (unsigned char*)d_ws; p.rep_mask = PROBE_REP_MASK;
    p.linit[0] = (float)(0.8 - 0.6 * std::exp(-0.3 * 2.0)); p.linit[1] = (float)(0.8 - 0.6 * std::exp(-0.3 * 3.0));
    for (int i = 0; i < 32; ++i) p.invfreq[i] = std::pow(10000.0, -(double)(2 * i) / 64.0);
    (void)hipMemsetAsync((char*)d_ws + WS_BAR, 0, 16384, stream);
#if MK_PER_STEP
    for (int st = 0; st < N_STEPS; ++st) { p.ph_lo = st; p.ph_hi = st + 1; hipLaunchKernelGGL(mega_fwd, dim3(grid), dim3(NTHREADS), LDS_BYTES, stream, p); }
#else
    p.ph_lo = 0; p.ph_hi = N_STEPS;
    void* args[] = {&p};
    hipError_t e = hipLaunchCooperativeKernel((const void*)mega_fwd, dim3(grid), dim3(NTHREADS), args, LDS_BYTES, stream);
    if (e != hipSuccess) fprintf(stderr, "cooperative launch failed: %s (grid %d)\n", hipGetErrorString(e), grid);
#endif
}
```

```cpp
#include <hip/hip_runtime.h>
#include <hip/hip_cooperative_groups.h>
#include <cstdio>
#include <cstdint>
#include <cmath>
namespace cg = cooperative_groups;
__device__ __forceinline__ float shx(float v, int k, int lane) { return __int_as_float(__builtin_amdgcn_ds_bpermute((lane ^ k) << 2, __float_as_int(v))); }
__device__ __forceinline__ float shl_from(float v, int src) { return __int_as_float(__builtin_amdgcn_ds_bpermute(src << 2, __float_as_int(v))); }
__device__ __forceinline__ unsigned lo4_enc(float x, float hif, unsigned e) { const float inv = (e >= 12u) ? __uint_as_float((265u - e) << 23) : 0.f; float q = rintf((x - hif) * inv) + 8.f; q = fminf(fmaxf(q, 0.f), 15.f); return (unsigned)q; }
__device__ __forceinline__ float lo4_dec(unsigned nib, unsigned e) { const float sc = (e >= 12u) ? __uint_as_float((e - 11u) << 23) : 0.f; return ((float)nib - 8.f) * sc; }
namespace pg8 {
#define PG8_LAS __attribute__((address_space(3)))
typedef unsigned short bf16_t;
typedef short bf16x8 __attribute__((ext_vector_type(8)));
typedef float f32x4 __attribute__((ext_vector_type(4)));
typedef unsigned u32x4 __attribute__((ext_vector_type(4)));
constexpr int BM = 256, BK = 64, HALF = 128, HTB = HALF * BK * 2  , STAGE_BYTES = 8 * HTB, NXCD = 8, WGM = 8;

__host__ __device__ __forceinline__ int lds_byte(int r, int c) { const int st = (r >> 4) * 2 + (c >> 5), rr = r & 15, cc = c & 31, ob = rr * 64 + cc * 2; return st * 1024 + (ob ^ (((ob >> 9) & 1) << 5)); }
__host__ __device__ __forceinline__ void stage_rc(int b, int& R, int& C) { const int st = b / 1024, sb = b % 1024, swz = sb ^ (((sb >> 9) & 1) << 5); R = (st >> 1) * 16 + swz / 64; C = (st & 1) * 32 + (swz % 64) / 2; }
__host__ __device__ __forceinline__ int perm32(int rho) { const int n = rho >> 4, i = rho & 15; return 8 * (i >> 2) + 4 * n + (i & 3); }

struct Unit { int pm, pn; };
struct Gemm { const bf16_t* A; const bf16_t* Bt; int M, N, K; };

struct StaticOrder {
    int nM, nN, nwg, G, c;
    __host__ __device__ void init(int M, int N, int G_, int c_) { nM = M / BM; nN = N / BM; nwg = nM * nN; G = G_; c = c_; }
    __host__ __device__ bool next(int i, Unit& u) const {
        const long L = (long)i * G + c; if (L >= nwg) return false;
        int wgid = (int)L; { const int q = nwg / NXCD, r = nwg % NXCD, xcd = wgid % NXCD, off = wgid / NXCD; wgid = (xcd < r ? xcd * (q + 1) : r * (q + 1) + (xcd - r) * q) + off; }
        const int nig = WGM * nN, gid = wgid / nig, fm = gid * WGM, gsz = (nM - fm) < WGM ? (nM - fm) : WGM;
        u.pm = fm + ((wgid % nig) % gsz); u.pn = (wgid % nig) / gsz; return true;
    }
    __device__ __forceinline__ void a_ready(const Unit&) const {}
    __device__ __forceinline__ void done(const Unit&) const {}
};
typedef unsigned u32x4 __attribute__((ext_vector_type(4)));
__device__ __forceinline__ unsigned cvt_pk_bf16(float lo, float hi) { unsigned r; asm volatile("v_cvt_pk_bf16_f32 %0, %1, %2" : "=v"(r) : "v"(lo), "v"(hi)); return r; }
__device__ __forceinline__ unsigned short cvt_bf16(float v) { return (unsigned short)(cvt_pk_bf16(v, 0.f) & 0xffffu); }
__device__ __forceinline__ u32x4 pack8(const f32x4 a, const f32x4 b) { u32x4 w; w.x = cvt_pk_bf16(a[0], a[1]); w.y = cvt_pk_bf16(a[2], a[3]); w.z = cvt_pk_bf16(b[0], b[1]); w.w = cvt_pk_bf16(b[2], b[3]); return w; }
__device__ __forceinline__ float row_rs(const float* ss, int row) {
    const f32x4* p = (const f32x4*)(ss + (size_t)row * 16);
    const f32x4 a = p[0], b = p[1], c = p[2], d = p[3];
    const float s = (((a[0] + a[1]) + (a[2] + a[3])) + ((b[0] + b[1]) + (b[2] + b[3]))) + (((c[0] + c[1]) + (c[2] + c[3])) + ((d[0] + d[1]) + (d[2] + d[3])));
    return __builtin_amdgcn_rsqf(s * (1.0f / 1024.0f) + 1e-6f);
}
__device__ __forceinline__ float silu_f(float g) { return g * __builtin_amdgcn_rcpf(1.0f + __builtin_amdgcn_exp2f(-1.4426950408889634f * g)); }
__device__ __forceinline__ float gelu_tanh_f(float v) { const float t = 0.7978845608028654f * (v + 0.044715f * v * v * v); return v * __builtin_amdgcn_rcpf(1.0f + __builtin_amdgcn_exp2f(-2.0f * 1.4426950408889634f * t)); }

struct RsCache { const PG8_LAS float* tab; int pm0; const float* ss;
    __device__ __forceinline__ float get(int pm, int lrow) const { return (pm == pm0) ? tab[lrow] : row_rs(ss, pm * BM + lrow); } };
struct EpiSwiglu {
    static constexpr bool PERM = true, AFTER_DRAIN = false;
    bf16_t* H; RsCache rc;
    typedef float f32x2 __attribute__((ext_vector_type(2)));
    static __device__ __forceinline__ f32x2 sw2(f32x2 g, f32x2 u, float c1, float rs2) {
        const f32x2 t = g * c1; f32x2 e; e.x = __builtin_amdgcn_exp2f(t.x); e.y = __builtin_amdgcn_exp2f(t.y);
        const f32x2 d = e + 1.0f; f32x2 r; r.x = __builtin_amdgcn_rcpf(d.x); r.y = __builtin_amdgcn_rcpf(d.y);
        return (g * u) * (r * rs2);
    }
    __device__ __forceinline__ void operator()(const f32x4 (&acc)[2][2][4][2], const Unit& u, int wr, int wc, int fr, int fq) const {
        const int col0 = u.pn * 128 + wc * 32 + 8 * fq;
        float rsv[2][4];
#pragma unroll
        for (int ai = 0; ai < 2; ++ai)
#pragma unroll
            for (int m = 0; m < 4; ++m) rsv[ai][m] = rc.get(u.pm, ai * HALF + wr * 64 + m * 16 + fr);
#pragma unroll
        for (int ai = 0; ai < 2; ++ai)
#pragma unroll
            for (int m = 0; m < 4; ++m) {
                const int row = u.pm * BM + ai * HALF + wr * 64 + m * 16 + fr; const float rs = rsv[ai][m], c1 = -1.4426950408889634f * rs, rs2 = rs * rs;
                const f32x4 g0 = acc[ai][0][m][0], g1 = acc[ai][0][m][1], u0 = acc[ai][1][m][0], u1 = acc[ai][1][m][1];
                const f32x2 a = sw2((f32x2){g0[0], g0[1]}, (f32x2){u0[0], u0[1]}, c1, rs2), b = sw2((f32x2){g0[2], g0[3]}, (f32x2){u0[2], u0[3]}, c1, rs2);
                const f32x2 c = sw2((f32x2){g1[0], g1[1]}, (f32x2){u1[0], u1[1]}, c1, rs2), d = sw2((f32x2){g1[2], g1[3]}, (f32x2){u1[2], u1[3]}, c1, rs2);
                u32x4 w; w.x = cvt_pk_bf16(a.x, a.y); w.y = cvt_pk_bf16(b.x, b.y); w.z = cvt_pk_bf16(c.x, c.y); w.w = cvt_pk_bf16(d.x, d.y);
                *(u32x4*)(H + (size_t)row * 2816 + col0) = w;
            }
    }
};
struct EpiResid {
    static constexpr bool PERM = true, AFTER_DRAIN = false;
    typedef unsigned u32x2 __attribute__((ext_vector_type(2)));
    float* OUT; bf16_t* XB; unsigned char* XL; float* ss; float alpha;
    __device__ __forceinline__ void operator()(const f32x4 (&acc)[2][2][4][2], const Unit& u, int wr, int wc, int fr, int fq) const {
        const int col0 = u.pn * BM + wc * 32 + 8 * fq;
        const size_t off0 = (size_t)(u.pm * BM + wr * 64 + fr) * 1024 + col0;
#pragma unroll
        for (int ai = 0; ai < 2; ++ai) {
            u32x4 hin[4][2]; unsigned lin[4][2];
#pragma unroll
            for (int m = 0; m < 4; ++m)
#pragma unroll
                for (int bj = 0; bj < 2; ++bj) { const size_t o = off0 + (size_t)(ai * HALF + m * 16) * 1024 + bj * HALF; hin[m][bj] = *(const u32x4*)(XB + o); lin[m][bj] = *(const unsigned*)(XL + (o >> 1)); }
            __builtin_amdgcn_sched_barrier(0);
#pragma unroll
            for (int m = 0; m < 4; ++m) {
                const int row = u.pm * BM + ai * HALF + wr * 64 + m * 16 + fr; float sq = 0.f;
#pragma unroll
                for (int bj = 0; bj < 2; ++bj) {
                    const size_t o = off0 + (size_t)(ai * HALF + m * 16) * 1024 + bj * HALF;
                    const u32x4 h = hin[m][bj]; const unsigned l = lin[m][bj];
                    float xv[8];
#pragma unroll
                    for (int k = 0; k < 8; ++k) { const unsigned wd = h[k >> 1]; const float hif = (k & 1) ? __uint_as_float(wd & 0xffff0000u) : __uint_as_float(wd << 16);
                        const unsigned ex = (k & 1) ? ((wd >> 23) & 0xffu) : ((wd >> 7) & 0xffu); const unsigned by = (l >> (4 * k)) & 0xfu;
                        xv[k] = hif + lo4_dec(by, ex) + acc[ai][bj][m][k >> 2][k & 3] * alpha; }
                    const f32x4 x0 = (f32x4){xv[0], xv[1], xv[2], xv[3]}, x1 = (f32x4){xv[4], xv[5], xv[6], xv[7]};
                    if (OUT) { *(f32x4*)(OUT + o) = x0; *(f32x4*)(OUT + o + 4) = x1; }
                    else {
#pragma unroll
                        for (int k = 0; k < 8; ++k) sq += xv[k] * xv[k];
                        const u32x4 hn = pack8(x0, x1);
                        unsigned ln = 0u;
#pragma unroll
                        for (int k = 0; k < 8; ++k) { const unsigned wd = hn[k >> 1]; const float hif = (k & 1) ? __uint_as_float(wd & 0xffff0000u) : __uint_as_float(wd << 16);
                            const unsigned ex = (k & 1) ? ((wd >> 23) & 0xffu) : ((wd >> 7) & 0xffu); ln |= lo4_enc(xv[k], hif, ex) << (4 * k); }
                        *(u32x4*)(XB + o) = hn; *(unsigned*)(XL + (o >> 1)) = ln;
                    }
                }
                if (!OUT) { { const int ln_ = fr + 16 * fq; sq += shx(sq, 16, ln_); sq += shx(sq, 32, ln_); }
                    if (fq == 0) ss[(size_t)row * 16 + u.pn * 4 + wc] = sq; }
            }
        }
    }
};
struct EpiRecIn {
    static constexpr bool PERM = true, AFTER_DRAIN = false;
    bf16_t* GG; bf16_t* REC; RsCache rc;
    __device__ __forceinline__ void operator()(const f32x4 (&acc)[2][2][4][2], const Unit& u, int wr, int wc, int fr, int fq) const {
        const bool isgate = u.pn < 4; bf16_t* dst = isgate ? GG : REC; const int col0 = (u.pn & 3) * BM + wc * 32 + 8 * fq;
#pragma unroll
        for (int ai = 0; ai < 2; ++ai)
#pragma unroll
            for (int m = 0; m < 4; ++m) {
                const int row = u.pm * BM + ai * HALF + wr * 64 + m * 16 + fr; const float rs = rc.get(u.pm, ai * HALF + wr * 64 + m * 16 + fr);
#pragma unroll
                for (int bj = 0; bj < 2; ++bj) {
                    f32x4 v0 = acc[ai][bj][m][0] * rs, v1 = acc[ai][bj][m][1] * rs;
                    if (isgate) {
#pragma unroll
                        for (int j = 0; j < 4; ++j) { v0[j] = gelu_tanh_f(v0[j]); v1[j] = gelu_tanh_f(v1[j]); }
                    }
                    *(u32x4*)(dst + (size_t)row * 1024 + col0 + bj * HALF) = pack8(v0, v1);
                }
            }
    }
};
struct EpiQK {
    static constexpr bool PERM = true, AFTER_DRAIN = false;
    bf16_t* QK; bf16_t* VT; RsCache rc; const float* gain; const float* cosT; const float* sinT; float oscale;
    __device__ __forceinline__ void operator()(const f32x4 (&acc)[2][2][4][2], const Unit& u, int wr, int wc, int fr, int fq) const {
        if (u.pn < 4) {
            const int hh = u.pn * 4 + wc;
            f32x4 glo[2], ghi[2];
#pragma unroll
            for (int n = 0; n < 2; ++n) { glo[n] = *(const f32x4*)(gain + 8 * fq + 4 * n); ghi[n] = *(const f32x4*)(gain + 32 + 8 * fq + 4 * n); }
#pragma unroll
            for (int ai = 0; ai < 2; ++ai)
#pragma unroll
                for (int m = 0; m < 4; ++m) {
                    const int row = u.pm * BM + ai * HALF + wr * 64 + m * 16 + fr; const float rs = rc.get(u.pm, ai * HALF + wr * 64 + m * 16 + fr); const int pos = row & 4095;
                    f32x4 v[2][2]; float sq = 0.f;
#pragma unroll
                    for (int bj = 0; bj < 2; ++bj)
#pragma unroll
                        for (int n = 0; n < 2; ++n) { v[bj][n] = acc[ai][bj][m][n] * rs; const f32x4 t = v[bj][n]; sq += (t[0] * t[0] + t[1] * t[1]) + (t[2] * t[2] + t[3] * t[3]); }
                    { const int ln_ = fr + 16 * fq; sq += shx(sq, 16, ln_); sq += shx(sq, 32, ln_); }
                    const float rinv = __builtin_amdgcn_rsqf(sq * (1.0f / 64.0f) + 1e-6f);
                    f32x4 olo[2], ohi[2];
#pragma unroll
                    for (int n = 0; n < 2; ++n) {
                        const f32x4 c = *(const f32x4*)(cosT + (size_t)pos * 32 + 8 * fq + 4 * n), s = *(const f32x4*)(sinT + (size_t)pos * 32 + 8 * fq + 4 * n);
                        const f32x4 ylo = v[0][n] * rinv * glo[n], yhi = v[1][n] * rinv * ghi[n];
                        olo[n] = (ylo * c - yhi * s) * oscale; ohi[n] = (yhi * c + ylo * s) * oscale;
                    }
                    bf16_t* dp = QK + (size_t)row * 1024 + hh * 64 + 8 * fq;
                    *(u32x4*)dp = pack8(olo[0], olo[1]); *(u32x4*)(dp + 32) = pack8(ohi[0], ohi[1]);
                }
        } else {
#pragma unroll
            for (int ai = 0; ai < 2; ++ai)
#pragma unroll
                for (int m = 0; m < 4; ++m) {
                    const int row = u.pm * BM + ai * HALF + wr * 64 + m * 16 + fr; const float rs = rc.get(u.pm, ai * HALF + wr * 64 + m * 16 + fr); const int b = row >> 12, s = row & 4095;
#pragma unroll
                    for (int bj = 0; bj < 2; ++bj)
#pragma unroll
                        for (int n = 0; n < 2; ++n)
#pragma unroll
                            for (int j = 0; j < 4; ++j) {
                                const int col = (u.pn - 4) * BM + bj * HALF + wc * 32 + 8 * fq + 4 * n + j;
                                VT[((size_t)(b * 1024 + col)) * 4096 + s] = cvt_bf16(acc[ai][bj][m][n][j] * rs);
                            }
                }
        }
    }
};

template <class Epi, class Sched, bool ALIGN_EPI = false, bool SP2 = false>
__device__ __forceinline__ void gemm_phase(PG8_LAS unsigned char* lds, const Gemm g, const Sched& S, const Epi& E, const int tid) {
    const int wid = __builtin_amdgcn_readfirstlane(tid >> 6), lane = tid & 63, wr = wid >> 2, wc = wid & 3, fr = lane & 15, fq = lane >> 4;
    const int K = g.K, nt = K / BK;
    unsigned voffA[2], voffB[2];
#pragma unroll
    for (int i = 0; i < 2; ++i) { int R, C; stage_rc(tid * 16 + i * 8192, R, C); const int Rb = Epi::PERM ? ((R & ~31) + perm32(R & 31)) : R;
        voffA[i] = (unsigned)(R * K + C) * 2u; voffB[i] = (unsigned)(Rb * K + C) * 2u; }
    const size_t kstep = (size_t)(BK * 2);
    const size_t hstep = (size_t)HALF * K * 2;
    const size_t tstep = 2 * hstep;
    const unsigned ldsw = (unsigned)wid * 1024u;
    const int aoff = lds_byte(wr * 64 + fr, fq * 8), boff = lds_byte(wc * 32 + fr, fq * 8);
#define PG8_SA(b, h) (((b) * 2 + (h)) * HTB)
#define PG8_SB(b, h) ((4 + (b) * 2 + (h)) * HTB)
#define PG8_STAGE(bufoff, gbase, voff) do { _Pragma("unroll") for (int _i = 0; _i < 2; ++_i) \
        __builtin_amdgcn_global_load_lds((const unsigned*)((const char*)(gbase) + (voff)[_i]), (PG8_LAS unsigned*)(lds + (bufoff) + ldsw + _i * 8192), 16, 0, 0); } while (0)
#define PG8_LDA(dst, b, h) do { _Pragma("unroll") for (int m = 0; m < 4; ++m) _Pragma("unroll") for (int k = 0; k < 2; ++k) dst[m][k] = *(const PG8_LAS bf16x8*)(lds + PG8_SA(b, h) + aoff + m * 2048 + k * 1024); } while (0)
#define PG8_LDB(dst, b, h) do { _Pragma("unroll") for (int n = 0; n < 2; ++n) _Pragma("unroll") for (int k = 0; k < 2; ++k) dst[n][k] = *(const PG8_LAS bf16x8*)(lds + PG8_SB(b, h) + boff + n * 2048 + k * 1024); } while (0)
#define PG8_MMA(ai, bj, At, Bt) do { __builtin_amdgcn_s_setprio(1); _Pragma("unroll") for (int m = 0; m < 4; ++m) _Pragma("unroll") for (int n = 0; n < 2; ++n) _Pragma("unroll") for (int k = 0; k < 2; ++k) \
        acc[ai][bj][m][n] = __builtin_amdgcn_mfma_f32_16x16x32_bf16(Bt[n][k], At[m][k], acc[ai][bj][m][n], 0, 0, 0); __builtin_amdgcn_s_setprio(0); } while (0)
#define PG8_WAIT_V(n) asm volatile("s_waitcnt vmcnt(" #n ")" ::: "memory")
#define PG8_WAIT_L(n) asm volatile("s_waitcnt lgkmcnt(" #n ")" ::: "memory")
#define PG8_BAR __builtin_amdgcn_s_barrier()
#define PG8_SCHED __builtin_amdgcn_sched_barrier(0)
    Unit cur, nxt; int ui = 0;
    if (!S.next(0, cur)) return;
    f32x4 acc[2][2][4][2];
#pragma unroll
    for (int a = 0; a < 2; ++a)
#pragma unroll
        for (int b = 0; b < 2; ++b)
#pragma unroll
            for (int m = 0; m < 4; ++m)
#pragma unroll
                for (int n = 0; n < 2; ++n) acc[a][b][m][n] = (f32x4){0.f, 0.f, 0.f, 0.f};
    bf16x8 At[4][2], B0[2][2], B1[2][2];
    const char* cA = (const char*)g.A + (size_t)cur.pm * tstep; const char* cB = (const char*)g.Bt + (size_t)cur.pn * tstep;
    S.a_ready(cur);
    if constexpr (SP2) {
        PG8_STAGE(PG8_SB(0, 0), cB, voffB); PG8_STAGE(PG8_SB(0, 1), cB + hstep, voffB); PG8_STAGE(PG8_SA(0, 0), cA, voffA); PG8_STAGE(PG8_SA(0, 1), cA + hstep, voffA);
        if (wr == 1) PG8_BAR;
        PG8_WAIT_V(2); PG8_BAR;
        PG8_STAGE(PG8_SB(1, 0), cB + kstep, voffB); PG8_STAGE(PG8_SA(1, 0), cA + kstep, voffA); PG8_STAGE(PG8_SB(1, 1), cB + hstep + kstep, voffB);
        PG8_WAIT_V(6); PG8_BAR;
    } else {
        PG8_STAGE(PG8_SB(0, 0), cB, voffB); PG8_STAGE(PG8_SA(0, 0), cA, voffA); PG8_STAGE(PG8_SB(0, 1), cB + hstep, voffB); PG8_STAGE(PG8_SA(0, 1), cA + hstep, voffA);
        if (wr == 1) PG8_BAR;
        PG8_WAIT_V(4); PG8_BAR;
        PG8_STAGE(PG8_SB(1, 0), cB + kstep, voffB); PG8_STAGE(PG8_SA(1, 0), cA + kstep, voffA); PG8_STAGE(PG8_SB(1, 1), cB + hstep + kstep, voffB);
        PG8_WAIT_V(6); PG8_BAR;
    }
    for (;;) {
        const bool has_next = S.next(ui + 1, nxt);
        const char* nA = has_next ? (const char*)g.A + (size_t)nxt.pm * tstep : cA; const char* nB = has_next ? (const char*)g.Bt + (size_t)nxt.pn * tstep : cB;
        for (int t = 0; t < nt; t += 2) {
            const bool last = (t == nt - 2);
            const char* a1 = cA + (size_t)(t + 1) * kstep;
            const char* a2 = last ? nA : cA + (size_t)(t + 2) * kstep; const char* b2 = last ? nB : cB + (size_t)(t + 2) * kstep;
            const char* a3 = a2 + kstep; const char* b3 = b2 + kstep;
            if (last && has_next) S.a_ready(nxt);
            if constexpr (SP2) {
            PG8_LDB(B0, 0, 0); PG8_LDB(B1, 0, 1); PG8_SCHED; PG8_LDA(At, 0, 0); PG8_STAGE(PG8_SA(1, 1), a1 + hstep, voffA);
            PG8_WAIT_V(8); PG8_WAIT_L(0); PG8_BAR; PG8_MMA(0, 0, At, B0); PG8_MMA(0, 1, At, B1); PG8_BAR; PG8_SCHED;
            PG8_LDA(At, 0, 1); PG8_STAGE(PG8_SB(0, 0), b2, voffB); PG8_STAGE(PG8_SB(0, 1), b2 + hstep, voffB); PG8_STAGE(PG8_SA(0, 0), a2, voffA);
            PG8_WAIT_V(8); PG8_WAIT_L(0); PG8_BAR; PG8_MMA(1, 0, At, B0); PG8_MMA(1, 1, At, B1); PG8_BAR; PG8_SCHED;
            PG8_LDB(B0, 1, 0); PG8_LDB(B1, 1, 1); PG8_SCHED; PG8_LDA(At, 1, 0); PG8_STAGE(PG8_SA(0, 1), a2 + hstep, voffA);
            PG8_WAIT_V(8); PG8_WAIT_L(0); PG8_BAR; PG8_MMA(0, 0, At, B0); PG8_MMA(0, 1, At, B1); PG8_BAR; PG8_SCHED;
            PG8_LDA(At, 1, 1); PG8_STAGE(PG8_SB(1, 0), b3, voffB); PG8_STAGE(PG8_SB(1, 1), b3 + hstep, voffB); PG8_STAGE(PG8_SA(1, 0), a3, voffA);
            PG8_WAIT_V(8); PG8_WAIT_L(0); PG8_BAR; PG8_MMA(1, 0, At, B0); PG8_MMA(1, 1, At, B1); PG8_BAR; PG8_SCHED;
            } else {
            PG8_LDB(B0, 0, 0); PG8_SCHED; PG8_LDA(At, 0, 0); PG8_STAGE(PG8_SA(1, 1), a1 + hstep, voffA);
            PG8_WAIT_L(8); PG8_BAR; PG8_WAIT_L(0); PG8_MMA(0, 0, At, B0); PG8_BAR; PG8_SCHED;
            PG8_LDB(B1, 0, 1); PG8_STAGE(PG8_SB(0, 0), b2, voffB);
            PG8_BAR; PG8_WAIT_L(0); PG8_MMA(0, 1, At, B1); PG8_BAR;
            PG8_LDA(At, 0, 1); PG8_STAGE(PG8_SA(0, 0), a2, voffA);
            PG8_BAR; PG8_WAIT_L(0); PG8_MMA(1, 0, At, B0); PG8_BAR; PG8_SCHED;
            PG8_STAGE(PG8_SB(0, 1), b2 + hstep, voffB);
            PG8_WAIT_V(6); PG8_BAR; PG8_MMA(1, 1, At, B1); PG8_BAR;
            PG8_LDB(B0, 1, 0); PG8_SCHED; PG8_LDA(At, 1, 0); PG8_STAGE(PG8_SA(0, 1), a2 + hstep, voffA);
            PG8_WAIT_L(8); PG8_BAR; PG8_WAIT_L(0); PG8_MMA(0, 0, At, B0); PG8_BAR; PG8_SCHED;
            PG8_LDB(B1, 1, 1); PG8_STAGE(PG8_SB(1, 0), b3, voffB);
            PG8_BAR; PG8_WAIT_L(0); PG8_MMA(0, 1, At, B1); PG8_BAR;
            PG8_LDA(At, 1, 1); PG8_STAGE(PG8_SA(1, 0), a3, voffA);
            PG8_BAR; PG8_WAIT_L(0); PG8_MMA(1, 0, At, B0); PG8_BAR; PG8_SCHED;
            PG8_STAGE(PG8_SB(1, 1), b3 + hstep, voffB);
            PG8_WAIT_V(6); PG8_BAR; PG8_MMA(1, 1, At, B1); PG8_BAR;
            }
        }
        if constexpr (ALIGN_EPI) { if (wr == 0) PG8_BAR; }
        if constexpr (!Epi::AFTER_DRAIN) { E(acc, cur, wr, wc, fr, fq); S.done(cur); }
        if (!has_next) break;
#pragma unroll
        for (int a = 0; a < 2; ++a)
#pragma unroll
            for (int b = 0; b < 2; ++b)
#pragma unroll
                for (int m = 0; m < 4; ++m)
#pragma unroll
                    for (int n = 0; n < 2; ++n) acc[a][b][m][n] = (f32x4){0.f, 0.f, 0.f, 0.f};
        cur = nxt; cA = nA; cB = nB; ++ui;
        if constexpr (ALIGN_EPI) { if (wr == 1) PG8_BAR; }
    }
    PG8_WAIT_V(0);
    if constexpr (!ALIGN_EPI) { if (wr == 0) PG8_BAR; }
    PG8_BAR;
    if constexpr (Epi::AFTER_DRAIN) { E.fused(acc, cur, wr, wc, fr, fq, lds, wid, lane); S.done(cur); }
#undef PG8_SA
#undef PG8_SB
#undef PG8_STAGE
#undef PG8_LDA
#undef PG8_LDB
#undef PG8_MMA
#undef PG8_WAIT_V
#undef PG8_WAIT_L
#undef PG8_BAR
#undef PG8_SCHED
}
}
#define LAS __attribute__((address_space(3)))
typedef unsigned short bf16_t;
typedef short bf16x8 __attribute__((ext_vector_type(8)));
typedef short s16x4 __attribute__((ext_vector_type(4)));
typedef float f32x4 __attribute__((ext_vector_type(4)));
typedef float f32x16 __attribute__((ext_vector_type(16)));
typedef unsigned u32x4 __attribute__((ext_vector_type(4)));
typedef unsigned u32x2 __attribute__((ext_vector_type(2)));
using pg8::cvt_pk_bf16; using pg8::cvt_bf16; using pg8::pack8;

constexpr int BATCH = 4, SEQ = 4096, DM = 1024, MROWS = BATCH * SEQ, FF = 2816;
constexpr int NTHREADS = 512, NWAVES = 8;
constexpr int LDS_BYTES = 147456;
constexpr size_t MiB = 1u << 20;
constexpr size_t WS_SS = 0;
constexpr size_t WS_COS = 1 * MiB, WS_SIN = 1 * MiB + 512 * 1024;
constexpr size_t WS_SPAN = 2 * MiB;
constexpr size_t WS_BAR = 3 * MiB;
constexpr size_t WS_W = 4 * MiB;
constexpr size_t W_FFN_STRIDE = 17301504, W_FFN_DN = 11534336;
constexpr size_t W_REC = WS_W + 132 * MiB, W_REC_STRIDE = 6 * MiB + 512 * 1024, W_REC_G = 4 * MiB, W_REC_OUT = 4 * MiB + 512 * 1024;
constexpr size_t W_KV = WS_W + 145 * MiB, W_Q = WS_W + 149 * MiB, W_O = WS_W + 153 * MiB;
constexpr size_t WS_XB = 162 * MiB, WS_K = 194 * MiB, WS_VT = 226 * MiB, WS_H = 258 * MiB;
constexpr size_t WS_GG = WS_H, WS_REC = WS_H + 32 * MiB, WS_Y = WS_K;
constexpr size_t WS_QO = WS_H, WS_ASCR = WS_H + 32 * MiB;
constexpr size_t WS_O = WS_W;
constexpr size_t WS_XL = 346 * MiB;
constexpr size_t WS_END = 378 * MiB;

struct Params { const float* in[31]; float* out; unsigned char* ws; double invfreq[32]; float linit[2]; int ph_lo, ph_hi, rep_mask, pad; };
typedef const __attribute__((address_space(4))) Params CParams;

__device__ __forceinline__ float wave_sum(float v, int lane) {
#pragma unroll
    for (int o = 1; o < 64; o <<= 1) v += shx(v, o, lane);
    return v;
}
#define LDS_WAIT() asm volatile("s_waitcnt lgkmcnt(0)" ::: "memory")
#define LDS_BARRIER() asm volatile("s_waitcnt lgkmcnt(0)\n\ts_barrier" ::: "memory")

__device__ __forceinline__ void tr_item(const float* W, int ldw, const float* gain, bf16_t* WT, int K, int drow0, int k0, int n0, LAS float* scr, int lane) {
    float tv[32];
    const float* wp = W + (size_t)(k0 + (lane >> 5)) * ldw + n0 + (lane & 31);
#pragma unroll
    for (int i = 0; i < 32; ++i) tv[i] = __builtin_nontemporal_load(wp + (size_t)(2 * i) * ldw);
    if (gain) {
#pragma unroll
        for (int i = 0; i < 32; ++i) tv[i] *= gain[k0 + 2 * i + (lane >> 5)];
    }
#pragma unroll
    for (int i = 0; i < 32; ++i) scr[(2 * i + (lane >> 5)) * 33 + (lane & 31)] = tv[i];
    LDS_WAIT(); asm volatile("" ::: "memory");
    const int c = lane & 7;
#pragma unroll
    for (int j = 0; j < 4; ++j) { const int n = (lane >> 3) + 8 * j; const LAS float* s = scr + (8 * c) * 33 + n;
        u32x4 o; o.x = cvt_pk_bf16(s[0 * 33], s[1 * 33]); o.y = cvt_pk_bf16(s[2 * 33], s[3 * 33]); o.z = cvt_pk_bf16(s[4 * 33], s[5 * 33]); o.w = cvt_pk_bf16(s[6 * 33], s[7 * 33]);
        *(u32x4*)(WT + (size_t)(drow0 + n) * K + k0 + 8 * c) = o; }
    LDS_WAIT(); asm volatile("" ::: "memory");
}
__device__ __forceinline__ int headperm_row0(int n0) { const int sb = n0 >> 5, pn = sb >> 3, rem = sb & 7, wc = rem >> 1, bj = rem & 1; return pn * 256 + bj * 128 + wc * 32; }

__device__ __forceinline__ void prologue_item(CParams& P, int it, LAS float* scr, int lane) {
    unsigned char* ws = P.ws;
    if (it < 16 * 1408) {
        const int mi = it / 1408, r = it % 1408, f = mi >> 1, gu = mi & 1, layer = f >> 1, which = f & 1;
        const float* W = (which ? (gu ? P.in[7] : P.in[6]) : (gu ? P.in[3] : P.in[2])) + (size_t)layer * 1024 * 2816;
        const float* g = (which ? P.in[5] : P.in[1]) + layer * 1024;
        const int kb = r / 88, nb = r % 88, n0 = nb * 32;
        tr_item(W, 2816, g, (bf16_t*)(ws + WS_W + (size_t)f * W_FFN_STRIDE), 1024, (n0 >> 7) * 256 + (n0 & 127) + gu * 128, kb * 64, n0, scr, lane); return; }
    it -= 16 * 1408;
    if (it < 8 * 1408) {
        const int f = it / 1408, r = it % 1408, layer = f >> 1, which = f & 1;
        const float* W = (which ? P.in[8] : P.in[4]) + (size_t)layer * 2816 * 1024;
        const int kb = r / 32, nb = r % 32;
        tr_item(W, 1024, nullptr, (bf16_t*)(ws + WS_W + (size_t)f * W_FFN_STRIDE + W_FFN_DN), 2816, nb * 32, kb * 64, nb * 32, scr, lane); return; }
    it -= 8 * 1408;
    if (it < 2 * 1024) {
        const int a = it / 1024, r = it % 1024, kb = r / 64, nb = r % 64;
        tr_item(P.in[10] + (size_t)a * 1024 * 2048, 2048, P.in[9] + a * 1024, (bf16_t*)(ws + W_REC + (size_t)a * W_REC_STRIDE), 1024, nb * 32, kb * 64, nb * 32, scr, lane); return; }
    it -= 2 * 1024;
    if (it < 256) {
        const int mi = it / 8, r = it % 8, a = mi >> 4, g = (mi >> 3) & 1, blk = mi & 7, kb = r / 4, nb = r % 4;
        const float* W = (g ? P.in[15] : P.in[13]) + (size_t)(a * 8 + blk) * 128 * 128;
        tr_item(W, 128, nullptr, (bf16_t*)(ws + W_REC + (size_t)a * W_REC_STRIDE + W_REC_G) + (size_t)(blk * 2 + g) * 128 * 128, 128, nb * 32, kb * 64, nb * 32, scr, lane); return; }
    it -= 256;
    if (it < 2 * 512) {
        const int a = it / 512, r = it % 512, kb = r / 32, nb = r % 32;
        tr_item(P.in[18] + (size_t)a * 1024 * 1024, 1024, nullptr, (bf16_t*)(ws + W_REC + (size_t)a * W_REC_STRIDE + W_REC_OUT), 1024, nb * 32, kb * 64, nb * 32, scr, lane); return; }
    it -= 2 * 512;
    if (it < 2 * 512) {
        const int v = it / 512, r = it % 512, kb = r / 32, nb = r % 32, n0 = nb * 32;
        tr_item(v ? P.in[21] : P.in[20], 1024, P.in[19], (bf16_t*)(ws + W_KV), 1024, v ? 1024 + n0 : headperm_row0(n0), kb * 64, n0, scr, lane); return; }
    it -= 2 * 512;
    if (it < 2 * 512) {
        const int j = it / 512, r = it % 512, kb = r / 32, nb = r % 32, n0 = nb * 32;
        tr_item(P.in[25] + (size_t)j * 1024 * 1024, 1024, P.in[9] + (2 + j) * 1024, (bf16_t*)(ws + W_Q + (size_t)j * 2 * MiB), 1024, headperm_row0(n0), kb * 64, n0, scr, lane); return; }
    it -= 2 * 512;
    {
        const int j = it / 512, r = it % 512, kb = r / 32, nb = r % 32;
        tr_item(P.in[30] + (size_t)j * 1024 * 1024, 1024, nullptr, (bf16_t*)(ws + W_O + (size_t)j * 2 * MiB), 1024, nb * 32, kb * 64, nb * 32, scr, lane); }
}
__device__ __forceinline__ void ffn_item(CParams& P, int f, int j, LAS float* scr, int lane) { prologue_item(P, (j < 2816) ? f * 2816 + j : 16 * 1408 + f * 1408 + (j - 2816), scr, lane); }
constexpr int N_PRO_ITEMS = 16 * 1408 + 8 * 1408 + 2 * 1024 + 256 + 2 * 512 + 2 * 512 + 2 * 512 + 2 * 512;

__device__ __forceinline__ void prologue(CParams& P, LAS unsigned char* lds, int vcu, int G, const int tid) {
    const int lane = tid & 63, wave = __builtin_amdgcn_readfirstlane(tid >> 6);
    LAS float* scr = (LAS float*)(lds + wave * 16384);
    const int gw = vcu * NWAVES + wave, NGW = G * NWAVES;
    for (int it = gw; it < 4224 + (N_PRO_ITEMS - 24 * 1408); it += NGW) { if (it < 4224) ffn_item(P, 0, it, scr, lane); else prologue_item(P, 24 * 1408 + (it - 4224), scr, lane); }
    const float* x = P.in[0]; bf16_t* XB = (bf16_t*)(P.ws + WS_XB); unsigned char* XL = (unsigned char*)(P.ws + WS_XL); float* ss = (float*)(P.ws + WS_SS);
    for (int m = gw; m < MROWS; m += NGW) {
        const f32x4* xr = (const f32x4*)(x + (size_t)m * DM) + lane; u32x2* bo = (u32x2*)(XB + (size_t)m * DM) + lane; unsigned short* lo = (unsigned short*)(XL + (size_t)m * (DM / 2)) + lane;
        float s = 0.f;
#pragma unroll
        for (int j = 0; j < 4; ++j) { const f32x4 v = xr[64 * j]; s += (v[0] * v[0] + v[1] * v[1]) + (v[2] * v[2] + v[3] * v[3]);
            u32x2 w; w.x = cvt_pk_bf16(v[0], v[1]); w.y = cvt_pk_bf16(v[2], v[3]); bo[64 * j] = w;
            const unsigned q0 = lo4_enc(v[0], __uint_as_float(w.x << 16), (w.x >> 7) & 0xffu), q1 = lo4_enc(v[1], __uint_as_float(w.x & 0xffff0000u), (w.x >> 23) & 0xffu);
            const unsigned q2 = lo4_enc(v[2], __uint_as_float(w.y << 16), (w.y >> 7) & 0xffu), q3 = lo4_enc(v[3], __uint_as_float(w.y & 0xffff0000u), (w.y >> 23) & 0xffu);
            lo[64 * j] = (unsigned short)(q0 | (q1 << 4) | (q2 << 8) | (q3 << 12)); }
        s = wave_sum(s, lane);
        if (lane < 16) ss[(size_t)m * 16 + lane] = (lane == 0) ? s : 0.f;
    }
    float* cosT = (float*)(P.ws + WS_COS); float* sinT = (float*)(P.ws + WS_SIN);
    for (int idx = vcu * NTHREADS + tid; idx < SEQ * 32; idx += G * NTHREADS) {
        const int pos = idx >> 5, i = idx & 31; double f = 0.0;
#pragma unroll
        for (int k = 0; k < 32; ++k) f = (i == k) ? P.invfreq[k] : f;
        const double ang = (double)pos * f; const double kq = __builtin_rint(ang * 0.63661977236758134308); const double r = ang - kq * 1.57079632679489661923;
        const float rf = (float)r, rr = rf * rf;
        const float sr = rf * (1.0f + rr * (-1.6666667e-1f + rr * (8.3333333e-3f + rr * (-1.9841270e-4f + rr * 2.7557319e-6f))));
        const float cr = 1.0f + rr * (-0.5f + rr * (4.1666667e-2f + rr * (-1.3888889e-3f + rr * (2.4801587e-5f + rr * -2.7557319e-7f))));
        const int q = ((int)kq) & 3; const float sv = (q == 0) ? sr : (q == 1) ? cr : (q == 2) ? -sr : -cr; const float cv = (q == 0) ? cr : (q == 1) ? -sr : (q == 2) ? -cr : sr;
        cosT[idx] = cv; sinT[idx] = sv;
    }
}

constexpr int SC_XA = 0, SC_X32 = 17408, SC_BUF = 51200;
__device__ __forceinline__ int sc_rho(int t) { return 16 * ((t >> 2) & 3) + 4 * (t >> 4) + (t & 3); }
__device__ __forceinline__ float bf_lo(unsigned u) { return __uint_as_float(u << 16); }
__device__ __forceinline__ float bf_hi(unsigned u) { return __uint_as_float(u & 0xffff0000u); }
template <int PASS> __device__ __forceinline__ void scan_unit(CParams& P, LAS unsigned char* lds, int a, int b, int n, int sp, const int tid) {
    const int lane = tid & 63, w = __builtin_amdgcn_readfirstlane(tid >> 6), chl = lane & 15, fq = lane >> 4;
    const int ch = 128 * n + 16 * w + chl;
    const bf16_t* REC = (const bf16_t*)(P.ws + WS_REC); const bf16_t* GG = (const bf16_t*)(P.ws + WS_GG); bf16_t* Y = (bf16_t*)(P.ws + WS_Y);
    const bf16_t* GW = (const bf16_t*)(P.ws + W_REC + (size_t)a * W_REC_STRIDE + W_REC_G);
    float* spanA = (float*)(P.ws + WS_SPAN); float* spanH = spanA + BATCH * 8 * 1024;
    bf16x8 bfa[4], bfx[4];
#pragma unroll
    for (int ks = 0; ks < 4; ++ks) { bfa[ks] = *(const bf16x8*)(GW + ((size_t)(n * 2 + 0) * 128 + 16 * w + chl) * 128 + 32 * ks + 8 * fq); bfx[ks] = *(const bf16x8*)(GW + ((size_t)(n * 2 + 1) * 128 + 16 * w + chl) * 128 + 32 * ks + 8 * fq); }
    const float ba = P.in[14][a * 1024 + ch], bxb = P.in[16][a * 1024 + ch];
    const float lamv = P.in[17][a * 1024 + ch];
    const float c8 = -8.0f * log1pf(__expf(-lamv));
    float hc = 0.f, Asp = 1.f;
    if (PASS == 2) {
        float A2[7], H2[7];
#pragma unroll
        for (int s2 = 0; s2 < 7; ++s2) { A2[s2] = spanA[(size_t)(b * 8 + s2) * 1024 + ch]; H2[s2] = spanH[(size_t)(b * 8 + s2) * 1024 + ch]; }
#pragma unroll
        for (int s2 = 0; s2 < 7; ++s2) hc = (s2 < sp) ? (A2[s2] * hc + H2[s2]) : hc;
    }
    const int tp = tid >> 4, cg8 = tid & 15;
    const int rho0 = sc_rho(2 * tp), rho1 = sc_rho(2 * tp + 1);
    const float* cwp = P.in[11] + (size_t)a * 4 * 1024 + 128 * n + 8 * cg8; const float* cbp = P.in[12] + a * 1024 + 128 * n + 8 * cg8;
    const bf16_t* rbase = REC + ((size_t)(b * SEQ + sp * 512 + 2 * tp)) * 1024 + 128 * n + 8 * cg8;
    const bf16_t* gbase = GG + ((size_t)(b * SEQ + sp * 512 + 2 * tp)) * 1024 + 128 * n + 8 * cg8;
    bf16_t* ybase = Y + ((size_t)(b * SEQ + sp * 512 + 2 * tp)) * 1024 + 128 * n + 8 * cg8;
    f32x4 cwa[4], cwb[4];
#pragma unroll
    for (int k = 0; k < 4; ++k) { cwa[k] = *(const f32x4*)(cwp + k * 1024); cwb[k] = *(const f32x4*)(cwp + k * 1024 + 4); }
    const f32x4 cb0 = *(const f32x4*)cbp, cb1 = *(const f32x4*)(cbp + 4);
    u32x4 R[5], G0 = (u32x4){0u, 0u, 0u, 0u}, G1 = (u32x4){0u, 0u, 0u, 0u};
#define SC_LOAD(ci_) do { _Pragma("unroll") for (int k = 0; k < 5; ++k) { const int pos = sp * 512 + (ci_) * 64 + 2 * tp - 3 + k; R[k] = (u32x4){0u, 0u, 0u, 0u}; \
            if (pos >= 0) R[k] = *(const u32x4*)(rbase + ((ci_) * 64 - 3 + k) * 1024); } \
        if (PASS == 2) { G0 = *(const u32x4*)(gbase + (ci_) * 64 * 1024); G1 = *(const u32x4*)(gbase + ((ci_) * 64 + 1) * 1024); } } while (0)
    SC_LOAD(0);
    for (int ci = 0; ci < 8; ++ci) {
        LAS unsigned char* buf = lds + (ci & 1) * SC_BUF;
        LAS float* xf = (LAS float*)(buf + SC_X32);
        const u32x4 Gc0 = G0, Gc1 = G1;
        {
            float x0[8], x1[8];
#pragma unroll
            for (int e = 0; e < 4; ++e) { x0[e] = cb0[e]; x0[4 + e] = cb1[e]; x1[e] = cb0[e]; x1[4 + e] = cb1[e]; }
#pragma unroll
            for (int k = 0; k < 4; ++k) {
                const f32x4 wa = cwa[k], wb = cwb[k];
                const u32x4 ra = R[k], rb = R[k + 1];
                x0[0] += wa[0] * bf_lo(ra.x); x0[1] += wa[1] * bf_hi(ra.x); x0[2] += wa[2] * bf_lo(ra.y); x0[3] += wa[3] * bf_hi(ra.y);
                x0[4] += wb[0] * bf_lo(ra.z); x0[5] += wb[1] * bf_hi(ra.z); x0[6] += wb[2] * bf_lo(ra.w); x0[7] += wb[3] * bf_hi(ra.w);
                x1[0] += wa[0] * bf_lo(rb.x); x1[1] += wa[1] * bf_hi(rb.x); x1[2] += wa[2] * bf_lo(rb.y); x1[3] += wa[3] * bf_hi(rb.y);
                x1[4] += wb[0] * bf_lo(rb.z); x1[5] += wb[1] * bf_hi(rb.z); x1[6] += wb[2] * bf_lo(rb.w); x1[7] += wb[3] * bf_hi(rb.w);
            }
            u32x4 p0, p1; p0.x = cvt_pk_bf16(x0[0], x0[1]); p0.y = cvt_pk_bf16(x0[2], x0[3]); p0.z = cvt_pk_bf16(x0[4], x0[5]); p0.w = cvt_pk_bf16(x0[6], x0[7]);
            p1.x = cvt_pk_bf16(x1[0], x1[1]); p1.y = cvt_pk_bf16(x1[2], x1[3]); p1.z = cvt_pk_bf16(x1[4], x1[5]); p1.w = cvt_pk_bf16(x1[6], x1[7]);
            *(LAS u32x4*)(buf + SC_XA + rho0 * 272 + cg8 * 16) = p0; *(LAS u32x4*)(buf + SC_XA + rho1 * 272 + cg8 * 16) = p1;
            *(LAS f32x4*)(xf + rho0 * 132 + cg8 * 8) = (f32x4){x0[0], x0[1], x0[2], x0[3]}; *(LAS f32x4*)(xf + rho0 * 132 + cg8 * 8 + 4) = (f32x4){x0[4], x0[5], x0[6], x0[7]};
            *(LAS f32x4*)(xf + rho1 * 132 + cg8 * 8) = (f32x4){x1[0], x1[1], x1[2], x1[3]}; *(LAS f32x4*)(xf + rho1 * 132 + cg8 * 8 + 4) = (f32x4){x1[4], x1[5], x1[6], x1[7]};
        }
        if (ci + 1 < 8) SC_LOAD(ci + 1);
        LDS_BARRIER();
        f32x4 ga[4], gx[4];
#pragma unroll
        for (int mt = 0; mt < 4; ++mt) { ga[mt] = (f32x4){0.f, 0.f, 0.f, 0.f}; gx[mt] = (f32x4){0.f, 0.f, 0.f, 0.f};
#pragma unroll
            for (int ks = 0; ks < 4; ++ks) { const bf16x8 af = *(const LAS bf16x8*)(buf + SC_XA + (16 * mt + chl) * 272 + (32 * ks + 8 * fq) * 2);
                ga[mt] = __builtin_amdgcn_mfma_f32_16x16x32_bf16(af, bfa[ks], ga[mt], 0, 0, 0); gx[mt] = __builtin_amdgcn_mfma_f32_16x16x32_bf16(af, bfx[ks], gx[mt], 0, 0, 0); } }
        LAS float* xl = xf + (4 * fq) * 132 + 16 * w + chl;
        float Pm[16], hl[16]; float p = 1.f, hh = 0.f;
#pragma unroll
        for (int mt = 0; mt < 4; ++mt)
#pragma unroll
            for (int r = 0; r < 4; ++r) {
                const float xv = xl[(16 * mt + r) * 132];
                const float rg = __builtin_amdgcn_rcpf(1.0f + __expf(-(ga[mt][r] + ba))), ig = __builtin_amdgcn_rcpf(1.0f + __expf(-(gx[mt][r] + bxb)));
                const float la = c8 * rg, t2 = 2.0f * la, av = __expf(la);
                const float poly = -t2 * (1.0f + t2 * (0.5f + t2 * (1.6666667e-1f + t2 * (4.1666667e-2f + t2 * (8.3333333e-3f + t2 * 1.3888889e-3f)))));
                const float om = (t2 > -0.25f) ? poly : (1.0f - av * av);
                const float bxv = __builtin_amdgcn_sqrtf(om) * ig * xv;
                p *= av; hh = av * hh + bxv; Pm[4 * mt + r] = p; hl[4 * mt + r] = hh;
            }
        float IA = p, IH = hh;
        float pA = shl_from(IA, (lane - 16) & 63), pH = shl_from(IH, (lane - 16) & 63); if (fq >= 1) { IH = IA * pH + IH; IA = IA * pA; }
        pA = shl_from(IA, (lane - 32) & 63); pH = shl_from(IH, (lane - 32) & 63); if (fq >= 2) { IH = IA * pH + IH; IA = IA * pA; }
        float EA = shl_from(IA, (lane - 16) & 63), EH = shl_from(IH, (lane - 16) & 63); if (fq == 0) { EA = 1.f; EH = 0.f; }
        const float TA = shl_from(IA, 48 + chl), TH = shl_from(IH, 48 + chl);
        const float hstart = EA * hc + EH;
        hc = TA * hc + TH; Asp *= TA;
        if (PASS == 2) {
#pragma unroll
            for (int mt = 0; mt < 4; ++mt)
#pragma unroll
                for (int r = 0; r < 4; ++r) xl[(16 * mt + r) * 132] = hl[4 * mt + r] + Pm[4 * mt + r] * hstart;
            LDS_BARRIER();
            const f32x4 h00 = *(const LAS f32x4*)(xf + rho0 * 132 + cg8 * 8), h01 = *(const LAS f32x4*)(xf + rho0 * 132 + cg8 * 8 + 4);
            const f32x4 h10 = *(const LAS f32x4*)(xf + rho1 * 132 + cg8 * 8), h11 = *(const LAS f32x4*)(xf + rho1 * 132 + cg8 * 8 + 4);
            u32x4 y0, y1;
            y0.x = cvt_pk_bf16(bf_lo(Gc0.x) * h00[0], bf_hi(Gc0.x) * h00[1]); y0.y = cvt_pk_bf16(bf_lo(Gc0.y) * h00[2], bf_hi(Gc0.y) * h00[3]);
            y0.z = cvt_pk_bf16(bf_lo(Gc0.z) * h01[0], bf_hi(Gc0.z) * h01[1]); y0.w = cvt_pk_bf16(bf_lo(Gc0.w) * h01[2], bf_hi(Gc0.w) * h01[3]);
            y1.x = cvt_pk_bf16(bf_lo(Gc1.x) * h10[0], bf_hi(Gc1.x) * h10[1]); y1.y = cvt_pk_bf16(bf_lo(Gc1.y) * h10[2], bf_hi(Gc1.y) * h10[3]);
            y1.z = cvt_pk_bf16(bf_lo(Gc1.z) * h11[0], bf_hi(Gc1.z) * h11[1]); y1.w = cvt_pk_bf16(bf_lo(Gc1.w) * h11[2], bf_hi(Gc1.w) * h11[3]);
            *(u32x4*)(ybase + (size_t)(ci * 64) * 1024) = y0; *(u32x4*)(ybase + (size_t)(ci * 64 + 1) * 1024) = y1;
        }
    }
#undef SC_LOAD
    if (PASS == 1 && fq == 0) { spanA[(size_t)(b * 8 + sp) * 1024 + ch] = Asp; spanH[(size_t)(b * 8 + sp) * 1024 + ch] = hc; }
    __syncthreads();
}

constexpr int AT_K1 = 0, AT_K2 = 9216, AT_V = 18432, AT_BUF = 36864, AT_Q = 2 * AT_BUF, AT_QW = 8704;
__device__ __forceinline__ int crow(int r, int hi) { return (r & 3) + 8 * (r >> 2) + 4 * hi; }
__device__ __forceinline__ void attn_map(const LAS unsigned char* Kb, const LAS unsigned char* Vb, const LAS unsigned char* Qc, f32x16 (&o)[4], float& lsum, const int q, const int hi) {
    u32x4 pw[4];
    const LAS unsigned char* kq = Kb + q * 144 + hi * 16;
#pragma unroll
    for (int blk = 0; blk < 2; ++blk) {
        f32x16 p;
#pragma unroll
        for (int r = 0; r < 16; ++r) p[r] = 0.f;
        bf16x8 kf[2], qf[2];
#define AT_KQ(ds) do { kf[(ds) & 1] = *(const LAS bf16x8*)(kq + blk * (32 * 144) + (ds) * 32); qf[(ds) & 1] = *(const LAS bf16x8*)(Qc + (ds) * 32); } while (0)
        AT_KQ(0); AT_KQ(1);
        __builtin_amdgcn_sched_barrier(0);
#pragma unroll
        for (int ds = 0; ds < 4; ++ds) { p = __builtin_amdgcn_mfma_f32_32x32x16_bf16(kf[ds & 1], qf[ds & 1], p, 0, 0, 0); if (ds + 2 < 4) AT_KQ(ds + 2); __builtin_amdgcn_sched_barrier(0); }
#undef AT_KQ
        float sa = 0.f;
#pragma unroll
        for (int r = 0; r < 16; ++r) { p[r] = __builtin_amdgcn_exp2f(p[r]); sa += p[r]; }
        lsum += sa;
#pragma unroll
        for (int e = 0; e < 4; ++e) { pw[2 * blk][e] = cvt_pk_bf16(p[2 * e], p[2 * e + 1]); pw[2 * blk + 1][e] = cvt_pk_bf16(p[8 + 2 * e], p[8 + 2 * e + 1]); }
        __builtin_amdgcn_sched_barrier(0);
    }
    {   bf16x8 vf[3];
        const LAS unsigned char* vq = Vb + q * 144 + hi * 16;
#define AT_VREAD(i) do { vf[(i) % 3] = *(const LAS bf16x8*)(vq + ((i) >> 2) * (32 * 144) + ((i) & 3) * 32); } while (0)
        AT_VREAD(0); AT_VREAD(1); AT_VREAD(2);
        __builtin_amdgcn_sched_barrier(0);
#pragma unroll
        for (int i = 0; i < 16; ++i) {
            o[i >> 2] = __builtin_amdgcn_mfma_f32_32x32x16_bf16(__builtin_bit_cast(bf16x8, pw[i & 3]), vf[i % 3], o[i >> 2], 0, 0, 0);
            if (i + 3 < 16) AT_VREAD(i + 3);
            __builtin_amdgcn_sched_barrier(0);
        }
#undef AT_VREAD
    }
}
__device__ __forceinline__ void attn_unit(CParams& P, LAS unsigned char* lds, int b, int h, int qb, int j, float lam, float linit, const int tid_in) {
    int tid = tid_in; asm volatile("" : "+v"(tid));
    const int lane = tid & 63, w = __builtin_amdgcn_readfirstlane(tid >> 6), q = lane & 31, hi = lane >> 5;
    const bf16_t* Q = (const bf16_t*)(P.ws + WS_QO); bf16_t* O = (bf16_t*)(P.ws + WS_O);
    const bf16_t* Kg = (const bf16_t*)(P.ws + WS_K); const bf16_t* VT = (const bf16_t*)(P.ws + WS_VT);
    const int NT = 4 * qb + 4, mylast = 4 * qb + (w >> 1);
    const int row0 = b * SEQ + qb * 256 + 32 * w;
    LAS unsigned char* Qw = lds + AT_Q + w * AT_QW;
    {
        const bf16_t* qsrc = Q + (size_t)(row0 + (lane >> 4)) * 1024 + h * 128 + (lane & 15) * 8;
        u32x4 qv[8];
#pragma unroll
        for (int i = 0; i < 8; ++i) qv[i] = *(const u32x4*)(qsrc + (size_t)(4 * i) * 1024);
#pragma unroll
        for (int i = 0; i < 8; ++i) *(LAS u32x4*)(Qw + ((lane >> 4) + 4 * i) * 272 + (lane & 15) * 16) = qv[i];
    }
    const LAS unsigned char* Qc0 = Qw + q * 272 + hi * 16;
    f32x16 o1[4], o2[4];
#pragma unroll
    for (int d = 0; d < 4; ++d)
#pragma unroll
        for (int r = 0; r < 16; ++r) { o1[d][r] = 0.f; o2[d][r] = 0.f; }
    float l1 = 0.f, l2 = 0.f;
#define AT_ADDR() \
    const int kr = tid >> 4, kc16 = tid & 15; \
    const unsigned koff = (unsigned)(((b * SEQ + kr) * 1024 + h * 128 + kc16 * 8) * 2);          \
    const int kdst = ((kc16 < 8) ? AT_K1 : AT_K2) + kr * 144 + (kc16 & 7) * 16;              \
    const int dv0 = tid >> 3, kc = tid & 7; \
    const unsigned voff = (unsigned)((((b * 8 + h) * 128 + dv0) * 4096 + kc * 8) * 2);           \
    const int vdst = AT_V + dv0 * 144 + 32 * (kc >> 1) + 8 * (kc & 1);
    u32x4 rk0, rk1, rv0, rv1;
#define AT_LOAD(t) do { const unsigned ko_ = koff + (unsigned)(t) * 131072u, vo_ = voff + (unsigned)(t) * 128u; \
        rk0 = *(const u32x4*)((const char*)Kg + ko_); rk1 = *(const u32x4*)((const char*)Kg + (ko_ + 65536u)); \
        rv0 = *(const u32x4*)((const char*)VT + vo_); rv1 = *(const u32x4*)((const char*)VT + (vo_ + 524288u)); } while (0)
#define AT_WRITE(Bp) do { LAS unsigned char* B_ = (Bp); *(LAS u32x4*)(B_ + kdst) = rk0; *(LAS u32x4*)(B_ + kdst + 32 * 144) = rk1; \
        *(LAS u32x2*)(B_ + vdst) = (u32x2){rv0.x, rv0.y}; *(LAS u32x2*)(B_ + vdst + 16) = (u32x2){rv0.z, rv0.w}; \
        *(LAS u32x2*)(B_ + vdst + 64 * 144) = (u32x2){rv1.x, rv1.y}; *(LAS u32x2*)(B_ + vdst + 64 * 144 + 16) = (u32x2){rv1.z, rv1.w}; } while (0)
    {   AT_ADDR()
        AT_LOAD(0);
        AT_WRITE(lds);
        LDS_BARRIER();
        for (int kt = 0; kt <= mylast; ++kt) {
            { const int tn_ = (kt + 1 < NT) ? kt + 1 : NT - 1; AT_LOAD(tn_); }
            const LAS unsigned char* B_ = lds + (kt & 1) * AT_BUF;
            attn_map(B_ + AT_K1, B_ + AT_V, Qc0, o1, l1, q, hi);
            attn_map(B_ + AT_K2, B_ + AT_V, Qc0 + 128, o2, l2, q, hi);
            AT_WRITE(lds + ((kt + 1) & 1) * AT_BUF);
            LDS_BARRIER();
        }
    }
    { unsigned z_ = 0u; asm volatile("" : "+v"(z_)); tid = (w << 6) + (int)__builtin_amdgcn_mbcnt_hi(~0u, __builtin_amdgcn_mbcnt_lo(~0u, z_)); }
    {   AT_ADDR()
        for (int kt = mylast + 1; kt < NT; ++kt) {
            { const int tn_ = (kt + 1 < NT) ? kt + 1 : NT - 1; AT_LOAD(tn_); }
            AT_WRITE(lds + ((kt + 1) & 1) * AT_BUF);
            LDS_BARRIER();
        }
    }
#undef AT_ADDR
#undef AT_LOAD
#undef AT_WRITE
    asm volatile("" : "+v"(tid));
    const int lane_e = tid & 63, q_e = lane_e & 31, hi_e = lane_e >> 5;
    l1 += shx(l1, 32, lane_e); l2 += shx(l2, 32, lane_e);
    LAS float* wl = (LAS float*)(Qw + 4608);
    if (hi_e == 0) { wl[q_e] = 1.0f / l1; wl[32 + q_e] = -lam / l2; }
    const LAS float* wlh = wl + 4 * hi_e;
    const float* gs = P.in[29] + j * 128;
    float gsv[4];
#pragma unroll
    for (int d = 0; d < 4; ++d) gsv[d] = gs[32 * d + q_e] * (1.0f - linit);
    bf16_t* obase2 = O + (size_t)(row0 + (lane_e >> 4)) * 1024 + h * 128 + (lane_e & 15) * 8;
    LAS unsigned char* stg = Qw;
#pragma unroll
    for (int r4 = 0; r4 < 4; ++r4) {
        f32x4 la, lb;
#pragma unroll
        for (int e = 0; e < 4; ++e) { la[e] = wlh[e + 8 * r4]; lb[e] = wlh[32 + e + 8 * r4]; }
#pragma unroll
        for (int e = 0; e < 4; ++e) {
            float df[4]; float sq = 0.f;
#pragma unroll
            for (int d = 0; d < 4; ++d) { df[d] = o1[d][4 * r4 + e] * la[e] + o2[d][4 * r4 + e] * lb[e]; sq += df[d] * df[d]; }
            sq += shx(sq, 1, lane_e); sq += shx(sq, 2, lane_e); sq += shx(sq, 4, lane_e); sq += shx(sq, 8, lane_e); sq += shx(sq, 16, lane_e);
            const float rinv = __builtin_amdgcn_rsqf(sq * (1.0f / 128.0f) + 1e-5f);
            LAS unsigned short* sr = (LAS unsigned short*)(stg + ((e + 8 * (r4 & 1) + 4 * hi_e) * 288) + q_e * 2);
#pragma unroll
            for (int d = 0; d < 4; ++d) sr[32 * d] = cvt_bf16(df[d] * rinv * gsv[d]);
        }
        if (r4 & 1) {
            LDS_WAIT();
#pragma unroll
            for (int i = 0; i < 4; ++i) {
                const u32x4 v = *(const LAS u32x4*)(stg + ((lane_e >> 4) + 4 * i) * 288 + (lane_e & 15) * 16);
                bf16_t* op = obase2; asm volatile("" : "+v"(op));
                *(u32x4*)(op + (size_t)(16 * (r4 >> 1) + 4 * i) * 1024) = v; }
            LDS_WAIT();
        }
    }
    __syncthreads();
}

#define XB_TMO      128
#define XB_XCNT(j)  (256  + 64 * (j))
#define XB_XSUB(j)  (1280 + 64 * (j))
#define XB_XGEN(j)  (2304 + 64 * (j))
#define XB_TOP      3328
#define XB_TOPGEN   3392
#define XCD_BAR_WORDS 3456
#define XB_SPIN_CAP (1u << 18)

__device__ __forceinline__ unsigned xb_ld(unsigned* p)              { return __hip_atomic_load(p, __ATOMIC_RELAXED, __HIP_MEMORY_SCOPE_AGENT); }
__device__ __forceinline__ unsigned xb_add(unsigned* p, unsigned v) { return __hip_atomic_fetch_add(p, v, __ATOMIC_RELAXED, __HIP_MEMORY_SCOPE_AGENT); }
__device__ __forceinline__ unsigned xb_xcc_id() { return (unsigned)__builtin_amdgcn_s_getreg((3 << 11) | 20) & 0xFu; }
#define XB_SPIN(cond, bar) do { unsigned _sp = 0; while (cond) { __builtin_amdgcn_s_sleep(1); \
    if ((++_sp & 255u) == 0u) { if (xb_ld(&(bar)[XB_TMO])) break; if (_sp > XB_SPIN_CAP) { atomicAdd(&(bar)[XB_TMO], 1u); break; } } } } while (0)

struct XcdBarrier {
    unsigned* bar; unsigned x;
    volatile LAS unsigned* st;
};

__device__ __forceinline__ XcdBarrier xcd_barrier_post(unsigned* bar, volatile LAS unsigned* st) {
    XcdBarrier b; b.bar = bar; b.x = xb_xcc_id(); b.st = st;
    if (threadIdx.x == 0) (void)xb_add(&bar[XB_XCNT(b.x)], 1u);
    return b;
}
__device__ __forceinline__ void xcd_barrier_complete(unsigned* bar, unsigned x, unsigned& nloc, unsigned& nx) {
    const unsigned G = gridDim.x * gridDim.y * gridDim.z;
    unsigned sum, cnt, mine, sp = 0u;
    for (;;) {
        sum = 0u; cnt = 0u; mine = 0u;
#pragma unroll
        for (unsigned j = 0; j < 16; ++j) { const unsigned c = xb_ld(&bar[XB_XCNT(j)]); sum += c; cnt += (c > 0u) ? 1u : 0u; mine = (j == x) ? c : mine; }
        if (sum == G) break;
        __builtin_amdgcn_s_sleep(1);
        if ((++sp & 255u) == 0u) { if (xb_ld(&bar[XB_TMO])) break; if (sp > XB_SPIN_CAP) { atomicAdd(&bar[XB_TMO], 1u); break; } }
    }
    nloc = mine > 0u ? mine : 1u; nx = cnt > 0u ? cnt : 1u;
}

__device__ __forceinline__ void xcd_barrier(const XcdBarrier& b, const bool is_t0) {
    asm volatile("s_waitcnt vmcnt(0)" ::: "memory");
    __syncthreads();
    if (is_t0) {
        unsigned* bar = b.bar;
        __builtin_amdgcn_s_waitcnt(0);
        unsigned nloc = b.st[0], nx = b.st[1];
        if (nloc == 0u) { xcd_barrier_complete(bar, b.x, nloc, nx); b.st[0] = nloc; b.st[1] = nx; }
        const unsigned old = xb_add(&bar[XB_XSUB(b.x)], 1u);
        const unsigned gen = old / nloc;
        if (old + 1u == (gen + 1u) * nloc) {
            __builtin_amdgcn_fence(__ATOMIC_RELEASE, "agent");
            asm volatile("s_waitcnt vmcnt(0)" ::: "memory");
            const unsigned og = xb_add(&bar[XB_TOP], 1u);
            const unsigned tg = og / nx;
            if (og + 1u == (tg + 1u) * nx) xb_add(&bar[XB_TOPGEN], 1u);
            else XB_SPIN(xb_ld(&bar[XB_TOPGEN]) == tg, bar);
            __builtin_amdgcn_fence(__ATOMIC_ACQUIRE, "agent");
            xb_add(&bar[XB_XGEN(b.x)], 1u);
            asm volatile("s_waitcnt vmcnt(0)" ::: "memory");
        } else {
            XB_SPIN(xb_ld(&bar[XB_XGEN(b.x)]) == gen, bar);
            __builtin_amdgcn_fence(__ATOMIC_ACQUIRE, "agent");
            asm volatile("s_waitcnt vmcnt(0)" ::: "memory");
        }
    }
    __syncthreads();
}


__device__ __forceinline__ pg8::RsCache make_rs_cache(LAS unsigned char* lds, const float* ss, int N, const int tid) {
    pg8::StaticOrder S; S.init(MROWS, N, (int)gridDim.x, (int)blockIdx.x); pg8::Unit u0; u0.pm = 0; u0.pn = 0; const bool any = S.next(0, u0);
    LAS float* tab = (LAS float*)(lds + LDS_BYTES - 1024);
    if (any && tid < 256) tab[tid] = pg8::row_rs(ss, u0.pm * 256 + tid);
    __syncthreads();
    return pg8::RsCache{tab, any ? u0.pm : -1, ss};
}
template <class Epi> __device__ __forceinline__ void run_gemm(LAS unsigned char* lds, const bf16_t* A, const bf16_t* Bt, int N, int K, const Epi& E, const int tid) {
    pg8::Gemm g{A, Bt, MROWS, N, K}; pg8::StaticOrder S; S.init(MROWS, N, (int)gridDim.x, (int)blockIdx.x);
    pg8::gemm_phase<Epi, pg8::StaticOrder, true, true>(lds, g, S, E, tid);
}
enum { OP_PRO = 0, OP_UP, OP_DOWN, OP_RECIN, OP_SCAN1, OP_SCAN2, OP_RECOUT, OP_KV, OP_QG, OP_ATTN, OP_WO };
constexpr int N_STEPS = 32;

__global__ void __launch_bounds__(NTHREADS) mega_fwd(Params P0) {
    extern __shared__ __attribute__((aligned(16))) unsigned char lds_raw[];
    LAS unsigned char* lds = (LAS unsigned char*)lds_raw;
    cg::grid_group grid = cg::this_grid();
    volatile LAS unsigned* bar_st = (volatile LAS unsigned*)(lds + LDS_BYTES - 2048);
    if (threadIdx.x < 2) bar_st[threadIdx.x] = 0u;
    __syncthreads();
    XcdBarrier xbar = xcd_barrier_post((unsigned*)(P0.ws + WS_BAR), bar_st);
    const int wave_s = __builtin_amdgcn_readfirstlane(threadIdx.x >> 6);
    auto mk_tid = [&]() -> int { unsigned z = 0u; asm volatile("" : "+v"(z)); return (wave_s << 6) + (int)__builtin_amdgcn_mbcnt_hi(~0u, __builtin_amdgcn_mbcnt_lo(~0u, z)); };
#define MK_TID() mk_tid()
    const int G = gridDim.x, bx = blockIdx.x, vcu = (G % 8 == 0) ? (bx % 8) * (G / 8) + bx / 8 : bx;
    for (int st = P0.ph_lo; st < P0.ph_hi; ++st) {
        int op, layer = 0, f = 0;
        if (st == 0) op = OP_PRO;
        else if (st <= 16) { const int k = (st - 1) & 7; layer = (st - 1) >> 3; f = layer * 2 + (k >= 6);
            op = (k == 0 || k == 6) ? OP_UP : (k == 1 || k == 7) ? OP_DOWN : (k == 2) ? OP_RECIN : (k == 3) ? OP_SCAN1 : (k == 4) ? OP_SCAN2 : OP_RECOUT; }
        else if (st == 17) { op = OP_KV; layer = 2; }
        else { const int q = st - 18, k = q % 7; layer = 2 + q / 7; f = layer * 2 + (k >= 5);
            op = (k == 0 || k == 5) ? OP_UP : (k == 1 || k == 6) ? OP_DOWN : (k == 2) ? OP_QG : (k == 3) ? OP_ATTN : OP_WO; }
        if (st > P0.ph_lo && st != 18) { if (P0.rep_mask & 0x4000) grid.sync(); else xcd_barrier(xbar, MK_TID() == 0); if (P0.rep_mask & 0x8000) { xcd_barrier(xbar, MK_TID() == 0); xcd_barrier(xbar, MK_TID() == 0); } }
        const int a = layer, jl = layer - 2;
#ifndef OPMASK
#define OPMASK 0xFFFF
#endif
#define HAS(o) ((OPMASK >> (o)) & 1)
#ifndef PROBE_REP_MASK
#define PROBE_REP_MASK 0
#endif
        const int nrep = ((P0.rep_mask >> op) & 1) ? 2 : 1;
        for (int rep = 0; rep < nrep; ++rep) {
        if (rep) xcd_barrier(xbar, MK_TID() == 0);
#define STEP_LOCALS() int tid = MK_TID(); asm volatile("" : "+v"(tid)); CParams* Pp = (CParams*)__builtin_amdgcn_kernarg_segment_ptr(); asm volatile("" : "+s"(Pp)); CParams& P = *Pp; \
        unsigned char* ws = P.ws; asm volatile("" : "+s"(ws)); bf16_t* XB = (bf16_t*)(ws + WS_XB); float* ss = (float*)(ws + WS_SS); bf16_t* HB = (bf16_t*)(ws + WS_H); (void)XB; (void)ss; (void)HB; (void)tid;
        switch (op) {
        case OP_PRO: if (HAS(0)) { STEP_LOCALS() prologue(P, lds, vcu, G, tid); } break;
        case OP_UP: if (HAS(1)) { STEP_LOCALS() pg8::EpiSwiglu E{HB, make_rs_cache(lds, ss, 5632, tid)}; run_gemm(lds, XB, (const bf16_t*)(ws + WS_W + (size_t)f * W_FFN_STRIDE), 5632, 1024, E, tid);
            if (f < 7 && G == 256 && rep == 0) {
                if (bx >= 128) { const int lane = tid & 63, wave = __builtin_amdgcn_readfirstlane(tid >> 6); LAS float* scr = (LAS float*)(lds + wave * 16384);
                    for (int it = (bx - 128) * NWAVES + wave; it < 4224; it += 128 * NWAVES) ffn_item(P, f + 1, it, scr, lane); }
            } else if (f < 7 && rep == 0) { const int lane = tid & 63, wave = __builtin_amdgcn_readfirstlane(tid >> 6); LAS float* scr = (LAS float*)(lds + wave * 16384);
                for (int it = vcu * NWAVES + wave; it < 4224; it += G * NWAVES) ffn_item(P, f + 1, it, scr, lane); }
        } break;
        case OP_DOWN: case OP_RECOUT: case OP_WO: if (HAS(2)) { STEP_LOCALS()
            const bf16_t* A = (op == OP_DOWN) ? HB : (op == OP_RECOUT) ? (const bf16_t*)(ws + WS_Y) : (const bf16_t*)(ws + WS_O);
            const bf16_t* Bt = (op == OP_DOWN) ? (const bf16_t*)(ws + WS_W + (size_t)f * W_FFN_STRIDE + W_FFN_DN) : (op == OP_RECOUT) ? (const bf16_t*)(ws + W_REC + (size_t)a * W_REC_STRIDE + W_REC_OUT) : (const bf16_t*)(ws + W_O + (size_t)jl * 2 * MiB);
            pg8::EpiResid E{(st == N_STEPS - 1) ? P.out : nullptr, XB, (unsigned char*)(ws + WS_XL), ss, __uint_as_float((op == OP_DOWN) ? 0x3f000000u : 0x3f800000u)}; run_gemm(lds, A, Bt, 1024, (op == OP_DOWN) ? 2816 : 1024, E, tid); } break;
        case OP_RECIN: if (HAS(3)) { STEP_LOCALS() pg8::EpiRecIn E{(bf16_t*)(ws + WS_GG), (bf16_t*)(ws + WS_REC), make_rs_cache(lds, ss, 2048, tid)}; run_gemm(lds, XB, (const bf16_t*)(ws + W_REC + (size_t)a * W_REC_STRIDE), 2048, 1024, E, tid); } break;
        case OP_SCAN1: if (HAS(4)) { STEP_LOCALS() for (int u = vcu; u < 256; u += G) scan_unit<1>(P, lds, a, u >> 6, (u >> 3) & 7, u & 7, tid); } break;
        case OP_SCAN2: if (HAS(5)) { STEP_LOCALS() for (int u = vcu; u < 256; u += G) scan_unit<2>(P, lds, a, u >> 6, (u >> 3) & 7, u & 7, tid); } break;
        case OP_KV: case OP_QG: if (HAS(7)) { STEP_LOCALS()
            const bool kv = (op == OP_KV);
            pg8::EpiQK E{kv ? (bf16_t*)(ws + WS_K) : (bf16_t*)(ws + WS_QO), (bf16_t*)(ws + WS_VT), make_rs_cache(lds, ss, kv ? 2048 : 1024, tid), kv ? P.in[22] : P.in[26] + jl * 64, (const float*)(ws + WS_COS), (const float*)(ws + WS_SIN), kv ? 1.0f : 0.125f * 1.4426950408889634f};
            run_gemm(lds, XB, kv ? (const bf16_t*)(ws + W_KV) : (const bf16_t*)(ws + W_Q + (size_t)jl * 2 * MiB), kv ? 2048 : 1024, 1024, E, tid); } break;
        case OP_ATTN: if (HAS(9)) { STEP_LOCALS()
            const int tid_a = MK_TID();
            const int lane = tid_a & 63;
            const float q1 = P.in[27][jl * 64 + lane], q2 = P.in[28][jl * 64 + lane], k1 = P.in[23][lane], k2 = P.in[24][lane];
            const float linit = jl ? P.linit[1] : P.linit[0];
            const float lam = __uint_as_float(__builtin_amdgcn_readfirstlane(__float_as_uint(__expf(wave_sum(q1 * k1, lane)) - __expf(wave_sum(q2 * k2, lane)) + linit)));
            for (int pr = vcu; pr < 256; pr += G) { const int bh = pr >> 3, s = pr & 7;
#pragma unroll 1
                for (int uu = 0; uu < 2; ++uu) attn_unit(P, lds, bh >> 3, bh & 7, uu ? s : 15 - s, jl, lam, linit, tid_a); }
        } break;
        }
        }
    }
}

#ifndef MK_PER_STEP
#define MK_PER_STEP 0
#endif
extern "C" void kernel_launch(void* const* d_in, const int* in_sizes, int n_in, void* d_out, int out_size, void* d_ws, size_t ws_size, hipStream_t stream) {
    static int grid = 0;
    if (grid == 0) {
        int dev = 0, cus = 0, per_cu = 0;
        if (n_in != 31 || out_size != MROWS * DM || ws_size < WS_END) { fprintf(stderr, "kernel_launch: unexpected shapes (n_in %d out %d ws %zu)\n", n_in, out_size, ws_size); grid = -1; return; }
        hipGetDevice(&dev); hipDeviceGetAttribute(&cus, hipDeviceAttributeMultiprocessorCount, dev);
        hipFuncSetAttribute((const void*)mega_fwd, hipFuncAttributeMaxDynamicSharedMemorySize, LDS_BYTES);
        hipOccupancyMaxActiveBlocksPerMultiprocessor(&per_cu, (const void*)mega_fwd, NTHREADS, LDS_BYTES);
        (void)hipGetLastError();
        if (per_cu < 1) per_cu = 1;
        grid = cus * 1;
        if (grid <= 0) grid = 256;
    }
    if (grid < 0) return;
    Params p{};
    for (int i = 0; i < 31; ++i) p.in[i] = (const float*)d_in[i];
    p.out = (float*)d_out; p.ws = (unsigned char*)d_ws; p.rep_mask = PROBE_REP_MASK;
    p.linit[0] = (float)(0.8 - 0.6 * std::exp(-0.3 * 2.0)); p.linit[1] = (float)(0.8 - 0.6 * std::exp(-0.3 * 3.0));
    for (int i = 0; i < 32; ++i) p.invfreq[i] = std::pow(10000.0, -(double)(2 * i) / 64.0);
    (void)hipMemsetAsync((char*)d_ws + WS_BAR, 0, 16384, stream);
#if MK_PER_STEP
    for (int st = 0; st < N_STEPS; ++st) { p.ph_lo = st; p.ph_hi = st + 1; hipLaunchKernelGGL(mega_fwd, dim3(grid), dim3(NTHREADS), LDS_BYTES, stream, p); }
#else
    p.ph_lo = 0; p.ph_hi = N_STEPS;
    void* args[] = {&p};
    hipError_t e = hipLaunchCooperativeKernel((const void*)mega_fwd, dim3(grid), dim3(NTHREADS), args, LDS_BYTES, stream);
    if (e != hipSuccess) fprintf(stderr, "cooperative launch failed: %s (grid %d)\n", hipGetErrorString(e), grid);
#endif
}
```

```cpp
#include <hip/hip_runtime.h>
#include <hip/hip_cooperative_groups.h>
#include <cstdio>
#include <cstdint>
#include <cmath>
namespace cg = cooperative_groups;
__device__ __forceinline__ float shx(float v, int k, int lane) { return __int_as_float(__builtin_amdgcn_ds_bpermute((lane ^ k) << 2, __float_as_int(v))); }
__device__ __forceinline__ float shl_from(float v, int src) { return __int_as_float(__builtin_amdgcn_ds_bpermute(src << 2, __float_as_int(v))); }
__device__ __forceinline__ unsigned lo4_enc(float x, float hif, unsigned e) { const float inv = (e >= 12u) ? __uint_as_float((265u - e) << 23) : 0.f; float q = rintf((x - hif) * inv) + 8.f; q = fminf(fmaxf(q, 0.f), 15.f); return (unsigned)q; }
__device__ __forceinline__ float lo4_dec(unsigned nib, unsigned e) { const float sc = (e >= 12u) ? __uint_as_float((e - 11u) << 23) : 0.f; return ((float)nib - 8.f) * sc; }
namespace pg8 {
#define PG8_LAS __attribute__((address_space(3)))
typedef unsigned short bf16_t;
typedef short bf16x8 __attribute__((ext_vector_type(8)));
typedef float f32x4 __attribute__((ext_vector_type(4)));
typedef unsigned u32x4 __attribute__((ext_vector_type(4)));
constexpr int BM = 256, BK = 64, HALF = 128, HTB = HALF * BK * 2  , STAGE_BYTES = 8 * HTB, NXCD = 8, WGM = 8;

__host__ __device__ __forceinline__ int lds_byte(int r, int c) { const int st = (r >> 4) * 2 + (c >> 5), rr = r & 15, cc = c & 31, ob = rr * 64 + cc * 2; return st * 1024 + (ob ^ (((ob >> 9) & 1) << 5)); }
__host__ __device__ __forceinline__ void stage_rc(int b, int& R, int& C) { const int st = b / 1024, sb = b % 1024, swz = sb ^ (((sb >> 9) & 1) << 5); R = (st >> 1) * 16 + swz / 64; C = (st & 1) * 32 + (swz % 64) / 2; }
__host__ __device__ __forceinline__ int perm32(int rho) { const int n = rho >> 4, i = rho & 15; return 8 * (i >> 2) + 4 * n + (i & 3); }

struct Unit { int pm, pn; };
struct Gemm { const bf16_t* A; const bf16_t* Bt; int M, N, K; };

struct StaticOrder {
    int nM, nN, nwg, G, c;
    __host__ __device__ void init(int M, int N, int G_, int c_) { nM = M / BM; nN = N / BM; nwg = nM * nN; G = G_; c = c_; }
    __host__ __device__ bool next(int i, Unit& u) const {
        const long L = (long)i * G + c; if (L >= nwg) return false;
        int wgid = (int)L; { const int q = nwg / NXCD, r = nwg % NXCD, xcd = wgid % NXCD, off = wgid / NXCD; wgid = (xcd < r ? xcd * (q + 1) : r * (q + 1) + (xcd - r) * q) + off; }
        const int nig = WGM * nN, gid = wgid / nig, fm = gid * WGM, gsz = (nM - fm) < WGM ? (nM - fm) : WGM;
        u.pm = fm + ((wgid % nig) % gsz); u.pn = (wgid % nig) / gsz; return true;
    }
    __device__ __forceinline__ void a_ready(const Unit&) const {}
    __device__ __forceinline__ void done(const Unit&) const {}
};
typedef unsigned u32x4 __attribute__((ext_vector_type(4)));
__device__ __forceinline__ unsigned cvt_pk_bf16(float lo, float hi) { unsigned r; asm volatile("v_cvt_pk_bf16_f32 %0, %1, %2" : "=v"(r) : "v"(lo), "v"(hi)); return r; }
__device__ __forceinline__ unsigned short cvt_bf16(float v) { return (unsigned short)(cvt_pk_bf16(v, 0.f) & 0xffffu); }
__device__ __forceinline__ u32x4 pack8(const f32x4 a, const f32x4 b) { u32x4 w; w.x = cvt_pk_bf16(a[0], a[1]); w.y = cvt_pk_bf16(a[2], a[3]); w.z = cvt_pk_bf16(b[0], b[1]); w.w = cvt_pk_bf16(b[2], b[3]); return w; }
__device__ __forceinline__ float row_rs(const float* ss, int row) {
    const f32x4* p = (const f32x4*)(ss + (size_t)row * 16);
    const f32x4 a = p[0], b = p[1], c = p[2], d = p[3];
    const float s = (((a[0] + a[1]) + (a[2] + a[3])) + ((b[0] + b[1]) + (b[2] + b[3]))) + (((c[0] + c[1]) + (c[2] + c[3])) + ((d[0] + d[1]) + (d[2] + d[3])));
    return __builtin_amdgcn_rsqf(s * (1.0f / 1024.0f) + 1e-6f);
}
__device__ __forceinline__ float silu_f(float g) { return g * __builtin_amdgcn_rcpf(1.0f + __builtin_amdgcn_exp2f(-1.4426950408889634f * g)); }
__device__ __forceinline__ float gelu_tanh_f(float v) { const float t = 0.7978845608028654f * (v + 0.044715f * v * v * v); return v * __builtin_amdgcn_rcpf(1.0f + __builtin_amdgcn_exp2f(-2.0f * 1.4426950408889634f * t)); }

struct RsCache { const PG8_LAS float* tab; int pm0; const float* ss;
    __device__ __forceinline__ float get(int pm, int lrow) const { return (pm == pm0) ? tab[lrow] : row_rs(ss, pm * BM + lrow); } };
struct EpiSwiglu {
    static constexpr bool PERM = true, AFTER_DRAIN = false;
    bf16_t* H; RsCache rc;
    typedef float f32x2 __attribute__((ext_vector_type(2)));
    static __device__ __forceinline__ f32x2 sw2(f32x2 g, f32x2 u, float c1, float rs2) {
        const f32x2 t = g * c1; f32x2 e; e.x = __builtin_amdgcn_exp2f(t.x); e.y = __builtin_amdgcn_exp2f(t.y);
        const f32x2 d = e + 1.0f; f32x2 r; r.x = __builtin_amdgcn_rcpf(d.x); r.y = __builtin_amdgcn_rcpf(d.y);
        return (g * u) * (r * rs2);
    }
    __device__ __forceinline__ void operator()(const f32x4 (&acc)[2][2][4][2], const Unit& u, int wr, int wc, int fr, int fq) const {
        const int col0 = u.pn * 128 + wc * 32 + 8 * fq;
        float rsv[2][4];
#pragma unroll
        for (int ai = 0; ai < 2; ++ai)
#pragma unroll
            for (int m = 0; m < 4; ++m) rsv[ai][m] = rc.get(u.pm, ai * HALF + wr * 64 + m * 16 + fr);
#pragma unroll
        for (int ai = 0; ai < 2; ++ai)
#pragma unroll
            for (int m = 0; m < 4; ++m) {
                const int row = u.pm * BM + ai * HALF + wr * 64 + m * 16 + fr; const float rs = rsv[ai][m], c1 = -1.4426950408889634f * rs, rs2 = rs * rs;
                const f32x4 g0 = acc[ai][0][m][0], g1 = acc[ai][0][m][1], u0 = acc[ai][1][m][0], u1 = acc[ai][1][m][1];
                const f32x2 a = sw2((f32x2){g0[0], g0[1]}, (f32x2){u0[0], u0[1]}, c1, rs2), b = sw2((f32x2){g0[2], g0[3]}, (f32x2){u0[2], u0[3]}, c1, rs2);
                const f32x2 c = sw2((f32x2){g1[0], g1[1]}, (f32x2){u1[0], u1[1]}, c1, rs2), d = sw2((f32x2){g1[2], g1[3]}, (f32x2){u1[2], u1[3]}, c1, rs2);
                u32x4 w; w.x = cvt_pk_bf16(a.x, a.y); w.y = cvt_pk_bf16(b.x, b.y); w.z = cvt_pk_bf16(c.x, c.y); w.w = cvt_pk_bf16(d.x, d.y);
                *(u32x4*)(H + (size_t)row * 2816 + col0) = w;
            }
    }
};
struct EpiResid {
    static constexpr bool PERM = true, AFTER_DRAIN = false;
    typedef unsigned u32x2 __attribute__((ext_vector_type(2)));
    float* OUT; bf16_t* XB; unsigned char* XL; float* ss; float alpha;
    __device__ __forceinline__ void operator()(const f32x4 (&acc)[2][2][4][2], const Unit& u, int wr, int wc, int fr, int fq) const {
        const int col0 = u.pn * BM + wc * 32 + 8 * fq;
        const size_t off0 = (size_t)(u.pm * BM + wr * 64 + fr) * 1024 + col0;
#pragma unroll
        for (int ai = 0; ai < 2; ++ai) {
            u32x4 hin[4][2]; unsigned lin[4][2];
#pragma unroll
            for (int m = 0; m < 4; ++m)
#pragma unroll
                for (int bj = 0; bj < 2; ++bj) { const size_t o = off0 + (size_t)(ai * HALF + m * 16) * 1024 + bj * HALF; hin[m][bj] = *(const u32x4*)(XB + o); lin[m][bj] = *(const unsigned*)(XL + (o >> 1)); }
            __builtin_amdgcn_sched_barrier(0);
#pragma unroll
            for (int m = 0; m < 4; ++m) {
                const int row = u.pm * BM + ai * HALF + wr * 64 + m * 16 + fr; float sq = 0.f;
#pragma unroll
                for (int bj = 0; bj < 2; ++bj) {
                    const size_t o = off0 + (size_t)(ai * HALF + m * 16) * 1024 + bj * HALF;
                    const u32x4 h = hin[m][bj]; const unsigned l = lin[m][bj];
                    float xv[8];
#pragma unroll
                    for (int k = 0; k < 8; ++k) { const unsigned wd = h[k >> 1]; const float hif = (k & 1) ? __uint_as_float(wd & 0xffff0000u) : __uint_as_float(wd << 16);
                        const unsigned ex = (k & 1) ? ((wd >> 23) & 0xffu) : ((wd >> 7) & 0xffu); const unsigned by = (l >> (4 * k)) & 0xfu;
                        xv[k] = hif + lo4_dec(by, ex) + acc[ai][bj][m][k >> 2][k & 3] * alpha; }
                    const f32x4 x0 = (f32x4){xv[0], xv[1], xv[2], xv[3]}, x1 = (f32x4){xv[4], xv[5], xv[6], xv[7]};
                    if (OUT) { *(f32x4*)(OUT + o) = x0; *(f32x4*)(OUT + o + 4) = x1; }
                    else {
#pragma unroll
                        for (int k = 0; k < 8; ++k) sq += xv[k] * xv[k];
                        const u32x4 hn = pack8(x0, x1);
                        unsigned ln = 0u;
#pragma unroll
                        for (int k = 0; k < 8; ++k) { const unsigned wd = hn[k >> 1]; const float hif = (k & 1) ? __uint_as_float(wd & 0xffff0000u) : __uint_as_float(wd << 16);
                            const unsigned ex = (k & 1) ? ((wd >> 23) & 0xffu) : ((wd >> 7) & 0xffu); ln |= lo4_enc(xv[k], hif, ex) << (4 * k); }
                        *(u32x4*)(XB + o) = hn; *(unsigned*)(XL + (o >> 1)) = ln;
                    }
                }
                if (!OUT) { { const int ln_ = fr + 16 * fq; sq += shx(sq, 16, ln_); sq += shx(sq, 32, ln_); }
                    if (fq == 0) ss[(size_t)row * 16 + u.pn * 4 + wc] = sq; }
            }
        }
    }
};
struct EpiRecIn {
    static constexpr bool PERM = true, AFTER_DRAIN = false;
    bf16_t* GG; bf16_t* REC; RsCache rc;
    __device__ __forceinline__ void operator()(const f32x4 (&acc)[2][2][4][2], const Unit& u, int wr, int wc, int fr, int fq) const {
        const bool isgate = u.pn < 4; bf16_t* dst = isgate ? GG : REC; const int col0 = (u.pn & 3) * BM + wc * 32 + 8 * fq;
#pragma unroll
        for (int ai = 0; ai < 2; ++ai)
#pragma unroll
            for (int m = 0; m < 4; ++m) {
                const int row = u.pm * BM + ai * HALF + wr * 64 + m * 16 + fr; const float rs = rc.get(u.pm, ai * HALF + wr * 64 + m * 16 + fr);
#pragma unroll
                for (int bj = 0; bj < 2; ++bj) {
                    f32x4 v0 = acc[ai][bj][m][0] * rs, v1 = acc[ai][bj][m][1] * rs;
                    if (isgate) {
#pragma unroll
                        for (int j = 0; j < 4; ++j) { v0[j] = gelu_tanh_f(v0[j]); v1[j] = gelu_tanh_f(v1[j]); }
                    }
                    *(u32x4*)(dst + (size_t)row * 1024 + col0 + bj * HALF) = pack8(v0, v1);
                }
            }
    }
};
struct EpiQK {
    static constexpr bool PERM = true, AFTER_DRAIN = false;
    bf16_t* QK; bf16_t* VT; RsCache rc; const float* gain; const float* cosT; const float* sinT; float oscale;
    __device__ __forceinline__ void operator()(const f32x4 (&acc)[2][2][4][2], const Unit& u, int wr, int wc, int fr, int fq) const {
        if (u.pn < 4) {
            const int hh = u.pn * 4 + wc;
            f32x4 glo[2], ghi[2];
#pragma unroll
            for (int n = 0; n < 2; ++n) { glo[n] = *(const f32x4*)(gain + 8 * fq + 4 * n); ghi[n] = *(const f32x4*)(gain + 32 + 8 * fq + 4 * n); }
#pragma unroll
            for (int ai = 0; ai < 2; ++ai)
#pragma unroll
                for (int m = 0; m < 4; ++m) {
                    const int row = u.pm * BM + ai * HALF + wr * 64 + m * 16 + fr; const float rs = rc.get(u.pm, ai * HALF + wr * 64 + m * 16 + fr); const int pos = row & 4095;
                    f32x4 v[2][2]; float sq = 0.f;
#pragma unroll
                    for (int bj = 0; bj < 2; ++bj)
#pragma unroll
                        for (int n = 0; n < 2; ++n) { v[bj][n] = acc[ai][bj][m][n] * rs; const f32x4 t = v[bj][n]; sq += (t[0] * t[0] + t[1] * t[1]) + (t[2] * t[2] + t[3] * t[3]); }
                    { const int ln_ = fr + 16 * fq; sq += shx(sq, 16, ln_); sq += shx(sq, 32, ln_); }
                    const float rinv = __builtin_amdgcn_rsqf(sq * (1.0f / 64.0f) + 1e-6f);
                    f32x4 olo[2], ohi[2];
#pragma unroll
                    for (int n = 0; n < 2; ++n) {
                        const f32x4 c = *(const f32x4*)(cosT + (size_t)pos * 32 + 8 * fq + 4 * n), s = *(const f32x4*)(sinT + (size_t)pos * 32 + 8 * fq + 4 * n);
                        const f32x4 ylo = v[0][n] * rinv * glo[n], yhi = v[1][n] * rinv * ghi[n];
                        olo[n] = (ylo * c - yhi * s) * oscale; ohi[n] = (yhi * c + ylo * s) * oscale;
                    }
                    bf16_t* dp = QK + (size_t)row * 1024 + hh * 64 + 8 * fq;
                    *(u32x4*)dp = pack8(olo[0], olo[1]); *(u32x4*)(dp + 32) = pack8(ohi[0], ohi[1]);
                }
        } else {
#pragma unroll
            for (int ai = 0; ai < 2; ++ai)
#pragma unroll
                for (int m = 0; m < 4; ++m) {
                    const int row = u.pm * BM + ai * HALF + wr * 64 + m * 16 + fr; const float rs = rc.get(u.pm, ai * HALF + wr * 64 + m * 16 + fr); const int b = row >> 12, s = row & 4095;
#pragma unroll
                    for (int bj = 0; bj < 2; ++bj)
#pragma unroll
                        for (int n = 0; n < 2; ++n)
#pragma unroll
                            for (int j = 0; j < 4; ++j) {
                                const int col = (u.pn - 4) * BM + bj * HALF + wc * 32 + 8 * fq + 4 * n + j;
                                VT[((size_t)(b * 1024 + col)) * 4096 + s] = cvt_bf16(acc[ai][bj][m][n][j] * rs);
                            }
                }
        }
    }
};

template <class Epi, class Sched, bool ALIGN_EPI = false, bool SP2 = false>
__device__ __forceinline__ void gemm_phase(PG8_LAS unsigned char* lds, const Gemm g, const Sched& S, const Epi& E, const int tid) {
    const int wid = __builtin_amdgcn_readfirstlane(tid >> 6), lane = tid & 63, wr = wid >> 2, wc = wid & 3, fr = lane & 15, fq = lane >> 4;
    const int K = g.K, nt = K / BK;
    unsigned voffA[2], voffB[2];
#pragma unroll
    for (int i = 0; i < 2; ++i) { int R, C; stage_rc(tid * 16 + i * 8192, R, C); const int Rb = Epi::PERM ? ((R & ~31) + perm32(R & 31)) : R;
        voffA[i] = (unsigned)(R * K + C) * 2u; voffB[i] = (unsigned)(Rb * K + C) * 2u; }
    const size_t kstep = (size_t)(BK * 2);
    const size_t hstep = (size_t)HALF * K * 2;
    const size_t tstep = 2 * hstep;
    const unsigned ldsw = (unsigned)wid * 1024u;
    const int aoff = lds_byte(wr * 64 + fr, fq * 8), boff = lds_byte(wc * 32 + fr, fq * 8);
#define PG8_SA(b, h) (((b) * 2 + (h)) * HTB)
#define PG8_SB(b, h) ((4 + (b) * 2 + (h)) * HTB)
#define PG8_STAGE(bufoff, gbase, voff) do { _Pragma("unroll") for (int _i = 0; _i < 2; ++_i) \
        __builtin_amdgcn_global_load_lds((const unsigned*)((const char*)(gbase) + (voff)[_i]), (PG8_LAS unsigned*)(lds + (bufoff) + ldsw + _i * 8192), 16, 0, 0); } while (0)
#define PG8_LDA(dst, b, h) do { _Pragma("unroll") for (int m = 0; m < 4; ++m) _Pragma("unroll") for (int k = 0; k < 2; ++k) dst[m][k] = *(const PG8_LAS bf16x8*)(lds + PG8_SA(b, h) + aoff + m * 2048 + k * 1024); } while (0)
#define PG8_LDB(dst, b, h) do { _Pragma("unroll") for (int n = 0; n < 2; ++n) _Pragma("unroll") for (int k = 0; k < 2; ++k) dst[n][k] = *(const PG8_LAS bf16x8*)(lds + PG8_SB(b, h) + boff + n * 2048 + k * 1024); } while (0)
#define PG8_MMA(ai, bj, At, Bt) do { __builtin_amdgcn_s_setprio(1); _Pragma("unroll") for (int m = 0; m < 4; ++m) _Pragma("unroll") for (int n = 0; n < 2; ++n) _Pragma("unroll") for (int k = 0; k < 2; ++k) \
        acc[ai][bj][m][n] = __builtin_amdgcn_mfma_f32_16x16x32_bf16(Bt[n][k], At[m][k], acc[ai][bj][m][n], 0, 0, 0); __builtin_amdgcn_s_setprio(0); } while (0)
#define PG8_WAIT_V(n) asm volatile("s_waitcnt vmcnt(" #n ")" ::: "memory")
#define PG8_WAIT_L(n) asm volatile("s_waitcnt lgkmcnt(" #n ")" ::: "memory")
#define PG8_BAR __builtin_amdgcn_s_barrier()
#define PG8_SCHED __builtin_amdgcn_sched_barrier(0)
    Unit cur, nxt; int ui = 0;
    if (!S.next(0, cur)) return;
    f32x4 acc[2][2][4][2];
#pragma unroll
    for (int a = 0; a < 2; ++a)
#pragma unroll
        for (int b = 0; b < 2; ++b)
#pragma unroll
            for (int m = 0; m < 4; ++m)
#pragma unroll
                for (int n = 0; n < 2; ++n) acc[a][b][m][n] = (f32x4){0.f, 0.f, 0.f, 0.f};
    bf16x8 At[4][2], B0[2][2], B1[2][2];
    const char* cA = (const char*)g.A + (size_t)cur.pm * tstep; const char* cB = (const char*)g.Bt + (size_t)cur.pn * tstep;
    S.a_ready(cur);
    if constexpr (SP2) {
        PG8_STAGE(PG8_SB(0, 0), cB, voffB); PG8_STAGE(PG8_SB(0, 1), cB + hstep, voffB); PG8_STAGE(PG8_SA(0, 0), cA, voffA); PG8_STAGE(PG8_SA(0, 1), cA + hstep, voffA);
        if (wr == 1) PG8_BAR;
        PG8_WAIT_V(2); PG8_BAR;
        PG8_STAGE(PG8_SB(1, 0), cB + kstep, voffB); PG8_STAGE(PG8_SA(1, 0), cA + kstep, voffA); PG8_STAGE(PG8_SB(1, 1), cB + hstep + kstep, voffB);
        PG8_WAIT_V(6); PG8_BAR;
    } else {
        PG8_STAGE(PG8_SB(0, 0), cB, voffB); PG8_STAGE(PG8_SA(0, 0), cA, voffA); PG8_STAGE(PG8_SB(0, 1), cB + hstep, voffB); PG8_STAGE(PG8_SA(0, 1), cA + hstep, voffA);
        if (wr == 1) PG8_BAR;
        PG8_WAIT_V(4); PG8_BAR;
        PG8_STAGE(PG8_SB(1, 0), cB + kstep, voffB); PG8_STAGE(PG8_SA(1, 0), cA + kstep, voffA); PG8_STAGE(PG8_SB(1, 1), cB + hstep + kstep, voffB);
        PG8_WAIT_V(6); PG8_BAR;
    }
    for (;;) {
        const bool has_next = S.next(ui + 1, nxt);
        const char* nA = has_next ? (const char*)g.A + (size_t)nxt.pm * tstep : cA; const char* nB = has_next ? (const char*)g.Bt + (size_t)nxt.pn * tstep : cB;
        for (int t = 0; t < nt; t += 2) {
            const bool last = (t == nt - 2);
            const char* a1 = cA + (size_t)(t + 1) * kstep;
            const char* a2 = last ? nA : cA + (size_t)(t + 2) * kstep; const char* b2 = last ? nB : cB + (size_t)(t + 2) * kstep;
            const char* a3 = a2 + kstep; const char* b3 = b2 + kstep;
            if (last && has_next) S.a_ready(nxt);
            if constexpr (SP2) {
            PG8_LDB(B0, 0, 0); PG8_LDB(B1, 0, 1); PG8_SCHED; PG8_LDA(At, 0, 0); PG8_STAGE(PG8_SA(1, 1), a1 + hstep, voffA);
            PG8_WAIT_V(8); PG8_WAIT_L(0); PG8_BAR; PG8_MMA(0, 0, At, B0); PG8_MMA(0, 1, At, B1); PG8_BAR; PG8_SCHED;
            PG8_LDA(At, 0, 1); PG8_STAGE(PG8_SB(0, 0), b2, voffB); PG8_STAGE(PG8_SB(0, 1), b2 + hstep, voffB); PG8_STAGE(PG8_SA(0, 0), a2, voffA);
            PG8_WAIT_V(8); PG8_WAIT_L(0); PG8_BAR; PG8_MMA(1, 0, At, B0); PG8_MMA(1, 1, At, B1); PG8_BAR; PG8_SCHED;
            PG8_LDB(B0, 1, 0); PG8_LDB(B1, 1, 1); PG8_SCHED; PG8_LDA(At, 1, 0); PG8_STAGE(PG8_SA(0, 1), a2 + hstep, voffA);
            PG8_WAIT_V(8); PG8_WAIT_L(0); PG8_BAR; PG8_MMA(0, 0, At, B0); PG8_MMA(0, 1, At, B1); PG8_BAR; PG8_SCHED;
            PG8_LDA(At, 1, 1); PG8_STAGE(PG8_SB(1, 0), b3, voffB); PG8_STAGE(PG8_SB(1, 1), b3 + hstep, voffB); PG8_STAGE(PG8_SA(1, 0), a3, voffA);
            PG8_WAIT_V(8); PG8_WAIT_L(0); PG8_BAR; PG8_MMA(1, 0, At, B0); PG8_MMA(1, 1, At, B1); PG8_BAR; PG8_SCHED;
            } else {
            PG8_LDB(B0, 0, 0); PG8_SCHED; PG8_LDA(At, 0, 0); PG8_STAGE(PG8_SA(1, 1), a1 + hstep, voffA);
            PG8_WAIT_L(8); PG8_BAR; PG8_WAIT_L(0); PG8_MMA(0, 0, At, B0); PG8_BAR; PG8_SCHED;
            PG8_LDB(B1, 0, 1); PG8_STAGE(PG8_SB(0, 0), b2, voffB);
            PG8_BAR; PG8_WAIT_L(0); PG8_MMA(0, 1, At, B1); PG8_BAR;
            PG8_LDA(At, 0, 1); PG8_STAGE(PG8_SA(0, 0), a2, voffA);
            PG8_BAR; PG8_WAIT_L(0); PG8_MMA(1, 0, At, B0); PG8_BAR; PG8_SCHED;
            PG8_STAGE(PG8_SB(0, 1), b2 + hstep, voffB);
            PG8_WAIT_V(6); PG8_BAR; PG8_MMA(1, 1, At, B1); PG8_BAR;
            PG8_LDB(B0, 1, 0); PG8_SCHED; PG8_LDA(At, 1, 0); PG8_STAGE(PG8_SA(0, 1), a2 + hstep, voffA);
            PG8_WAIT_L(8); PG8_BAR; PG8_WAIT_L(0); PG8_MMA(0, 0, At, B0); PG8_BAR; PG8_SCHED;
            PG8_LDB(B1, 1, 1); PG8_STAGE(PG8_SB(1, 0), b3, voffB);
            PG8_BAR; PG8_WAIT_L(0); PG8_MMA(0, 1, At, B1); PG8_BAR;
            PG8_LDA(At, 1, 1); PG8_STAGE(PG8_SA(1, 0), a3, voffA);
            PG8_BAR; PG8_WAIT_L(0); PG8_MMA(1, 0, At, B0); PG8_BAR; PG8_SCHED;
            PG8_STAGE(PG8_SB(1, 1), b3 + hstep, voffB);
            PG8_WAIT_V(6); PG8_BAR; PG8_MMA(1, 1, At, B1); PG8_BAR;
            }
        }
        if constexpr (ALIGN_EPI) { if (wr == 0) PG8_BAR; }
        if constexpr (!Epi::AFTER_DRAIN) { E(acc, cur, wr, wc, fr, fq); S.done(cur); }
        if (!has_next) break;
#pragma unroll
        for (int a = 0; a < 2; ++a)
#pragma unroll
            for (int b = 0; b < 2; ++b)
#pragma unroll
                for (int m = 0; m < 4; ++m)
#pragma unroll
                    for (int n = 0; n < 2; ++n) acc[a][b][m][n] = (f32x4){0.f, 0.f, 0.f, 0.f};
        cur = nxt; cA = nA; cB = nB; ++ui;
        if constexpr (ALIGN_EPI) { if (wr == 1) PG8_BAR; }
    }
    PG8_WAIT_V(0);
    if constexpr (!ALIGN_EPI) { if (wr == 0) PG8_BAR; }
    PG8_BAR;
    if constexpr (Epi::AFTER_DRAIN) { E.fused(acc, cur, wr, wc, fr, fq, lds, wid, lane); S.done(cur); }
#undef PG8_SA
#undef PG8_SB
#undef PG8_STAGE
#undef PG8_LDA
#undef PG8_LDB
#undef PG8_MMA
#undef PG8_WAIT_V
#undef PG8_WAIT_L
#undef PG8_BAR
#undef PG8_SCHED
}
}
#define LAS __attribute__((address_space(3)))
typedef unsigned short bf16_t;
typedef short bf16x8 __attribute__((ext_vector_type(8)));
typedef short s16x4 __attribute__((ext_vector_type(4)));
typedef float f32x4 __attribute__((ext_vector_type(4)));
typedef float f32x16 __attribute__((ext_vector_type(16)));
typedef unsigned u32x4 __attribute__((ext_vector_type(4)));
typedef unsigned u32x2 __attribute__((ext_vector_type(2)));
using pg8::cvt_pk_bf16; using pg8::cvt_bf16; using pg8::pack8;

constexpr int BATCH = 4, SEQ = 4096, DM = 1024, MROWS = BATCH * SEQ, FF = 2816;
constexpr int NTHREADS = 512, NWAVES = 8;
constexpr int LDS_BYTES = 147456;
constexpr size_t MiB = 1u << 20;
constexpr size_t WS_SS = 0;
constexpr size_t WS_COS = 1 * MiB, WS_SIN = 1 * MiB + 512 * 1024;
constexpr size_t WS_SPAN = 2 * MiB;
constexpr size_t WS_BAR = 3 * MiB;
constexpr size_t WS_W = 4 * MiB;
constexpr size_t W_FFN_STRIDE = 17301504, W_FFN_DN = 11534336;
constexpr size_t W_REC = WS_W + 132 * MiB, W_REC_STRIDE = 6 * MiB + 512 * 1024, W_REC_G = 4 * MiB, W_REC_OUT = 4 * MiB + 512 * 1024;
constexpr size_t W_KV = WS_W + 145 * MiB, W_Q = WS_W + 149 * MiB, W_O = WS_W + 153 * MiB;
constexpr size_t WS_XB = 162 * MiB, WS_K = 194 * MiB, WS_VT = 226 * MiB, WS_H = 258 * MiB;
constexpr size_t WS_GG = WS_H, WS_REC = WS_H + 32 * MiB, WS_Y = WS_K;
constexpr size_t WS_QO = WS_H, WS_ASCR = WS_H + 32 * MiB;
constexpr size_t WS_O = WS_W;
constexpr size_t WS_XL = 346 * MiB;
constexpr size_t WS_END = 378 * MiB;

struct Params { const float* in[31]; float* out; unsigned char* ws; double invfreq[32]; float linit[2]; int ph_lo, ph_hi, rep_mask, pad; };
typedef const __attribute__((address_space(4))) Params CParams;

__device__ __forceinline__ float wave_sum(float v, int lane) {
#pragma unroll
    for (int o = 1; o < 64; o <<= 1) v += shx(v, o, lane);
    return v;
}
#define LDS_WAIT() asm volatile("s_waitcnt lgkmcnt(0)" ::: "memory")
#define LDS_BARRIER() asm volatile("s_waitcnt lgkmcnt(0)\n\ts_barrier" ::: "memory")

__device__ __forceinline__ void tr_item(const float* W, int ldw, const float* gain, bf16_t* WT, int K, int drow0, int k0, int n0, LAS float* scr, int lane) {
    float tv[32];
    const float* wp = W + (size_t)(k0 + (lane >> 5)) * ldw + n0 + (lane & 31);
#pragma unroll
    for (int i = 0; i < 32; ++i) tv[i] = __builtin_nontemporal_load(wp + (size_t)(2 * i) * ldw);
    if (gain) {
#pragma unroll
        for (int i = 0; i < 32; ++i) tv[i] *= gain[k0 + 2 * i + (lane >> 5)];
    }
#pragma unroll
    for (int i = 0; i < 32; ++i) scr[(2 * i + (lane >> 5)) * 33 + (lane & 31)] = tv[i];
    LDS_WAIT(); asm volatile("" ::: "memory");
    const int c = lane & 7;
#pragma unroll
    for (int j = 0; j < 4; ++j) { const int n = (lane >> 3) + 8 * j; const LAS float* s = scr + (8 * c) * 33 + n;
        u32x4 o; o.x = cvt_pk_bf16(s[0 * 33], s[1 * 33]); o.y = cvt_pk_bf16(s[2 * 33], s[3 * 33]); o.z = cvt_pk_bf16(s[4 * 33], s[5 * 33]); o.w = cvt_pk_bf16(s[6 * 33], s[7 * 33]);
        *(u32x4*)(WT + (size_t)(drow0 + n) * K + k0 + 8 * c) = o; }
    LDS_WAIT(); asm volatile("" ::: "memory");
}
__device__ __forceinline__ int headperm_row0(int n0) { const int sb = n0 >> 5, pn = sb >> 3, rem = sb & 7, wc = rem >> 1, bj = rem & 1; return pn * 256 + bj * 128 + wc * 32; }

__device__ __forceinline__ void prologue_item(CParams& P, int it, LAS float* scr, int lane) {
    unsigned char* ws = P.ws;
    if (it < 16 * 1408) {
        const int mi = it / 1408, r = it % 1408, f = mi >> 1, gu = mi & 1, layer = f >> 1, which = f & 1;
        const float* W = (which ? (gu ? P.in[7] : P.in[6]) : (gu ? P.in[3] : P.in[2])) + (size_t)layer * 1024 * 2816;
        const float* g = (which ? P.in[5] : P.in[1]) + layer * 1024;
        const int kb = r / 88, nb = r % 88, n0 = nb * 32;
        tr_item(W, 2816, g, (bf16_t*)(ws + WS_W + (size_t)f * W_FFN_STRIDE), 1024, (n0 >> 7) * 256 + (n0 & 127) + gu * 128, kb * 64, n0, scr, lane); return; }
    it -= 16 * 1408;
    if (it < 8 * 1408) {
        const int f = it / 1408, r = it % 1408, layer = f >> 1, which = f & 1;
        const float* W = (which ? P.in[8] : P.in[4]) + (size_t)layer * 2816 * 1024;
        const int kb = r / 32, nb = r % 32;
        tr_item(W, 1024, nullptr, (bf16_t*)(ws + WS_W + (size_t)f * W_FFN_STRIDE + W_FFN_DN), 2816, nb * 32, kb * 64, nb * 32, scr, lane); return; }
    it -= 8 * 1408;
    if (it < 2 * 1024) {
        const int a = it / 1024, r = it % 1024, kb = r / 64, nb = r % 64;
        tr_item(P.in[10] + (size_t)a * 1024 * 2048, 2048, P.in[9] + a * 1024, (bf16_t*)(ws + W_REC + (size_t)a * W_REC_STRIDE), 1024, nb * 32, kb * 64, nb * 32, scr, lane); return; }
    it -= 2 * 1024;
    if (it < 256) {
        const int mi = it / 8, r = it % 8, a = mi >> 4, g = (mi >> 3) & 1, blk = mi & 7, kb = r / 4, nb = r % 4;
        const float* W = (g ? P.in[15] : P.in[13]) + (size_t)(a * 8 + blk) * 128 * 128;
        tr_item(W, 128, nullptr, (bf16_t*)(ws + W_REC + (size_t)a * W_REC_STRIDE + W_REC_G) + (size_t)(blk * 2 + g) * 128 * 128, 128, nb * 32, kb * 64, nb * 32, scr, lane); return; }
    it -= 256;
    if (it < 2 * 512) {
        const int a = it / 512, r = it % 512, kb = r / 32, nb = r % 32;
        tr_item(P.in[18] + (size_t)a * 1024 * 1024, 1024, nullptr, (bf16_t*)(ws + W_REC + (size_t)a * W_REC_STRIDE + W_REC_OUT), 1024, nb * 32, kb * 64, nb * 32, scr, lane); return; }
    it -= 2 * 512;
    if (it < 2 * 512) {
        const int v = it / 512, r = it % 512, kb = r / 32, nb = r % 32, n0 = nb * 32;
        tr_item(v ? P.in[21] : P.in[20], 1024, P.in[19], (bf16_t*)(ws + W_KV), 1024, v ? 1024 + n0 : headperm_row0(n0), kb * 64, n0, scr, lane); return; }
    it -= 2 * 512;
    if (it < 2 * 512) {
        const int j = it / 512, r = it % 512, kb = r / 32, nb = r % 32, n0 = nb * 32;
        tr_item(P.in[25] + (size_t)j * 1024 * 1024, 1024, P.in[9] + (2 + j) * 1024, (bf16_t*)(ws + W_Q + (size_t)j * 2 * MiB), 1024, headperm_row0(n0), kb * 64, n0, scr, lane); return; }
    it -= 2 * 512;
    {
        const int j = it / 512, r = it % 512, kb = r / 32, nb = r % 32;
        tr_item(P.in[30] + (size_t)j * 1024 * 1024, 1024, nullptr, (bf16_t*)(ws + W_O + (size_t)j * 2 * MiB), 1024, nb * 32, kb * 64, nb * 32, scr, lane); }
}
__device__ __forceinline__ void ffn_item(CParams& P, int f, int j, LAS float* scr, int lane) { prologue_item(P, (j < 2816) ? f * 2816 + j : 16 * 1408 + f * 1408 + (j - 2816), scr, lane); }
constexpr int N_PRO_ITEMS = 16 * 1408 + 8 * 1408 + 2 * 1024 + 256 + 2 * 512 + 2 * 512 + 2 * 512 + 2 * 512;

__device__ __forceinline__ void prologue(CParams& P, LAS unsigned char* lds, int vcu, int G, const int tid) {
    const int lane = tid & 63, wave = __builtin_amdgcn_readfirstlane(tid >> 6);
    LAS float* scr = (LAS float*)(lds + wave * 16384);
    const int gw = vcu * NWAVES + wave, NGW = G * NWAVES;
    for (int it = gw; it < 4224 + (N_PRO_ITEMS - 24 * 1408); it += NGW) { if (it < 4224) ffn_item(P, 0, it, scr, lane); else prologue_item(P, 24 * 1408 + (it - 4224), scr, lane); }
    const float* x = P.in[0]; bf16_t* XB = (bf16_t*)(P.ws + WS_XB); unsigned char* XL = (unsigned char*)(P.ws + WS_XL); float* ss = (float*)(P.ws + WS_SS);
    for (int m = gw; m < MROWS; m += NGW) {
        const f32x4* xr = (const f32x4*)(x + (size_t)m * DM) + lane; u32x2* bo = (u32x2*)(XB + (size_t)m * DM) + lane; unsigned short* lo = (unsigned short*)(XL + (size_t)m * (DM / 2)) + lane;
        float s = 0.f;
#pragma unroll
        for (int j = 0; j < 4; ++j) { const f32x4 v = xr[64 * j]; s += (v[0] * v[0] + v[1] * v[1]) + (v[2] * v[2] + v[3] * v[3]);
            u32x2 w; w.x = cvt_pk_bf16(v[0], v[1]); w.y = cvt_pk_bf16(v[2], v[3]); bo[64 * j] = w;
            const unsigned q0 = lo4_enc(v[0], __uint_as_float(w.x << 16), (w.x >> 7) & 0xffu), q1 = lo4_enc(v[1], __uint_as_float(w.x & 0xffff0000u), (w.x >> 23) & 0xffu);
            const unsigned q2 = lo4_enc(v[2], __uint_as_float(w.y << 16), (w.y >> 7) & 0xffu), q3 = lo4_enc(v[3], __uint_as_float(w.y & 0xffff0000u), (w.y >> 23) & 0xffu);
            lo[64 * j] = (unsigned short)(q0 | (q1 << 4) | (q2 << 8) | (q3 << 12)); }
        s = wave_sum(s, lane);
        if (lane < 16) ss[(size_t)m * 16 + lane] = (lane == 0) ? s : 0.f;
    }
    float* cosT = (float*)(P.ws + WS_COS); float* sinT = (float*)(P.ws + WS_SIN);
    for (int idx = vcu * NTHREADS + tid; idx < SEQ * 32; idx += G * NTHREADS) {
        const int pos = idx >> 5, i = idx & 31; double f = 0.0;
#pragma unroll
        for (int k = 0; k < 32; ++k) f = (i == k) ? P.invfreq[k] : f;
        const double ang = (double)pos * f; const double kq = __builtin_rint(ang * 0.63661977236758134308); const double r = ang - kq * 1.57079632679489661923;
        const float rf = (float)r, rr = rf * rf;
        const float sr = rf * (1.0f + rr * (-1.6666667e-1f + rr * (8.3333333e-3f + rr * (-1.9841270e-4f + rr * 2.7557319e-6f))));
        const float cr = 1.0f + rr * (-0.5f + rr * (4.1666667e-2f + rr * (-1.3888889e-3f + rr * (2.4801587e-5f + rr * -2.7557319e-7f))));
        const int q = ((int)kq) & 3; const float sv = (q == 0) ? sr : (q == 1) ? cr : (q == 2) ? -sr : -cr; const float cv = (q == 0) ? cr : (q == 1) ? -sr : (q == 2) ? -cr : sr;
        cosT[idx] = cv; sinT[idx] = sv;
    }
}

constexpr int SC_XA = 0, SC_X32 = 17408, SC_BUF = 51200;
__device__ __forceinline__ int sc_rho(int t) { return 16 * ((t >> 2) & 3) + 4 * (t >> 4) + (t & 3); }
__device__ __forceinline__ float bf_lo(unsigned u) { return __uint_as_float(u << 16); }
__device__ __forceinline__ float bf_hi(unsigned u) { return __uint_as_float(u & 0xffff0000u); }
template <int PASS> __device__ __forceinline__ void scan_unit(CParams& P, LAS unsigned char* lds, int a, int b, int n, int sp, const int tid) {
    const int lane = tid & 63, w = __builtin_amdgcn_readfirstlane(tid >> 6), chl = lane & 15, fq = lane >> 4;
    const int ch = 128 * n + 16 * w + chl;
    const bf16_t* REC = (const bf16_t*)(P.ws + WS_REC); const bf16_t* GG = (const bf16_t*)(P.ws + WS_GG); bf16_t* Y = (bf16_t*)(P.ws + WS_Y);
    const bf16_t* GW = (const bf16_t*)(P.ws + W_REC + (size_t)a * W_REC_STRIDE + W_REC_G);
    float* spanA = (float*)(P.ws + WS_SPAN); float* spanH = spanA + BATCH * 8 * 1024;
    bf16x8 bfa[4], bfx[4];
#pragma unroll
    for (int ks = 0; ks < 4; ++ks) { bfa[ks] = *(const bf16x8*)(GW + ((size_t)(n * 2 + 0) * 128 + 16 * w + chl) * 128 + 32 * ks + 8 * fq); bfx[ks] = *(const bf16x8*)(GW + ((size_t)(n * 2 + 1) * 128 + 16 * w + chl) * 128 + 32 * ks + 8 * fq); }
    const float ba = P.in[14][a * 1024 + ch], bxb = P.in[16][a * 1024 + ch];
    const float lamv = P.in[17][a * 1024 + ch];
    const float c8 = -8.0f * log1pf(__expf(-lamv));
    float hc = 0.f, Asp = 1.f;
    if (PASS == 2) {
        float A2[7], H2[7];
#pragma unroll
        for (int s2 = 0; s2 < 7; ++s2) { A2[s2] = spanA[(size_t)(b * 8 + s2) * 1024 + ch]; H2[s2] = spanH[(size_t)(b * 8 + s2) * 1024 + ch]; }
#pragma unroll
        for (int s2 = 0; s2 < 7; ++s2) hc = (s2 < sp) ? (A2[s2] * hc + H2[s2]) : hc;
    }
    const int tp = tid >> 4, cg8 = tid & 15;
    const int rho0 = sc_rho(2 * tp), rho1 = sc_rho(2 * tp + 1);
    const float* cwp = P.in[11] + (size_t)a * 4 * 1024 + 128 * n + 8 * cg8; const float* cbp = P.in[12] + a * 1024 + 128 * n + 8 * cg8;
    const bf16_t* rbase = REC + ((size_t)(b * SEQ + sp * 512 + 2 * tp)) * 1024 + 128 * n + 8 * cg8;
    const bf16_t* gbase = GG + ((size_t)(b * SEQ + sp * 512 + 2 * tp)) * 1024 + 128 * n + 8 * cg8;
    bf16_t* ybase = Y + ((size_t)(b * SEQ + sp * 512 + 2 * tp)) * 1024 + 128 * n + 8 * cg8;
    f32x4 cwa[4], cwb[4];
#pragma unroll
    for (int k = 0; k < 4; ++k) { cwa[k] = *(const f32x4*)(cwp + k * 1024); cwb[k] = *(const f32x4*)(cwp + k * 1024 + 4); }
    const f32x4 cb0 = *(const f32x4*)cbp, cb1 = *(const f32x4*)(cbp + 4);
    u32x4 R[5], G0 = (u32x4){0u, 0u, 0u, 0u}, G1 = (u32x4){0u, 0u, 0u, 0u};
#define SC_LOAD(ci_) do { _Pragma("unroll") for (int k = 0; k < 5; ++k) { const int pos = sp * 512 + (ci_) * 64 + 2 * tp - 3 + k; R[k] = (u32x4){0u, 0u, 0u, 0u}; \
            if (pos >= 0) R[k] = *(const u32x4*)(rbase + ((ci_) * 64 - 3 + k) * 1024); } \
        if (PASS == 2) { G0 = *(const u32x4*)(gbase + (ci_) * 64 * 1024); G1 = *(const u32x4*)(gbase + ((ci_) * 64 + 1) * 1024); } } while (0)
    SC_LOAD(0);
    for (int ci = 0; ci < 8; ++ci) {
        LAS unsigned char* buf = lds + (ci & 1) * SC_BUF;
        LAS float* xf = (LAS float*)(buf + SC_X32);
        const u32x4 Gc0 = G0, Gc1 = G1;
        {
            float x0[8], x1[8];
#pragma unroll
            for (int e = 0; e < 4; ++e) { x0[e] = cb0[e]; x0[4 + e] = cb1[e]; x1[e] = cb0[e]; x1[4 + e] = cb1[e]; }
#pragma unroll
            for (int k = 0; k < 4; ++k) {
                const f32x4 wa = cwa[k], wb = cwb[k];
                const u32x4 ra = R[k], rb = R[k + 1];
                x0[0] += wa[0] * bf_lo(ra.x); x0[1] += wa[1] * bf_hi(ra.x); x0[2] += wa[2] * bf_lo(ra.y); x0[3] += wa[3] * bf_hi(ra.y);
                x0[4] += wb[0] * bf_lo(ra.z); x0[5] += wb[1] * bf_hi(ra.z); x0[6] += wb[2] * bf_lo(ra.w); x0[7] += wb[3] * bf_hi(ra.w);
                x1[0] += wa[0] * bf_lo(rb.x); x1[1] += wa[1] * bf_hi(rb.x); x1[2] += wa[2] * bf_lo(rb.y); x1[3] += wa[3] * bf_hi(rb.y);
                x1[4] += wb[0] * bf_lo(rb.z); x1[5] += wb[1] * bf_hi(rb.z); x1[6] += wb[2] * bf_lo(rb.w); x1[7] += wb[3] * bf_hi(rb.w);
            }
            u32x4 p0, p1; p0.x = cvt_pk_bf16(x0[0], x0[1]); p0.y = cvt_pk_bf16(x0[2], x0[3]); p0.z = cvt_pk_bf16(x0[4], x0[5]); p0.w = cvt_pk_bf16(x0[6], x0[7]);
            p1.x = cvt_pk_bf16(x1[0], x1[1]); p1.y = cvt_pk_bf16(x1[2], x1[3]); p1.z = cvt_pk_bf16(x1[4], x1[5]); p1.w = cvt_pk_bf16(x1[6], x1[7]);
            *(LAS u32x4*)(buf + SC_XA + rho0 * 272 + cg8 * 16) = p0; *(LAS u32x4*)(buf + SC_XA + rho1 * 272 + cg8 * 16) = p1;
            *(LAS f32x4*)(xf + rho0 * 132 + cg8 * 8) = (f32x4){x0[0], x0[1], x0[2], x0[3]}; *(LAS f32x4*)(xf + rho0 * 132 + cg8 * 8 + 4) = (f32x4){x0[4], x0[5], x0[6], x0[7]};
            *(LAS f32x4*)(xf + rho1 * 132 + cg8 * 8) = (f32x4){x1[0], x1[1], x1[2], x1[3]}; *(LAS f32x4*)(xf + rho1 * 132 + cg8 * 8 + 4) = (f32x4){x1[4], x1[5], x1[6], x1[7]};
        }
        if (ci + 1 < 8) SC_LOAD(ci + 1);
        LDS_BARRIER();
        f32x4 ga[4], gx[4];
#pragma unroll
        for (int mt = 0; mt < 4; ++mt) { ga[mt] = (f32x4){0.f, 0.f, 0.f, 0.f}; gx[mt] = (f32x4){0.f, 0.f, 0.f, 0.f};
#pragma unroll
            for (int ks = 0; ks < 4; ++ks) { const bf16x8 af = *(const LAS bf16x8*)(buf + SC_XA + (16 * mt + chl) * 272 + (32 * ks + 8 * fq) * 2);
                ga[mt] = __builtin_amdgcn_mfma_f32_16x16x32_bf16(af, bfa[ks], ga[mt], 0, 0, 0); gx[mt] = __builtin_amdgcn_mfma_f32_16x16x32_bf16(af, bfx[ks], gx[mt], 0, 0, 0); } }
        LAS float* xl = xf + (4 * fq) * 132 + 16 * w + chl;
        float Pm[16], hl[16]; float p = 1.f, hh = 0.f;
#pragma unroll
        for (int mt = 0; mt < 4; ++mt)
#pragma unroll
            for (int r = 0; r < 4; ++r) {
                const float xv = xl[(16 * mt + r) * 132];
                const float rg = __builtin_amdgcn_rcpf(1.0f + __expf(-(ga[mt][r] + ba))), ig = __builtin_amdgcn_rcpf(1.0f + __expf(-(gx[mt][r] + bxb)));
                const float la = c8 * rg, t2 = 2.0f * la, av = __expf(la);
                const float poly = -t2 * (1.0f + t2 * (0.5f + t2 * (1.6666667e-1f + t2 * (4.1666667e-2f + t2 * (8.3333333e-3f + t2 * 1.3888889e-3f)))));
                const float om = (t2 > -0.25f) ? poly : (1.0f - av * av);
                const float bxv = __builtin_amdgcn_sqrtf(om) * ig * xv;
                p *= av; hh = av * hh + bxv; Pm[4 * mt + r] = p; hl[4 * mt + r] = hh;
            }
        float IA = p, IH = hh;
        float pA = shl_from(IA, (lane - 16) & 63), pH = shl_from(IH, (lane - 16) & 63); if (fq >= 1) { IH = IA * pH + IH; IA = IA * pA; }
        pA = shl_from(IA, (lane - 32) & 63); pH = shl_from(IH, (lane - 32) & 63); if (fq >= 2) { IH = IA * pH + IH; IA = IA * pA; }
        float EA = shl_from(IA, (lane - 16) & 63), EH = shl_from(IH, (lane - 16) & 63); if (fq == 0) { EA = 1.f; EH = 0.f; }
        const float TA = shl_from(IA, 48 + chl), TH = shl_from(IH, 48 + chl);
        const float hstart = EA * hc + EH;
        hc = TA * hc + TH; Asp *= TA;
        if (PASS == 2) {
#pragma unroll
            for (int mt = 0; mt < 4; ++mt)
#pragma unroll
                for (int r = 0; r < 4; ++r) xl[(16 * mt + r) * 132] = hl[4 * mt + r] + Pm[4 * mt + r] * hstart;
            LDS_BARRIER();
            const f32x4 h00 = *(const LAS f32x4*)(xf + rho0 * 132 + cg8 * 8), h01 = *(const LAS f32x4*)(xf + rho0 * 132 + cg8 * 8 + 4);
            const f32x4 h10 = *(const LAS f32x4*)(xf + rho1 * 132 + cg8 * 8), h11 = *(const LAS f32x4*)(xf + rho1 * 132 + cg8 * 8 + 4);
            u32x4 y0, y1;
            y0.x = cvt_pk_bf16(bf_lo(Gc0.x) * h00[0], bf_hi(Gc0.x) * h00[1]); y0.y = cvt_pk_bf16(bf_lo(Gc0.y) * h00[2], bf_hi(Gc0.y) * h00[3]);
            y0.z = cvt_pk_bf16(bf_lo(Gc0.z) * h01[0], bf_hi(Gc0.z) * h01[1]); y0.w = cvt_pk_bf16(bf_lo(Gc0.w) * h01[2], bf_hi(Gc0.w) * h01[3]);
            y1.x = cvt_pk_bf16(bf_lo(Gc1.x) * h10[0], bf_hi(Gc1.x) * h10[1]); y1.y = cvt_pk_bf16(bf_lo(Gc1.y) * h10[2], bf_hi(Gc1.y) * h10[3]);
            y1.z = cvt_pk_bf16(bf_lo(Gc1.z) * h11[0], bf_hi(Gc1.z) * h11[1]); y1.w = cvt_pk_bf16(bf_lo(Gc1.w) * h11[2], bf_hi(Gc1.w) * h11[3]);
            *(u32x4*)(ybase + (size_t)(ci * 64) * 1024) = y0; *(u32x4*)(ybase + (size_t)(ci * 64 + 1) * 1024) = y1;
        }
    }
#undef SC_LOAD
    if (PASS == 1 && fq == 0) { spanA[(size_t)(b * 8 + sp) * 1024 + ch] = Asp; spanH[(size_t)(b * 8 + sp) * 1024 + ch] = hc; }
    __syncthreads();
}

constexpr int AT_K1 = 0, AT_K2 = 9216, AT_V = 18432, AT_BUF = 36864, AT_Q = 2 * AT_BUF, AT_QW = 8704;
__device__ __forceinline__ int crow(int r, int hi) { return (r & 3) + 8 * (r >> 2) + 4 * hi; }
__device__ __forceinline__ void attn_map(const LAS unsigned char* Kb, const LAS unsigned char* Vb, const LAS unsigned char* Qc, f32x16 (&o)[4], float& lsum, const int q, const int hi) {
    u32x4 pw[4];
    const LAS unsigned char* kq = Kb + q * 144 + hi * 16;
#pragma unroll
    for (int blk = 0; blk < 2; ++blk) {
        f32x16 p;
#pragma unroll
        for (int r = 0; r < 16; ++r) p[r] = 0.f;
        bf16x8 kf[2], qf[2];
#define AT_KQ(ds) do { kf[(ds) & 1] = *(const LAS bf16x8*)(kq + blk * (32 * 144) + (ds) * 32); qf[(ds) & 1] = *(const LAS bf16x8*)(Qc + (ds) * 32); } while (0)
        AT_KQ(0); AT_KQ(1);
        __builtin_amdgcn_sched_barrier(0);
#pragma unroll
        for (int ds = 0; ds < 4; ++ds) { p = __builtin_amdgcn_mfma_f32_32x32x16_bf16(kf[ds & 1], qf[ds & 1], p, 0, 0, 0); if (ds + 2 < 4) AT_KQ(ds + 2); __builtin_amdgcn_sched_barrier(0); }
#undef AT_KQ
        float sa = 0.f;
#pragma unroll
        for (int r = 0; r < 16; ++r) { p[r] = __builtin_amdgcn_exp2f(p[r]); sa += p[r]; }
        lsum += sa;
#pragma unroll
        for (int e = 0; e < 4; ++e) { pw[2 * blk][e] = cvt_pk_bf16(p[2 * e], p[2 * e + 1]); pw[2 * blk + 1][e] = cvt_pk_bf16(p[8 + 2 * e], p[8 + 2 * e + 1]); }
        __builtin_amdgcn_sched_barrier(0);
    }
    {   bf16x8 vf[4];
        const LAS unsigned char* vq = Vb + q * 144 + hi * 16;
#define AT_VREAD(i) do { vf[(i) & 3] = *(const LAS bf16x8*)(vq + ((i) >> 2) * (32 * 144) + ((i) & 3) * 32); } while (0)
        AT_VREAD(0); AT_VREAD(1); AT_VREAD(2); AT_VREAD(3);
        __builtin_amdgcn_sched_barrier(0);
#pragma unroll
        for (int i = 0; i < 16; ++i) {
            o[i >> 2] = __builtin_amdgcn_mfma_f32_32x32x16_bf16(__builtin_bit_cast(bf16x8, pw[i & 3]), vf[i & 3], o[i >> 2], 0, 0, 0);
            if (i + 4 < 16) AT_VREAD(i + 4);
            __builtin_amdgcn_sched_barrier(0);
        }
#undef AT_VREAD
    }
}
__device__ __forceinline__ void attn_unit(CParams& P, LAS unsigned char* lds, int b, int h, int qb, int j, float lam, float linit, const int tid_in) {
    int tid = tid_in; asm volatile("" : "+v"(tid));
    const int lane = tid & 63, w = __builtin_amdgcn_readfirstlane(tid >> 6), q = lane & 31, hi = lane >> 5;
    const bf16_t* Q = (const bf16_t*)(P.ws + WS_QO); bf16_t* O = (bf16_t*)(P.ws + WS_O);
    const bf16_t* Kg = (const bf16_t*)(P.ws + WS_K); const bf16_t* VT = (const bf16_t*)(P.ws + WS_VT);
    const int NT = 4 * qb + 4, mylast = 4 * qb + (w >> 1);
    const int row0 = b * SEQ + qb * 256 + 32 * w;
    LAS unsigned char* Qw = lds + AT_Q + w * AT_QW;
    {
        const bf16_t* qsrc = Q + (size_t)(row0 + (lane >> 4)) * 1024 + h * 128 + (lane & 15) * 8;
        u32x4 qv[8];
#pragma unroll
        for (int i = 0; i < 8; ++i) qv[i] = *(const u32x4*)(qsrc + (size_t)(4 * i) * 1024);
#pragma unroll
        for (int i = 0; i < 8; ++i) *(LAS u32x4*)(Qw + ((lane >> 4) + 4 * i) * 272 + (lane & 15) * 16) = qv[i];
    }
    const LAS unsigned char* Qc0 = Qw + q * 272 + hi * 16;
    f32x16 o1[4], o2[4];
#pragma unroll
    for (int d = 0; d < 4; ++d)
#pragma unroll
        for (int r = 0; r < 16; ++r) { o1[d][r] = 0.f; o2[d][r] = 0.f; }
    float l1 = 0.f, l2 = 0.f;
#define AT_ADDR() \
    const int kr = tid >> 4, kc16 = tid & 15; \
    const unsigned koff = (unsigned)(((b * SEQ + kr) * 1024 + h * 128 + kc16 * 8) * 2);          \
    const int kdst = ((kc16 < 8) ? AT_K1 : AT_K2) + kr * 144 + (kc16 & 7) * 16;              \
    const int dv0 = tid >> 3, kc = tid & 7; \
    const unsigned voff = (unsigned)((((b * 8 + h) * 128 + dv0) * 4096 + kc * 8) * 2);           \
    const int vdst = AT_V + dv0 * 144 + 32 * (kc >> 1) + 8 * (kc & 1);
    u32x4 rk0, rk1, rv0, rv1;
#define AT_LOAD(t) do { const unsigned ko_ = koff + (unsigned)(t) * 131072u, vo_ = voff + (unsigned)(t) * 128u; \
        rk0 = *(const u32x4*)((const char*)Kg + ko_); rk1 = *(const u32x4*)((const char*)Kg + (ko_ + 65536u)); \
        rv0 = *(const u32x4*)((const char*)VT + vo_); rv1 = *(const u32x4*)((const char*)VT + (vo_ + 524288u)); } while (0)
#define AT_WRITE(Bp) do { LAS unsigned char* B_ = (Bp); *(LAS u32x4*)(B_ + kdst) = rk0; *(LAS u32x4*)(B_ + kdst + 32 * 144) = rk1; \
        *(LAS u32x2*)(B_ + vdst) = (u32x2){rv0.x, rv0.y}; *(LAS u32x2*)(B_ + vdst + 16) = (u32x2){rv0.z, rv0.w}; \
        *(LAS u32x2*)(B_ + vdst + 64 * 144) = (u32x2){rv1.x, rv1.y}; *(LAS u32x2*)(B_ + vdst + 64 * 144 + 16) = (u32x2){rv1.z, rv1.w}; } while (0)
    {   AT_ADDR()
        AT_LOAD(0);
        AT_WRITE(lds);
        LDS_BARRIER();
        for (int kt = 0; kt <= mylast; ++kt) {
            { const int tn_ = (kt + 1 < NT) ? kt + 1 : NT - 1; AT_LOAD(tn_); }
            const LAS unsigned char* B_ = lds + (kt & 1) * AT_BUF;
            attn_map(B_ + AT_K1, B_ + AT_V, Qc0, o1, l1, q, hi);
            attn_map(B_ + AT_K2, B_ + AT_V, Qc0 + 128, o2, l2, q, hi);
            AT_WRITE(lds + ((kt + 1) & 1) * AT_BUF);
            LDS_BARRIER();
        }
    }
    { unsigned z_ = 0u; asm volatile("" : "+v"(z_)); tid = (w << 6) + (int)__builtin_amdgcn_mbcnt_hi(~0u, __builtin_amdgcn_mbcnt_lo(~0u, z_)); }
    {   AT_ADDR()
        for (int kt = mylast + 1; kt < NT; ++kt) {
            { const int tn_ = (kt + 1 < NT) ? kt + 1 : NT - 1; AT_LOAD(tn_); }
            AT_WRITE(lds + ((kt + 1) & 1) * AT_BUF);
            LDS_BARRIER();
        }
    }
#undef AT_ADDR
#undef AT_LOAD
#undef AT_WRITE
    asm volatile("" : "+v"(tid));
    const int lane_e = tid & 63, q_e = lane_e & 31, hi_e = lane_e >> 5;
    l1 += shx(l1, 32, lane_e); l2 += shx(l2, 32, lane_e);
    LAS float* wl = (LAS float*)(Qw + 4608);
    if (hi_e == 0) { wl[q_e] = 1.0f / l1; wl[32 + q_e] = -lam / l2; }
    const LAS float* wlh = wl + 4 * hi_e;
    const float* gs = P.in[29] + j * 128;
    float gsv[4];
#pragma unroll
    for (int d = 0; d < 4; ++d) gsv[d] = gs[32 * d + q_e] * (1.0f - linit);
    bf16_t* obase2 = O + (size_t)(row0 + (lane_e >> 4)) * 1024 + h * 128 + (lane_e & 15) * 8;
    LAS unsigned char* stg = Qw;
#pragma unroll
    for (int r4 = 0; r4 < 4; ++r4) {
        f32x4 la, lb;
#pragma unroll
        for (int e = 0; e < 4; ++e) { la[e] = wlh[e + 8 * r4]; lb[e] = wlh[32 + e + 8 * r4]; }
#pragma unroll
        for (int e = 0; e < 4; ++e) {
            float df[4]; float sq = 0.f;
#pragma unroll
            for (int d = 0; d < 4; ++d) { df[d] = o1[d][4 * r4 + e] * la[e] + o2[d][4 * r4 + e] * lb[e]; sq += df[d] * df[d]; }
            sq += shx(sq, 1, lane_e); sq += shx(sq, 2, lane_e); sq += shx(sq, 4, lane_e); sq += shx(sq, 8, lane_e); sq += shx(sq, 16, lane_e);
            const float rinv = __builtin_amdgcn_rsqf(sq * (1.0f / 128.0f) + 1e-5f);
            LAS unsigned short* sr = (LAS unsigned short*)(stg + ((e + 8 * (r4 & 1) + 4 * hi_e) * 288) + q_e * 2);
#pragma unroll
            for (int d = 0; d < 4; ++d) sr[32 * d] = cvt_bf16(df[d] * rinv * gsv[d]);
        }
        if (r4 & 1) {
            LDS_WAIT();
#pragma unroll
            for (int i = 0; i < 4; ++i) {
                const u32x4 v = *(const LAS u32x4*)(stg + ((lane_e >> 4) + 4 * i) * 288 + (lane_e & 15) * 16);
                bf16_t* op = obase2; asm volatile("" : "+v"(op));
                *(u32x4*)(op + (size_t)(16 * (r4 >> 1) + 4 * i) * 1024) = v; }
            LDS_WAIT();
        }
    }
    __syncthreads();
}

#define XB_TMO      128
#define XB_XCNT(j)  (256  + 64 * (j))
#define XB_XSUB(j)  (1280 + 64 * (j))
#define XB_XGEN(j)  (2304 + 64 * (j))
#define XB_TOP      3328
#define XB_TOPGEN   3392
#define XCD_BAR_WORDS 3456
#define XB_SPIN_CAP (1u << 18)

__device__ __forceinline__ unsigned xb_ld(unsigned* p)              { return __hip_atomic_load(p, __ATOMIC_RELAXED, __HIP_MEMORY_SCOPE_AGENT); }
__device__ __forceinline__ unsigned xb_add(unsigned* p, unsigned v) { return __hip_atomic_fetch_add(p, v, __ATOMIC_RELAXED, __HIP_MEMORY_SCOPE_AGENT); }
__device__ __forceinline__ unsigned xb_xcc_id() { return (unsigned)__builtin_amdgcn_s_getreg((3 << 11) | 20) & 0xFu; }
#define XB_SPIN(cond, bar) do { unsigned _sp = 0; while (cond) { __builtin_amdgcn_s_sleep(1); \
    if ((++_sp & 255u) == 0u) { if (xb_ld(&(bar)[XB_TMO])) break; if (_sp > XB_SPIN_CAP) { atomicAdd(&(bar)[XB_TMO], 1u); break; } } } } while (0)

struct XcdBarrier {
    unsigned* bar; unsigned x;
    volatile LAS unsigned* st;
};

__device__ __forceinline__ XcdBarrier xcd_barrier_post(unsigned* bar, volatile LAS unsigned* st) {
    XcdBarrier b; b.bar = bar; b.x = xb_xcc_id(); b.st = st;
    if (threadIdx.x == 0) (void)xb_add(&bar[XB_XCNT(b.x)], 1u);
    return b;
}
__device__ __forceinline__ void xcd_barrier_complete(unsigned* bar, unsigned x, unsigned& nloc, unsigned& nx) {
    const unsigned G = gridDim.x * gridDim.y * gridDim.z;
    unsigned sum, cnt, mine, sp = 0u;
    for (;;) {
        sum = 0u; cnt = 0u; mine = 0u;
#pragma unroll
        for (unsigned j = 0; j < 16; ++j) { const unsigned c = xb_ld(&bar[XB_XCNT(j)]); sum += c; cnt += (c > 0u) ? 1u : 0u; mine = (j == x) ? c : mine; }
        if (sum == G) break;
        __builtin_amdgcn_s_sleep(1);
        if ((++sp & 255u) == 0u) { if (xb_ld(&bar[XB_TMO])) break; if (sp > XB_SPIN_CAP) { atomicAdd(&bar[XB_TMO], 1u); break; } }
    }
    nloc = mine > 0u ? mine : 1u; nx = cnt > 0u ? cnt : 1u;
}

__device__ __forceinline__ void xcd_barrier(const XcdBarrier& b, const bool is_t0) {
    asm volatile("s_waitcnt vmcnt(0)" ::: "memory");
    __syncthreads();
    if (is_t0) {
        unsigned* bar = b.bar;
        __builtin_amdgcn_s_waitcnt(0);
        unsigned nloc = b.st[0], nx = b.st[1];
        if (nloc == 0u) { xcd_barrier_complete(bar, b.x, nloc, nx); b.st[0] = nloc; b.st[1] = nx; }
        const unsigned old = xb_add(&bar[XB_XSUB(b.x)], 1u);
        const unsigned gen = old / nloc;
        if (old + 1u == (gen + 1u) * nloc) {
            __builtin_amdgcn_fence(__ATOMIC_RELEASE, "agent");
            asm volatile("s_waitcnt vmcnt(0)" ::: "memory");
            const unsigned og = xb_add(&bar[XB_TOP], 1u);
            const unsigned tg = og / nx;
            if (og + 1u == (tg + 1u) * nx) xb_add(&bar[XB_TOPGEN], 1u);
            else XB_SPIN(xb_ld(&bar[XB_TOPGEN]) == tg, bar);
            __builtin_amdgcn_fence(__ATOMIC_ACQUIRE, "agent");
            xb_add(&bar[XB_XGEN(b.x)], 1u);
            asm volatile("s_waitcnt vmcnt(0)" ::: "memory");
        } else {
            XB_SPIN(xb_ld(&bar[XB_XGEN(b.x)]) == gen, bar);
            __builtin_amdgcn_fence(__ATOMIC_ACQUIRE, "agent");
            asm volatile("s_waitcnt vmcnt(0)" ::: "memory");
        }
    }
    __syncthreads();
}


__device__ __forceinline__ pg8::RsCache make_rs_cache(LAS unsigned char* lds, const float* ss, int N, const int tid) {
    pg8::StaticOrder S; S.init(MROWS, N, (int)gridDim.x, (int)blockIdx.x); pg8::Unit u0; u0.pm = 0; u0.pn = 0; const bool any = S.next(0, u0);
    LAS float* tab = (LAS float*)(lds + LDS_BYTES - 1024);
    if (any && tid < 256) tab[tid] = pg8::row_rs(ss, u0.pm * 256 + tid);
    __syncthreads();
    return pg8::RsCache{tab, any ? u0.pm : -1, ss};
}
template <class Epi> __device__ __forceinline__ void run_gemm(LAS unsigned char* lds, const bf16_t* A, const bf16_t* Bt, int N, int K, const Epi& E, const int tid) {
    pg8::Gemm g{A, Bt, MROWS, N, K}; pg8::StaticOrder S; S.init(MROWS, N, (int)gridDim.x, (int)blockIdx.x);
    pg8::gemm_phase<Epi, pg8::StaticOrder, true, true>(lds, g, S, E, tid);
}
enum { OP_PRO = 0, OP_UP, OP_DOWN, OP_RECIN, OP_SCAN1, OP_SCAN2, OP_RECOUT, OP_KV, OP_QG, OP_ATTN, OP_WO };
constexpr int N_STEPS = 32;

__global__ void __launch_bounds__(NTHREADS) mega_fwd(Params P0) {
    extern __shared__ __attribute__((aligned(16))) unsigned char lds_raw[];
    LAS unsigned char* lds = (LAS unsigned char*)lds_raw;
    cg::grid_group grid = cg::this_grid();
    volatile LAS unsigned* bar_st = (volatile LAS unsigned*)(lds + LDS_BYTES - 2048);
    if (threadIdx.x < 2) bar_st[threadIdx.x] = 0u;
    __syncthreads();
    XcdBarrier xbar = xcd_barrier_post((unsigned*)(P0.ws + WS_BAR), bar_st);
    const int wave_s = __builtin_amdgcn_readfirstlane(threadIdx.x >> 6);
    auto mk_tid = [&]() -> int { unsigned z = 0u; asm volatile("" : "+v"(z)); return (wave_s << 6) + (int)__builtin_amdgcn_mbcnt_hi(~0u, __builtin_amdgcn_mbcnt_lo(~0u, z)); };
#define MK_TID() mk_tid()
    const int G = gridDim.x, bx = blockIdx.x, vcu = (G % 8 == 0) ? (bx % 8) * (G / 8) + bx / 8 : bx;
    for (int st = P0.ph_lo; st < P0.ph_hi; ++st) {
        int op, layer = 0, f = 0;
        if (st == 0) op = OP_PRO;
        else if (st <= 16) { const int k = (st - 1) & 7; layer = (st - 1) >> 3; f = layer * 2 + (k >= 6);
            op = (k == 0 || k == 6) ? OP_UP : (k == 1 || k == 7) ? OP_DOWN : (k == 2) ? OP_RECIN : (k == 3) ? OP_SCAN1 : (k == 4) ? OP_SCAN2 : OP_RECOUT; }
        else if (st == 17) { op = OP_KV; layer = 2; }
        else { const int q = st - 18, k = q % 7; layer = 2 + q / 7; f = layer * 2 + (k >= 5);
            op = (k == 0 || k == 5) ? OP_UP : (k == 1 || k == 6) ? OP_DOWN : (k == 2) ? OP_QG : (k == 3) ? OP_ATTN : OP_WO; }
        if (st > P0.ph_lo && st != 18) { if (P0.rep_mask & 0x4000) grid.sync(); else xcd_barrier(xbar, MK_TID() == 0); if (P0.rep_mask & 0x8000) { xcd_barrier(xbar, MK_TID() == 0); xcd_barrier(xbar, MK_TID() == 0); } }
        const int a = layer, jl = layer - 2;
#ifndef OPMASK
#define OPMASK 0xFFFF
#endif
#define HAS(o) ((OPMASK >> (o)) & 1)
#ifndef PROBE_REP_MASK
#define PROBE_REP_MASK 0
#endif
        const int nrep = ((P0.rep_mask >> op) & 1) ? 2 : 1;
        for (int rep = 0; rep < nrep; ++rep) {
        if (rep) xcd_barrier(xbar, MK_TID() == 0);
#define STEP_LOCALS() int tid = MK_TID(); asm volatile("" : "+v"(tid)); CParams* Pp = (CParams*)__builtin_amdgcn_kernarg_segment_ptr(); asm volatile("" : "+s"(Pp)); CParams& P = *Pp; \
        unsigned char* ws = P.ws; asm volatile("" : "+s"(ws)); bf16_t* XB = (bf16_t*)(ws + WS_XB); float* ss = (float*)(ws + WS_SS); bf16_t* HB = (bf16_t*)(ws + WS_H); (void)XB; (void)ss; (void)HB; (void)tid;
        switch (op) {
        case OP_PRO: if (HAS(0)) { STEP_LOCALS() prologue(P, lds, vcu, G, tid); } break;
        case OP_UP: if (HAS(1)) { STEP_LOCALS() pg8::EpiSwiglu E{HB, make_rs_cache(lds, ss, 5632, tid)}; run_gemm(lds, XB, (const bf16_t*)(ws + WS_W + (size_t)f * W_FFN_STRIDE), 5632, 1024, E, tid);
            if (f < 7 && G == 256 && rep == 0) {
                if (bx >= 128) { const int lane = tid & 63, wave = __builtin_amdgcn_readfirstlane(tid >> 6); LAS float* scr = (LAS float*)(lds + wave * 16384);
                    for (int it = (bx - 128) * NWAVES + wave; it < 4224; it += 128 * NWAVES) ffn_item(P, f + 1, it, scr, lane); }
            } else if (f < 7 && rep == 0) { const int lane = tid & 63, wave = __builtin_amdgcn_readfirstlane(tid >> 6); LAS float* scr = (LAS float*)(lds + wave * 16384);
                for (int it = vcu * NWAVES + wave; it < 4224; it += G * NWAVES) ffn_item(P, f + 1, it, scr, lane); }
        } break;
        case OP_DOWN: case OP_RECOUT: case OP_WO: if (HAS(2)) { STEP_LOCALS()
            const bf16_t* A = (op == OP_DOWN) ? HB : (op == OP_RECOUT) ? (const bf16_t*)(ws + WS_Y) : (const bf16_t*)(ws + WS_O);
            const bf16_t* Bt = (op == OP_DOWN) ? (const bf16_t*)(ws + WS_W + (size_t)f * W_FFN_STRIDE + W_FFN_DN) : (op == OP_RECOUT) ? (const bf16_t*)(ws + W_REC + (size_t)a * W_REC_STRIDE + W_REC_OUT) : (const bf16_t*)(ws + W_O + (size_t)jl * 2 * MiB);
            pg8::EpiResid E{(st == N_STEPS - 1) ? P.out : nullptr, XB, (unsigned char*)(ws + WS_XL), ss, __uint_as_float((op == OP_DOWN) ? 0x3f000000u : 0x3f800000u)}; run_gemm(lds, A, Bt, 1024, (op == OP_DOWN) ? 2816 : 1024, E, tid); } break;
        case OP_RECIN: if (HAS(3)) { STEP_LOCALS() pg8::EpiRecIn E{(bf16_t*)(ws + WS_GG), (bf16_t*)(ws + WS_REC), make_rs_cache(lds, ss, 2048, tid)}; run_gemm(lds, XB, (const bf16_t*)(ws + W_REC + (size_t)a * W_REC_STRIDE), 2048, 1024, E, tid); } break;
        case OP_SCAN1: if (HAS(4)) { STEP_LOCALS() for (int u = vcu; u < 256; u += G) scan_unit<1>(P, lds, a, u >> 6, (u >> 3) & 7, u & 7, tid); } break;
        case OP_SCAN2: if (HAS(5)) { STEP_LOCALS() for (int u = vcu; u < 256; u += G) scan_unit<2>(P, lds, a, u >> 6, (u >> 3) & 7, u & 7, tid); } break;
        case OP_KV: case OP_QG: if (HAS(7)) { STEP_LOCALS()
            const bool kv = (op == OP_KV);
            pg8::EpiQK E{kv ? (bf16_t*)(ws + WS_K) : (bf16_t*)(ws + WS_QO), (bf16_t*)(ws + WS_VT), make_rs_cache(lds, ss, kv ? 2048 : 1024, tid), kv ? P.in[22] : P.in[26] + jl * 64, (const float*)(ws + WS_COS), (const float*)(ws + WS_SIN), kv ? 1.0f : 0.125f * 1.4426950408889634f};
            run_gemm(lds, XB, kv ? (const bf16_t*)(ws + W_KV) : (const bf16_t*)(ws + W_Q + (size_t)jl * 2 * MiB), kv ? 2048 : 1024, 1024, E, tid); } break;
        case OP_ATTN: if (HAS(9)) { STEP_LOCALS()
            const int tid_a = MK_TID();
            const int lane = tid_a & 63;
            const float q1 = P.in[27][jl * 64 + lane], q2 = P.in[28][jl * 64 + lane], k1 = P.in[23][lane], k2 = P.in[24][lane];
            const float linit = jl ? P.linit[1] : P.linit[0];
            const float lam = __uint_as_float(__builtin_amdgcn_readfirstlane(__float_as_uint(__expf(wave_sum(q1 * k1, lane)) - __expf(wave_sum(q2 * k2, lane)) + linit)));
            for (int pr = vcu; pr < 256; pr += G) { const int bh = pr >> 3, s = pr & 7;
#pragma unroll 1
                for (int uu = 0; uu < 2; ++uu) attn_unit(P, lds, bh >> 3, bh & 7, uu ? s : 15 - s, jl, lam, linit, tid_a); }
        } break;
        }
        }
    }
}

#ifndef MK_PER_STEP
#define MK_PER_STEP 0
#endif
extern "C" void kernel_launch(void* const* d_in, const int* in_sizes, int n_in, void* d_out, int out_size, void* d_ws, size_t ws_size, hipStream_t stream) {
    static int grid = 0;
    if (grid == 0) {
        int dev = 0, cus = 0, per_cu = 0;
        if (n_in != 31 || out_size != MROWS * DM || ws_size < WS_END) { fprintf(stderr, "kernel_launch: unexpected shapes (n_in %d out %d ws %zu)\n", n_in, out_size, ws_size); grid = -1; return; }
        hipGetDevice(&dev); hipDeviceGetAttribute(&cus, hipDeviceAttributeMultiprocessorCount, dev);
        hipFuncSetAttribute((const void*)mega_fwd, hipFuncAttributeMaxDynamicSharedMemorySize, LDS_BYTES);
        hipOccupancyMaxActiveBlocksPerMultiprocessor(&per_cu, (const void*)mega_fwd, NTHREADS, LDS_BYTES);
        (void)hipGetLastError();
        if (per_cu < 1) per_cu = 1;
        grid = cus * 1;
        if (grid <= 0) grid = 256;
    }
    if (grid < 0) return;
    Params p{};
    for (int i = 0; i < 31; ++i) p.in[i] = (const float*)d_in[i];
    p.out = (float*)d_out; p.ws = (unsigned char*)d_ws; p.rep_mask = PROBE_REP_MASK;
    p.linit[0] = (float)(0.8 - 0.6 * std::exp(-0.3 * 2.0)); p.linit[1] = (float)(0.8 - 0.6 * std::exp(-0.3 * 3.0));
    for (int i = 0; i < 32; ++i) p.invfreq[i] = std::pow(10000.0, -(double)(2 * i) / 64.0);
    (void)hipMemsetAsync((char*)d_ws + WS_BAR, 0, 16384, stream);
#if MK_PER_STEP
    for (int st = 0; st < N_STEPS; ++st) { p.ph_lo = st; p.ph_hi = st + 1; hipLaunchKernelGGL(mega_fwd, dim3(grid), dim3(NTHREADS), LDS_BYTES, stream, p); }
#else
    p.ph_lo = 0; p.ph_hi = N_STEPS;
    void* args[] = {&p};
    hipError_t e = hipLaunchCooperativeKernel((const void*)mega_fwd, dim3(grid), dim3(NTHREADS), args, LDS_BYTES, stream);
    if (e != hipSuccess) fprintf(stderr, "cooperative launch failed: %s (grid %d)\n", hipGetErrorString(e), grid);
#endif
}
```

```cpp
#include <hip/hip_runtime.h>
#include <hip/hip_cooperative_groups.h>
#include <cstdio>
#include <cstdint>
#include <cmath>
namespace cg = cooperative_groups;
__device__ __forceinline__ float shx(float v, int k, int lane) { return __int_as_float(__builtin_amdgcn_ds_bpermute((lane ^ k) << 2, __float_as_int(v))); }
__device__ __forceinline__ float shl_from(float v, int src) { return __int_as_float(__builtin_amdgcn_ds_bpermute(src << 2, __float_as_int(v))); }
__device__ __forceinline__ unsigned lo4_enc(float x, float hif, unsigned e) { const float inv = (e >= 12u) ? __uint_as_float((265u - e) << 23) : 0.f; float q = rintf((x - hif) * inv) + 8.f; q = fminf(fmaxf(q, 0.f), 15.f); return (unsigned)q; }
__device__ __forceinline__ float lo4_dec(unsigned nib, unsigned e) { const float sc = (e >= 12u) ? __uint_as_float((e - 11u) << 23) : 0.f; return ((float)nib - 8.f) * sc; }
namespace pg8 {
#define PG8_LAS __attribute__((address_space(3)))
typedef unsigned short bf16_t;
typedef short bf16x8 __attribute__((ext_vector_type(8)));
typedef float f32x4 __attribute__((ext_vector_type(4)));
typedef unsigned u32x4 __attribute__((ext_vector_type(4)));
constexpr int BM = 256, BK = 64, HALF = 128, HTB = HALF * BK * 2  , STAGE_BYTES = 8 * HTB, NXCD = 8, WGM = 8;

__host__ __device__ __forceinline__ int lds_byte(int r, int c) { const int st = (r >> 4) * 2 + (c >> 5), rr = r & 15, cc = c & 31, ob = rr * 64 + cc * 2; return st * 1024 + (ob ^ (((ob >> 9) & 1) << 5)); }
__host__ __device__ __forceinline__ void stage_rc(int b, int& R, int& C) { const int st = b / 1024, sb = b % 1024, swz = sb ^ (((sb >> 9) & 1) << 5); R = (st >> 1) * 16 + swz / 64; C = (st & 1) * 32 + (swz % 64) / 2; }
__host__ __device__ __forceinline__ int perm32(int rho) { const int n = rho >> 4, i = rho & 15; return 8 * (i >> 2) + 4 * n + (i & 3); }

struct Unit { int pm, pn; };
struct Gemm { const bf16_t* A; const bf16_t* Bt; int M, N, K; };

struct StaticOrder {
    int nM, nN, nwg, G, c;
    __host__ __device__ void init(int M, int N, int G_, int c_) { nM = M / BM; nN = N / BM; nwg = nM * nN; G = G_; c = c_; }
    __host__ __device__ bool next(int i, Unit& u) const {
        const long L = (long)i * G + c; if (L >= nwg) return false;
        int wgid = (int)L; { const int q = nwg / NXCD, r = nwg % NXCD, xcd = wgid % NXCD, off = wgid / NXCD; wgid = (xcd < r ? xcd * (q + 1) : r * (q + 1) + (xcd - r) * q) + off; }
        const int nig = WGM * nN, gid = wgid / nig, fm = gid * WGM, gsz = (nM - fm) < WGM ? (nM - fm) : WGM;
        u.pm = fm + ((wgid % nig) % gsz); u.pn = (wgid % nig) / gsz; return true;
    }
    __device__ __forceinline__ void a_ready(const Unit&) const {}
    __device__ __forceinline__ void done(const Unit&) const {}
};
typedef unsigned u32x4 __attribute__((ext_vector_type(4)));
__device__ __forceinline__ unsigned cvt_pk_bf16(float lo, float hi) { unsigned r; asm volatile("v_cvt_pk_bf16_f32 %0, %1, %2" : "=v"(r) : "v"(lo), "v"(hi)); return r; }
__device__ __forceinline__ unsigned short cvt_bf16(float v) { return (unsigned short)(cvt_pk_bf16(v, 0.f) & 0xffffu); }
__device__ __forceinline__ u32x4 pack8(const f32x4 a, const f32x4 b) { u32x4 w; w.x = cvt_pk_bf16(a[0], a[1]); w.y = cvt_pk_bf16(a[2], a[3]); w.z = cvt_pk_bf16(b[0], b[1]); w.w = cvt_pk_bf16(b[2], b[3]); return w; }
__device__ __forceinline__ float row_rs(const float* ss, int row) {
    const f32x4* p = (const f32x4*)(ss + (size_t)row * 16);
    const f32x4 a = p[0], b = p[1], c = p[2], d = p[3];
    const float s = (((a[0] + a[1]) + (a[2] + a[3])) + ((b[0] + b[1]) + (b[2] + b[3]))) + (((c[0] + c[1]) + (c[2] + c[3])) + ((d[0] + d[1]) + (d[2] + d[3])));
    return __builtin_amdgcn_rsqf(s * (1.0f / 1024.0f) + 1e-6f);
}
__device__ __forceinline__ float silu_f(float g) { return g * __builtin_amdgcn_rcpf(1.0f + __builtin_amdgcn_exp2f(-1.4426950408889634f * g)); }
__device__ __forceinline__ float gelu_tanh_f(float v) { const float t = 0.7978845608028654f * (v + 0.044715f * v * v * v); return v * __builtin_amdgcn_rcpf(1.0f + __builtin_amdgcn_exp2f(-2.0f * 1.4426950408889634f * t)); }

struct RsCache { const PG8_LAS float* tab; int pm0; const float* ss;
    __device__ __forceinline__ float get(int pm, int lrow) const { return (pm == pm0) ? tab[lrow] : row_rs(ss, pm * BM + lrow); } };
struct EpiSwiglu {
    static constexpr bool PERM = true, AFTER_DRAIN = false;
    bf16_t* H; RsCache rc;
    typedef float f32x2 __attribute__((ext_vector_type(2)));
    static __device__ __forceinline__ f32x2 sw2(f32x2 g, f32x2 u, float c1, float rs2) {
        const f32x2 t = g * c1; f32x2 e; e.x = __builtin_amdgcn_exp2f(t.x); e.y = __builtin_amdgcn_exp2f(t.y);
        const f32x2 d = e + 1.0f; f32x2 r; r.x = __builtin_amdgcn_rcpf(d.x); r.y = __builtin_amdgcn_rcpf(d.y);
        return (g * u) * (r * rs2);
    }
    __device__ __forceinline__ void operator()(const f32x4 (&acc)[2][2][4][2], const Unit& u, int wr, int wc, int fr, int fq) const {
        const int col0 = u.pn * 128 + wc * 32 + 8 * fq;
        float rsv[2][4];
#pragma unroll
        for (int ai = 0; ai < 2; ++ai)
#pragma unroll
            for (int m = 0; m < 4; ++m) rsv[ai][m] = rc.get(u.pm, ai * HALF + wr * 64 + m * 16 + fr);
#pragma unroll
        for (int ai = 0; ai < 2; ++ai)
#pragma unroll
            for (int m = 0; m < 4; ++m) {
                const int row = u.pm * BM + ai * HALF + wr * 64 + m * 16 + fr; const float rs = rsv[ai][m], c1 = -1.4426950408889634f * rs, rs2 = rs * rs;
                const f32x4 g0 = acc[ai][0][m][0], g1 = acc[ai][0][m][1], u0 = acc[ai][1][m][0], u1 = acc[ai][1][m][1];
                const f32x2 a = sw2((f32x2){g0[0], g0[1]}, (f32x2){u0[0], u0[1]}, c1, rs2), b = sw2((f32x2){g0[2], g0[3]}, (f32x2){u0[2], u0[3]}, c1, rs2);
                const f32x2 c = sw2((f32x2){g1[0], g1[1]}, (f32x2){u1[0], u1[1]}, c1, rs2), d = sw2((f32x2){g1[2], g1[3]}, (f32x2){u1[2], u1[3]}, c1, rs2);
                u32x4 w; w.x = cvt_pk_bf16(a.x, a.y); w.y = cvt_pk_bf16(b.x, b.y); w.z = cvt_pk_bf16(c.x, c.y); w.w = cvt_pk_bf16(d.x, d.y);
                *(u32x4*)(H + (size_t)row * 2816 + col0) = w;
            }
    }
};
struct EpiResid {
    static constexpr bool PERM = true, AFTER_DRAIN = false;
    typedef unsigned u32x2 __attribute__((ext_vector_type(2)));
    float* OUT; bf16_t* XB; unsigned char* XL; float* ss; float alpha;
    __device__ __forceinline__ void operator()(const f32x4 (&acc)[2][2][4][2], const Unit& u, int wr, int wc, int fr, int fq) const {
        const int col0 = u.pn * BM + wc * 32 + 8 * fq;
        const size_t off0 = (size_t)(u.pm * BM + wr * 64 + fr) * 1024 + col0;
#pragma unroll
        for (int ai = 0; ai < 2; ++ai) {
            u32x4 hin[4][2]; unsigned lin[4][2];
#pragma unroll
            for (int m = 0; m < 4; ++m)
#pragma unroll
                for (int bj = 0; bj < 2; ++bj) { const size_t o = off0 + (size_t)(ai * HALF + m * 16) * 1024 + bj * HALF; hin[m][bj] = *(const u32x4*)(XB + o); lin[m][bj] = *(const unsigned*)(XL + (o >> 1)); }
            __builtin_amdgcn_sched_barrier(0);
#pragma unroll
            for (int m = 0; m < 4; ++m) {
                const int row = u.pm * BM + ai * HALF + wr * 64 + m * 16 + fr; float sq = 0.f;
#pragma unroll
                for (int bj = 0; bj < 2; ++bj) {
                    const size_t o = off0 + (size_t)(ai * HALF + m * 16) * 1024 + bj * HALF;
                    const u32x4 h = hin[m][bj]; const unsigned l = lin[m][bj];
                    float xv[8];
#pragma unroll
                    for (int k = 0; k < 8; ++k) { const unsigned wd = h[k >> 1]; const float hif = (k & 1) ? __uint_as_float(wd & 0xffff0000u) : __uint_as_float(wd << 16);
                        const unsigned ex = (k & 1) ? ((wd >> 23) & 0xffu) : ((wd >> 7) & 0xffu); const unsigned by = (l >> (4 * k)) & 0xfu;
                        xv[k] = hif + lo4_dec(by, ex) + acc[ai][bj][m][k >> 2][k & 3] * alpha; }
                    const f32x4 x0 = (f32x4){xv[0], xv[1], xv[2], xv[3]}, x1 = (f32x4){xv[4], xv[5], xv[6], xv[7]};
                    if (OUT) { *(f32x4*)(OUT + o) = x0; *(f32x4*)(OUT + o + 4) = x1; }
                    else {
#pragma unroll
                        for (int k = 0; k < 8; ++k) sq += xv[k] * xv[k];
                        const u32x4 hn = pack8(x0, x1);
                        unsigned ln = 0u;
#pragma unroll
                        for (int k = 0; k < 8; ++k) { const unsigned wd = hn[k >> 1]; const float hif = (k & 1) ? __uint_as_float(wd & 0xffff0000u) : __uint_as_float(wd << 16);
                            const unsigned ex = (k & 1) ? ((wd >> 23) & 0xffu) : ((wd >> 7) & 0xffu); ln |= lo4_enc(xv[k], hif, ex) << (4 * k); }
                        *(u32x4*)(XB + o) = hn; *(unsigned*)(XL + (o >> 1)) = ln;
                    }
                }
                if (!OUT) { { const int ln_ = fr + 16 * fq; sq += shx(sq, 16, ln_); sq += shx(sq, 32, ln_); }
                    if (fq == 0) ss[(size_t)row * 16 + u.pn * 4 + wc] = sq; }
            }
        }
    }
};
struct EpiRecIn {
    static constexpr bool PERM = true, AFTER_DRAIN = false;
    bf16_t* GG; bf16_t* REC; RsCache rc;
    __device__ __forceinline__ void operator()(const f32x4 (&acc)[2][2][4][2], const Unit& u, int wr, int wc, int fr, int fq) const {
        const bool isgate = u.pn < 4; bf16_t* dst = isgate ? GG : REC; const int col0 = (u.pn & 3) * BM + wc * 32 + 8 * fq;
#pragma unroll
        for (int ai = 0; ai < 2; ++ai)
#pragma unroll
            for (int m = 0; m < 4; ++m) {
                const int row = u.pm * BM + ai * HALF + wr * 64 + m * 16 + fr; const float rs = rc.get(u.pm, ai * HALF + wr * 64 + m * 16 + fr);
#pragma unroll
                for (int bj = 0; bj < 2; ++bj) {
                    f32x4 v0 = acc[ai][bj][m][0] * rs, v1 = acc[ai][bj][m][1] * rs;
                    if (isgate) {
#pragma unroll
                        for (int j = 0; j < 4; ++j) { v0[j] = gelu_tanh_f(v0[j]); v1[j] = gelu_tanh_f(v1[j]); }
                    }
                    *(u32x4*)(dst + (size_t)row * 1024 + col0 + bj * HALF) = pack8(v0, v1);
                }
            }
    }
};
struct EpiQK {
    static constexpr bool PERM = true, AFTER_DRAIN = false;
    bf16_t* QK; bf16_t* VT; RsCache rc; const float* gain; const float* cosT; const float* sinT; float oscale;
    __device__ __forceinline__ void operator()(const f32x4 (&acc)[2][2][4][2], const Unit& u, int wr, int wc, int fr, int fq) const {
        if (u.pn < 4) {
            const int hh = u.pn * 4 + wc;
            f32x4 glo[2], ghi[2];
#pragma unroll
            for (int n = 0; n < 2; ++n) { glo[n] = *(const f32x4*)(gain + 8 * fq + 4 * n); ghi[n] = *(const f32x4*)(gain + 32 + 8 * fq + 4 * n); }
#pragma unroll
            for (int ai = 0; ai < 2; ++ai)
#pragma unroll
                for (int m = 0; m < 4; ++m) {
                    const int row = u.pm * BM + ai * HALF + wr * 64 + m * 16 + fr; const float rs = rc.get(u.pm, ai * HALF + wr * 64 + m * 16 + fr); const int pos = row & 4095;
                    f32x4 v[2][2]; float sq = 0.f;
#pragma unroll
                    for (int bj = 0; bj < 2; ++bj)
#pragma unroll
                        for (int n = 0; n < 2; ++n) { v[bj][n] = acc[ai][bj][m][n] * rs; const f32x4 t = v[bj][n]; sq += (t[0] * t[0] + t[1] * t[1]) + (t[2] * t[2] + t[3] * t[3]); }
                    { const int ln_ = fr + 16 * fq; sq += shx(sq, 16, ln_); sq += shx(sq, 32, ln_); }
                    const float rinv = __builtin_amdgcn_rsqf(sq * (1.0f / 64.0f) + 1e-6f);
                    f32x4 olo[2], ohi[2];
#pragma unroll
                    for (int n = 0; n < 2; ++n) {
                        const f32x4 c = *(const f32x4*)(cosT + (size_t)pos * 32 + 8 * fq + 4 * n), s = *(const f32x4*)(sinT + (size_t)pos * 32 + 8 * fq + 4 * n);
                        const f32x4 ylo = v[0][n] * rinv * glo[n], yhi = v[1][n] * rinv * ghi[n];
                        olo[n] = (ylo * c - yhi * s) * oscale; ohi[n] = (yhi * c + ylo * s) * oscale;
                    }
                    bf16_t* dp = QK + (size_t)row * 1024 + hh * 64 + 8 * fq;
                    *(u32x4*)dp = pack8(olo[0], olo[1]); *(u32x4*)(dp + 32) = pack8(ohi[0], ohi[1]);
                }
        } else {
#pragma unroll
            for (int ai = 0; ai < 2; ++ai)
#pragma unroll
                for (int m = 0; m < 4; ++m) {
                    const int row = u.pm * BM + ai * HALF + wr * 64 + m * 16 + fr; const float rs = rc.get(u.pm, ai * HALF + wr * 64 + m * 16 + fr); const int b = row >> 12, s = row & 4095;
#pragma unroll
                    for (int bj = 0; bj < 2; ++bj)
#pragma unroll
                        for (int n = 0; n < 2; ++n)
#pragma unroll
                            for (int j = 0; j < 4; ++j) {
                                const int col = (u.pn - 4) * BM + bj * HALF + wc * 32 + 8 * fq + 4 * n + j;
                                VT[((size_t)(b * 1024 + col)) * 4096 + s] = cvt_bf16(acc[ai][bj][m][n][j] * rs);
                            }
                }
        }
    }
};

template <class Epi, class Sched, bool ALIGN_EPI = false, bool SP2 = false>
__device__ __forceinline__ void gemm_phase(PG8_LAS unsigned char* lds, const Gemm g, const Sched& S, const Epi& E, const int tid) {
    const int wid = __builtin_amdgcn_readfirstlane(tid >> 6), lane = tid & 63, wr = wid >> 2, wc = wid & 3, fr = lane & 15, fq = lane >> 4;
    const int K = g.K, nt = K / BK;
    unsigned voffA[2], voffB[2];
#pragma unroll
    for (int i = 0; i < 2; ++i) { int R, C; stage_rc(tid * 16 + i * 8192, R, C); const int Rb = Epi::PERM ? ((R & ~31) + perm32(R & 31)) : R;
        voffA[i] = (unsigned)(R * K + C) * 2u; voffB[i] = (unsigned)(Rb * K + C) * 2u; }
    const size_t kstep = (size_t)(BK * 2);
    const size_t hstep = (size_t)HALF * K * 2;
    const size_t tstep = 2 * hstep;
    const unsigned ldsw = (unsigned)wid * 1024u;
    const int aoff = lds_byte(wr * 64 + fr, fq * 8), boff = lds_byte(wc * 32 + fr, fq * 8);
#define PG8_SA(b, h) (((b) * 2 + (h)) * HTB)
#define PG8_SB(b, h) ((4 + (b) * 2 + (h)) * HTB)
#define PG8_STAGE(bufoff, gbase, voff) do { _Pragma("unroll") for (int _i = 0; _i < 2; ++_i) \
        __builtin_amdgcn_global_load_lds((const unsigned*)((const char*)(gbase) + (voff)[_i]), (PG8_LAS unsigned*)(lds + (bufoff) + ldsw + _i * 8192), 16, 0, 0); } while (0)
#define PG8_LDA(dst, b, h) do { _Pragma("unroll") for (int m = 0; m < 4; ++m) _Pragma("unroll") for (int k = 0; k < 2; ++k) dst[m][k] = *(const PG8_LAS bf16x8*)(lds + PG8_SA(b, h) + aoff + m * 2048 + k * 1024); } while (0)
#define PG8_LDB(dst, b, h) do { _Pragma("unroll") for (int n = 0; n < 2; ++n) _Pragma("unroll") for (int k = 0; k < 2; ++k) dst[n][k] = *(const PG8_LAS bf16x8*)(lds + PG8_SB(b, h) + boff + n * 2048 + k * 1024); } while (0)
#define PG8_MMA(ai, bj, At, Bt) do { __builtin_amdgcn_s_setprio(1); _Pragma("unroll") for (int m = 0; m < 4; ++m) _Pragma("unroll") for (int n = 0; n < 2; ++n) _Pragma("unroll") for (int k = 0; k < 2; ++k) \
        acc[ai][bj][m][n] = __builtin_amdgcn_mfma_f32_16x16x32_bf16(Bt[n][k], At[m][k], acc[ai][bj][m][n], 0, 0, 0); __builtin_amdgcn_s_setprio(0); } while (0)
#define PG8_WAIT_V(n) asm volatile("s_waitcnt vmcnt(" #n ")" ::: "memory")
#define PG8_WAIT_L(n) asm volatile("s_waitcnt lgkmcnt(" #n ")" ::: "memory")
#define PG8_BAR __builtin_amdgcn_s_barrier()
#define PG8_SCHED __builtin_amdgcn_sched_barrier(0)
    Unit cur, nxt; int ui = 0;
    if (!S.next(0, cur)) return;
    f32x4 acc[2][2][4][2];
#pragma unroll
    for (int a = 0; a < 2; ++a)
#pragma unroll
        for (int b = 0; b < 2; ++b)
#pragma unroll
            for (int m = 0; m < 4; ++m)
#pragma unroll
                for (int n = 0; n < 2; ++n) acc[a][b][m][n] = (f32x4){0.f, 0.f, 0.f, 0.f};
    bf16x8 At[4][2], B0[2][2], B1[2][2];
    const char* cA = (const char*)g.A + (size_t)cur.pm * tstep; const char* cB = (const char*)g.Bt + (size_t)cur.pn * tstep;
    S.a_ready(cur);
    if constexpr (SP2) {
        PG8_STAGE(PG8_SB(0, 0), cB, voffB); PG8_STAGE(PG8_SB(0, 1), cB + hstep, voffB); PG8_STAGE(PG8_SA(0, 0), cA, voffA); PG8_STAGE(PG8_SA(0, 1), cA + hstep, voffA);
        if (wr == 1) PG8_BAR;
        PG8_WAIT_V(2); PG8_BAR;
        PG8_STAGE(PG8_SB(1, 0), cB + kstep, voffB); PG8_STAGE(PG8_SA(1, 0), cA + kstep, voffA); PG8_STAGE(PG8_SB(1, 1), cB + hstep + kstep, voffB);
        PG8_WAIT_V(6); PG8_BAR;
    } else {
        PG8_STAGE(PG8_SB(0, 0), cB, voffB); PG8_STAGE(PG8_SA(0, 0), cA, voffA); PG8_STAGE(PG8_SB(0, 1), cB + hstep, voffB); PG8_STAGE(PG8_SA(0, 1), cA + hstep, voffA);
        if (wr == 1) PG8_BAR;
        PG8_WAIT_V(4); PG8_BAR;
        PG8_STAGE(PG8_SB(1, 0), cB + kstep, voffB); PG8_STAGE(PG8_SA(1, 0), cA + kstep, voffA); PG8_STAGE(PG8_SB(1, 1), cB + hstep + kstep, voffB);
        PG8_WAIT_V(6); PG8_BAR;
    }
    for (;;) {
        const bool has_next = S.next(ui + 1, nxt);
        const char* nA = has_next ? (const char*)g.A + (size_t)nxt.pm * tstep : cA; const char* nB = has_next ? (const char*)g.Bt + (size_t)nxt.pn * tstep : cB;
        for (int t = 0; t < nt; t += 2) {
            const bool last = (t == nt - 2);
            const char* a1 = cA + (size_t)(t + 1) * kstep;
            const char* a2 = last ? nA : cA + (size_t)(t + 2) * kstep; const char* b2 = last ? nB : cB + (size_t)(t + 2) * kstep;
            const char* a3 = a2 + kstep; const char* b3 = b2 + kstep;
            if (last && has_next) S.a_ready(nxt);
            if constexpr (SP2) {
            PG8_LDB(B0, 0, 0); PG8_LDB(B1, 0, 1); PG8_SCHED; PG8_LDA(At, 0, 0); PG8_STAGE(PG8_SA(1, 1), a1 + hstep, voffA);
            PG8_WAIT_V(8); PG8_WAIT_L(0); PG8_BAR; PG8_MMA(0, 0, At, B0); PG8_MMA(0, 1, At, B1); PG8_BAR; PG8_SCHED;
            PG8_LDA(At, 0, 1); PG8_STAGE(PG8_SB(0, 0), b2, voffB); PG8_STAGE(PG8_SB(0, 1), b2 + hstep, voffB); PG8_STAGE(PG8_SA(0, 0), a2, voffA);
            PG8_WAIT_V(8); PG8_WAIT_L(0); PG8_BAR; PG8_MMA(1, 0, At, B0); PG8_MMA(1, 1, At, B1); PG8_BAR; PG8_SCHED;
            PG8_LDB(B0, 1, 0); PG8_LDB(B1, 1, 1); PG8_SCHED; PG8_LDA(At, 1, 0); PG8_STAGE(PG8_SA(0, 1), a2 + hstep, voffA);
            PG8_WAIT_V(8); PG8_WAIT_L(0); PG8_BAR; PG8_MMA(0, 0, At, B0); PG8_MMA(0, 1, At, B1); PG8_BAR; PG8_SCHED;
            PG8_LDA(At, 1, 1); PG8_STAGE(PG8_SB(1, 0), b3, voffB); PG8_STAGE(PG8_SB(1, 1), b3 + hstep, voffB); PG8_STAGE(PG8_SA(1, 0), a3, voffA);
            PG8_WAIT_V(8); PG8_WAIT_L(0); PG8_BAR; PG8_MMA(1, 0, At, B0); PG8_MMA(1, 1, At, B1); PG8_BAR; PG8_SCHED;
            } else {
            PG8_LDB(B0, 0, 0); PG8_SCHED; PG8_LDA(At, 0, 0); PG8_STAGE(PG8_SA(1, 1), a1 + hstep, voffA);
            PG8_WAIT_L(8); PG8_BAR; PG8_WAIT_L(0); PG8_MMA(0, 0, At, B0); PG8_BAR; PG8_SCHED;
            PG8_LDB(B1, 0, 1); PG8_STAGE(PG8_SB(0, 0), b2, voffB);
            PG8_BAR; PG8_WAIT_L(0); PG8_MMA(0, 1, At, B1); PG8_BAR;
            PG8_LDA(At, 0, 1); PG8_STAGE(PG8_SA(0, 0), a2, voffA);
            PG8_BAR; PG8_WAIT_L(0); PG8_MMA(1, 0, At, B0); PG8_BAR; PG8_SCHED;
            PG8_STAGE(PG8_SB(0, 1), b2 + hstep, voffB);
            PG8_WAIT_V(6); PG8_BAR; PG8_MMA(1, 1, At, B1); PG8_BAR;
            PG8_LDB(B0, 1, 0); PG8_SCHED; PG8_LDA(At, 1, 0); PG8_STAGE(PG8_SA(0, 1), a2 + hstep, voffA);
            PG8_WAIT_L(8); PG8_BAR; PG8_WAIT_L(0); PG8_MMA(0, 0, At, B0); PG8_BAR; PG8_SCHED;
            PG8_LDB(B1, 1, 1); PG8_STAGE(PG8_SB(1, 0), b3, voffB);
            PG8_BAR; PG8_WAIT_L(0); PG8_MMA(0, 1, At, B1); PG8_BAR;
            PG8_LDA(At, 1, 1); PG8_STAGE(PG8_SA(1, 0), a3, voffA);
            PG8_BAR; PG8_WAIT_L(0); PG8_MMA(1, 0, At, B0); PG8_BAR; PG8_SCHED;
            PG8_STAGE(PG8_SB(1, 1), b3 + hstep, voffB);
            PG8_WAIT_V(6); PG8_BAR; PG8_MMA(1, 1, At, B1); PG8_BAR;
            }
        }
        if constexpr (ALIGN_EPI) { if (wr == 0) PG8_BAR; }
        if constexpr (!Epi::AFTER_DRAIN) { E(acc, cur, wr, wc, fr, fq); S.done(cur); }
        if (!has_next) break;
#pragma unroll
        for (int a = 0; a < 2; ++a)
#pragma unroll
            for (int b = 0; b < 2; ++b)
#pragma unroll
                for (int m = 0; m < 4; ++m)
#pragma unroll
                    for (int n = 0; n < 2; ++n) acc[a][b][m][n] = (f32x4){0.f, 0.f, 0.f, 0.f};
        cur = nxt; cA = nA; cB = nB; ++ui;
        if constexpr (ALIGN_EPI) { if (wr == 1) PG8_BAR; }
    }
    PG8_WAIT_V(0);
    if constexpr (!ALIGN_EPI) { if (wr == 0) PG8_BAR; }
    PG8_BAR;
    if constexpr (Epi::AFTER_DRAIN) { E.fused(acc, cur, wr, wc, fr, fq, lds, wid, lane); S.done(cur); }
#undef PG8_SA
#undef PG8_SB
#undef PG8_STAGE
#undef PG8_LDA
#undef PG8_LDB
#undef PG8_MMA
#undef PG8_WAIT_V
#undef PG8_WAIT_L
#undef PG8_BAR
#undef PG8_SCHED
}
}
#define LAS __attribute__((address_space(3)))
typedef unsigned short bf16_t;
typedef short bf16x8 __attribute__((ext_vector_type(8)));
typedef short s16x4 __attribute__((ext_vector_type(4)));
typedef float f32x4 __attribute__((ext_vector_type(4)));
typedef float f32x16 __attribute__((ext_vector_type(16)));
typedef unsigned u32x4 __attribute__((ext_vector_type(4)));
typedef unsigned u32x2 __attribute__((ext_vector_type(2)));
using pg8::cvt_pk_bf16; using pg8::cvt_bf16; using pg8::pack8;

constexpr int BATCH = 4, SEQ = 4096, DM = 1024, MROWS = BATCH * SEQ, FF = 2816;
constexpr int NTHREADS = 512, NWAVES = 8;
constexpr int LDS_BYTES = 147456;
constexpr size_t MiB = 1u << 20;
constexpr size_t WS_SS = 0;
constexpr size_t WS_COS = 1 * MiB, WS_SIN = 1 * MiB + 512 * 1024;
constexpr size_t WS_SPAN = 2 * MiB;
constexpr size_t WS_BAR = 3 * MiB;
constexpr size_t WS_W = 4 * MiB;
constexpr size_t W_FFN_STRIDE = 17301504, W_FFN_DN = 11534336;
constexpr size_t W_REC = WS_W + 132 * MiB, W_REC_STRIDE = 6 * MiB + 512 * 1024, W_REC_G = 4 * MiB, W_REC_OUT = 4 * MiB + 512 * 1024;
constexpr size_t W_KV = WS_W + 145 * MiB, W_Q = WS_W + 149 * MiB, W_O = WS_W + 153 * MiB;
constexpr size_t WS_XB = 162 * MiB, WS_K = 194 * MiB, WS_VT = 226 * MiB, WS_H = 258 * MiB;
constexpr size_t WS_GG = WS_H, WS_REC = WS_H + 32 * MiB, WS_Y = WS_K;
constexpr size_t WS_QO = WS_H, WS_ASCR = WS_H + 32 * MiB;
constexpr size_t WS_O = WS_W;
constexpr size_t WS_XL = 346 * MiB;
constexpr size_t WS_END = 378 * MiB;

struct Params { const float* in[31]; float* out; unsigned char* ws; double invfreq[32]; float linit[2]; int ph_lo, ph_hi, rep_mask, pad; };
typedef const __attribute__((address_space(4))) Params CParams;

__device__ __forceinline__ float wave_sum(float v, int lane) {
#pragma unroll
    for (int o = 1; o < 64; o <<= 1) v += shx(v, o, lane);
    return v;
}
#define LDS_WAIT() asm volatile("s_waitcnt lgkmcnt(0)" ::: "memory")
#define LDS_BARRIER() asm volatile("s_waitcnt lgkmcnt(0)\n\ts_barrier" ::: "memory")

__device__ __forceinline__ void tr_item(const float* W, int ldw, const float* gain, bf16_t* WT, int K, int drow0, int k0, int n0, LAS float* scr, int lane) {
    f32x4 tv[8];
    const float* wp = W + (size_t)(k0 + (lane >> 3)) * ldw + n0 + (lane & 7) * 4;
#pragma unroll
    for (int i = 0; i < 8; ++i) tv[i] = __builtin_nontemporal_load((const f32x4*)(wp + (size_t)(8 * i) * ldw));
    if (gain) {
#pragma unroll
        for (int i = 0; i < 8; ++i) tv[i] = tv[i] * gain[k0 + 8 * i + (lane >> 3)];
    }
#pragma unroll
    for (int i = 0; i < 8; ++i) { LAS float* sp_ = scr + (8 * i + (lane >> 3)) * 33 + (lane & 7) * 4; sp_[0] = tv[i][0]; sp_[1] = tv[i][1]; sp_[2] = tv[i][2]; sp_[3] = tv[i][3]; }
    LDS_WAIT(); asm volatile("" ::: "memory");
    const int c = lane & 7;
#pragma unroll
    for (int j = 0; j < 4; ++j) { const int n = (lane >> 3) + 8 * j; const LAS float* s = scr + (8 * c) * 33 + n;
        u32x4 o; o.x = cvt_pk_bf16(s[0 * 33], s[1 * 33]); o.y = cvt_pk_bf16(s[2 * 33], s[3 * 33]); o.z = cvt_pk_bf16(s[4 * 33], s[5 * 33]); o.w = cvt_pk_bf16(s[6 * 33], s[7 * 33]);
        *(u32x4*)(WT + (size_t)(drow0 + n) * K + k0 + 8 * c) = o; }
    LDS_WAIT(); asm volatile("" ::: "memory");
}
__device__ __forceinline__ int headperm_row0(int n0) { const int sb = n0 >> 5, pn = sb >> 3, rem = sb & 7, wc = rem >> 1, bj = rem & 1; return pn * 256 + bj * 128 + wc * 32; }

__device__ __forceinline__ void prologue_item(CParams& P, int it, LAS float* scr, int lane) {
    unsigned char* ws = P.ws;
    if (it < 16 * 1408) {
        const int mi = it / 1408, r = it % 1408, f = mi >> 1, gu = mi & 1, layer = f >> 1, which = f & 1;
        const float* W = (which ? (gu ? P.in[7] : P.in[6]) : (gu ? P.in[3] : P.in[2])) + (size_t)layer * 1024 * 2816;
        const float* g = (which ? P.in[5] : P.in[1]) + layer * 1024;
        const int kb = r / 88, nb = r % 88, n0 = nb * 32;
        tr_item(W, 2816, g, (bf16_t*)(ws + WS_W + (size_t)f * W_FFN_STRIDE), 1024, (n0 >> 7) * 256 + (n0 & 127) + gu * 128, kb * 64, n0, scr, lane); return; }
    it -= 16 * 1408;
    if (it < 8 * 1408) {
        const int f = it / 1408, r = it % 1408, layer = f >> 1, which = f & 1;
        const float* W = (which ? P.in[8] : P.in[4]) + (size_t)layer * 2816 * 1024;
        const int kb = r / 32, nb = r % 32;
        tr_item(W, 1024, nullptr, (bf16_t*)(ws + WS_W + (size_t)f * W_FFN_STRIDE + W_FFN_DN), 2816, nb * 32, kb * 64, nb * 32, scr, lane); return; }
    it -= 8 * 1408;
    if (it < 2 * 1024) {
        const int a = it / 1024, r = it % 1024, kb = r / 64, nb = r % 64;
        tr_item(P.in[10] + (size_t)a * 1024 * 2048, 2048, P.in[9] + a * 1024, (bf16_t*)(ws + W_REC + (size_t)a * W_REC_STRIDE), 1024, nb * 32, kb * 64, nb * 32, scr, lane); return; }
    it -= 2 * 1024;
    if (it < 256) {
        const int mi = it / 8, r = it % 8, a = mi >> 4, g = (mi >> 3) & 1, blk = mi & 7, kb = r / 4, nb = r % 4;
        const float* W = (g ? P.in[15] : P.in[13]) + (size_t)(a * 8 + blk) * 128 * 128;
        tr_item(W, 128, nullptr, (bf16_t*)(ws + W_REC + (size_t)a * W_REC_STRIDE + W_REC_G) + (size_t)(blk * 2 + g) * 128 * 128, 128, nb * 32, kb * 64, nb * 32, scr, lane); return; }
    it -= 256;
    if (it < 2 * 512) {
        const int a = it / 512, r = it % 512, kb = r / 32, nb = r % 32;
        tr_item(P.in[18] + (size_t)a * 1024 * 1024, 1024, nullptr, (bf16_t*)(ws + W_REC + (size_t)a * W_REC_STRIDE + W_REC_OUT), 1024, nb * 32, kb * 64, nb * 32, scr, lane); return; }
    it -= 2 * 512;
    if (it < 2 * 512) {
        const int v = it / 512, r = it % 512, kb = r / 32, nb = r % 32, n0 = nb * 32;
        tr_item(v ? P.in[21] : P.in[20], 1024, P.in[19], (bf16_t*)(ws + W_KV), 1024, v ? 1024 + n0 : headperm_row0(n0), kb * 64, n0, scr, lane); return; }
    it -= 2 * 512;
    if (it < 2 * 512) {
        const int j = it / 512, r = it % 512, kb = r / 32, nb = r % 32, n0 = nb * 32;
        tr_item(P.in[25] + (size_t)j * 1024 * 1024, 1024, P.in[9] + (2 + j) * 1024, (bf16_t*)(ws + W_Q + (size_t)j * 2 * MiB), 1024, headperm_row0(n0), kb * 64, n0, scr, lane); return; }
    it -= 2 * 512;
    {
        const int j = it / 512, r = it % 512, kb = r / 32, nb = r % 32;
        tr_item(P.in[30] + (size_t)j * 1024 * 1024, 1024, nullptr, (bf16_t*)(ws + W_O + (size_t)j * 2 * MiB), 1024, nb * 32, kb * 64, nb * 32, scr, lane); }
}
__device__ __forceinline__ void ffn_item(CParams& P, int f, int j, LAS float* scr, int lane) { prologue_item(P, (j < 2816) ? f * 2816 + j : 16 * 1408 + f * 1408 + (j - 2816), scr, lane); }
constexpr int N_PRO_ITEMS = 16 * 1408 + 8 * 1408 + 2 * 1024 + 256 + 2 * 512 + 2 * 512 + 2 * 512 + 2 * 512;

__device__ __forceinline__ void prologue(CParams& P, LAS unsigned char* lds, int vcu, int G, const int tid) {
    const int lane = tid & 63, wave = __builtin_amdgcn_readfirstlane(tid >> 6);
    LAS float* scr = (LAS float*)(lds + wave * 16384);
    const int gw = vcu * NWAVES + wave, NGW = G * NWAVES;
    for (int it = gw; it < 4224 + (N_PRO_ITEMS - 24 * 1408); it += NGW) { if (it < 4224) ffn_item(P, 0, it, scr, lane); else prologue_item(P, 24 * 1408 + (it - 4224), scr, lane); }
    const float* x = P.in[0]; bf16_t* XB = (bf16_t*)(P.ws + WS_XB); unsigned char* XL = (unsigned char*)(P.ws + WS_XL); float* ss = (float*)(P.ws + WS_SS);
    for (int m = gw; m < MROWS; m += NGW) {
        const f32x4* xr = (const f32x4*)(x + (size_t)m * DM) + lane; u32x2* bo = (u32x2*)(XB + (size_t)m * DM) + lane; unsigned short* lo = (unsigned short*)(XL + (size_t)m * (DM / 2)) + lane;
        float s = 0.f;
#pragma unroll
        for (int j = 0; j < 4; ++j) { const f32x4 v = xr[64 * j]; s += (v[0] * v[0] + v[1] * v[1]) + (v[2] * v[2] + v[3] * v[3]);
            u32x2 w; w.x = cvt_pk_bf16(v[0], v[1]); w.y = cvt_pk_bf16(v[2], v[3]); bo[64 * j] = w;
            const unsigned q0 = lo4_enc(v[0], __uint_as_float(w.x << 16), (w.x >> 7) & 0xffu), q1 = lo4_enc(v[1], __uint_as_float(w.x & 0xffff0000u), (w.x >> 23) & 0xffu);
            const unsigned q2 = lo4_enc(v[2], __uint_as_float(w.y << 16), (w.y >> 7) & 0xffu), q3 = lo4_enc(v[3], __uint_as_float(w.y & 0xffff0000u), (w.y >> 23) & 0xffu);
            lo[64 * j] = (unsigned short)(q0 | (q1 << 4) | (q2 << 8) | (q3 << 12)); }
        s = wave_sum(s, lane);
        if (lane < 16) ss[(size_t)m * 16 + lane] = (lane == 0) ? s : 0.f;
    }
    float* cosT = (float*)(P.ws + WS_COS); float* sinT = (float*)(P.ws + WS_SIN);
    for (int idx = vcu * NTHREADS + tid; idx < SEQ * 32; idx += G * NTHREADS) {
        const int pos = idx >> 5, i = idx & 31; double f = 0.0;
#pragma unroll
        for (int k = 0; k < 32; ++k) f = (i == k) ? P.invfreq[k] : f;
        const double ang = (double)pos * f; const double kq = __builtin_rint(ang * 0.63661977236758134308); const double r = ang - kq * 1.57079632679489661923;
        const float rf = (float)r, rr = rf * rf;
        const float sr = rf * (1.0f + rr * (-1.6666667e-1f + rr * (8.3333333e-3f + rr * (-1.9841270e-4f + rr * 2.7557319e-6f))));
        const float cr = 1.0f + rr * (-0.5f + rr * (4.1666667e-2f + rr * (-1.3888889e-3f + rr * (2.4801587e-5f + rr * -2.7557319e-7f))));
        const int q = ((int)kq) & 3; const float sv = (q == 0) ? sr : (q == 1) ? cr : (q == 2) ? -sr : -cr; const float cv = (q == 0) ? cr : (q == 1) ? -sr : (q == 2) ? -cr : sr;
        cosT[idx] = cv; sinT[idx] = sv;
    }
}

constexpr int SC_XA = 0, SC_X32 = 17408, SC_BUF = 51200;
__device__ __forceinline__ int sc_rho(int t) { return 16 * ((t >> 2) & 3) + 4 * (t >> 4) + (t & 3); }
__device__ __forceinline__ float bf_lo(unsigned u) { return __uint_as_float(u << 16); }
__device__ __forceinline__ float bf_hi(unsigned u) { return __uint_as_float(u & 0xffff0000u); }
template <int PASS> __device__ __forceinline__ void scan_unit(CParams& P, LAS unsigned char* lds, int a, int b, int n, int sp, const int tid) {
    const int lane = tid & 63, w = __builtin_amdgcn_readfirstlane(tid >> 6), chl = lane & 15, fq = lane >> 4;
    const int ch = 128 * n + 16 * w + chl;
    const bf16_t* REC = (const bf16_t*)(P.ws + WS_REC); const bf16_t* GG = (const bf16_t*)(P.ws + WS_GG); bf16_t* Y = (bf16_t*)(P.ws + WS_Y);
    const bf16_t* GW = (const bf16_t*)(P.ws + W_REC + (size_t)a * W_REC_STRIDE + W_REC_G);
    float* spanA = (float*)(P.ws + WS_SPAN); float* spanH = spanA + BATCH * 8 * 1024;
    bf16x8 bfa[4], bfx[4];
#pragma unroll
    for (int ks = 0; ks < 4; ++ks) { bfa[ks] = *(const bf16x8*)(GW + ((size_t)(n * 2 + 0) * 128 + 16 * w + chl) * 128 + 32 * ks + 8 * fq); bfx[ks] = *(const bf16x8*)(GW + ((size_t)(n * 2 + 1) * 128 + 16 * w + chl) * 128 + 32 * ks + 8 * fq); }
    const float ba = P.in[14][a * 1024 + ch], bxb = P.in[16][a * 1024 + ch];
    const float lamv = P.in[17][a * 1024 + ch];
    const float c8 = -8.0f * log1pf(__expf(-lamv));
    float hc = 0.f, Asp = 1.f;
    if (PASS == 2) {
        float A2[7], H2[7];
#pragma unroll
        for (int s2 = 0; s2 < 7; ++s2) { A2[s2] = spanA[(size_t)(b * 8 + s2) * 1024 + ch]; H2[s2] = spanH[(size_t)(b * 8 + s2) * 1024 + ch]; }
#pragma unroll
        for (int s2 = 0; s2 < 7; ++s2) hc = (s2 < sp) ? (A2[s2] * hc + H2[s2]) : hc;
    }
    const int tp = tid >> 4, cg8 = tid & 15;
    const int rho0 = sc_rho(2 * tp), rho1 = sc_rho(2 * tp + 1);
    const float* cwp = P.in[11] + (size_t)a * 4 * 1024 + 128 * n + 8 * cg8; const float* cbp = P.in[12] + a * 1024 + 128 * n + 8 * cg8;
    const bf16_t* rbase = REC + ((size_t)(b * SEQ + sp * 512 + 2 * tp)) * 1024 + 128 * n + 8 * cg8;
    const bf16_t* gbase = GG + ((size_t)(b * SEQ + sp * 512 + 2 * tp)) * 1024 + 128 * n + 8 * cg8;
    bf16_t* ybase = Y + ((size_t)(b * SEQ + sp * 512 + 2 * tp)) * 1024 + 128 * n + 8 * cg8;
    f32x4 cwa[4], cwb[4];
#pragma unroll
    for (int k = 0; k < 4; ++k) { cwa[k] = *(const f32x4*)(cwp + k * 1024); cwb[k] = *(const f32x4*)(cwp + k * 1024 + 4); }
    const f32x4 cb0 = *(const f32x4*)cbp, cb1 = *(const f32x4*)(cbp + 4);
    u32x4 R[5], G0 = (u32x4){0u, 0u, 0u, 0u}, G1 = (u32x4){0u, 0u, 0u, 0u};
#define SC_LOAD(ci_) do { _Pragma("unroll") for (int k = 0; k < 5; ++k) { const int pos = sp * 512 + (ci_) * 64 + 2 * tp - 3 + k; R[k] = (u32x4){0u, 0u, 0u, 0u}; \
            if (pos >= 0) R[k] = *(const u32x4*)(rbase + ((ci_) * 64 - 3 + k) * 1024); } \
        if (PASS == 2) { G0 = *(const u32x4*)(gbase + (ci_) * 64 * 1024); G1 = *(const u32x4*)(gbase + ((ci_) * 64 + 1) * 1024); } } while (0)
    SC_LOAD(0);
    for (int ci = 0; ci < 8; ++ci) {
        LAS unsigned char* buf = lds + (ci & 1) * SC_BUF;
        LAS float* xf = (LAS float*)(buf + SC_X32);
        const u32x4 Gc0 = G0, Gc1 = G1;
        {
            float x0[8], x1[8];
#pragma unroll
            for (int e = 0; e < 4; ++e) { x0[e] = cb0[e]; x0[4 + e] = cb1[e]; x1[e] = cb0[e]; x1[4 + e] = cb1[e]; }
#pragma unroll
            for (int k = 0; k < 4; ++k) {
                const f32x4 wa = cwa[k], wb = cwb[k];
                const u32x4 ra = R[k], rb = R[k + 1];
                x0[0] += wa[0] * bf_lo(ra.x); x0[1] += wa[1] * bf_hi(ra.x); x0[2] += wa[2] * bf_lo(ra.y); x0[3] += wa[3] * bf_hi(ra.y);
                x0[4] += wb[0] * bf_lo(ra.z); x0[5] += wb[1] * bf_hi(ra.z); x0[6] += wb[2] * bf_lo(ra.w); x0[7] += wb[3] * bf_hi(ra.w);
                x1[0] += wa[0] * bf_lo(rb.x); x1[1] += wa[1] * bf_hi(rb.x); x1[2] += wa[2] * bf_lo(rb.y); x1[3] += wa[3] * bf_hi(rb.y);
                x1[4] += wb[0] * bf_lo(rb.z); x1[5] += wb[1] * bf_hi(rb.z); x1[6] += wb[2] * bf_lo(rb.w); x1[7] += wb[3] * bf_hi(rb.w);
            }
            u32x4 p0, p1; p0.x = cvt_pk_bf16(x0[0], x0[1]); p0.y = cvt_pk_bf16(x0[2], x0[3]); p0.z = cvt_pk_bf16(x0[4], x0[5]); p0.w = cvt_pk_bf16(x0[6], x0[7]);
            p1.x = cvt_pk_bf16(x1[0], x1[1]); p1.y = cvt_pk_bf16(x1[2], x1[3]); p1.z = cvt_pk_bf16(x1[4], x1[5]); p1.w = cvt_pk_bf16(x1[6], x1[7]);
            *(LAS u32x4*)(buf + SC_XA + rho0 * 272 + cg8 * 16) = p0; *(LAS u32x4*)(buf + SC_XA + rho1 * 272 + cg8 * 16) = p1;
            *(LAS f32x4*)(xf + rho0 * 132 + cg8 * 8) = (f32x4){x0[0], x0[1], x0[2], x0[3]}; *(LAS f32x4*)(xf + rho0 * 132 + cg8 * 8 + 4) = (f32x4){x0[4], x0[5], x0[6], x0[7]};
            *(LAS f32x4*)(xf + rho1 * 132 + cg8 * 8) = (f32x4){x1[0], x1[1], x1[2], x1[3]}; *(LAS f32x4*)(xf + rho1 * 132 + cg8 * 8 + 4) = (f32x4){x1[4], x1[5], x1[6], x1[7]};
        }
        if (ci + 1 < 8) SC_LOAD(ci + 1);
        LDS_BARRIER();
        f32x4 ga[4], gx[4];
#pragma unroll
        for (int mt = 0; mt < 4; ++mt) { ga[mt] = (f32x4){0.f, 0.f, 0.f, 0.f}; gx[mt] = (f32x4){0.f, 0.f, 0.f, 0.f};
#pragma unroll
            for (int ks = 0; ks < 4; ++ks) { const bf16x8 af = *(const LAS bf16x8*)(buf + SC_XA + (16 * mt + chl) * 272 + (32 * ks + 8 * fq) * 2);
                ga[mt] = __builtin_amdgcn_mfma_f32_16x16x32_bf16(af, bfa[ks], ga[mt], 0, 0, 0); gx[mt] = __builtin_amdgcn_mfma_f32_16x16x32_bf16(af, bfx[ks], gx[mt], 0, 0, 0); } }
        LAS float* xl = xf + (4 * fq) * 132 + 16 * w + chl;
        float Pm[16], hl[16]; float p = 1.f, hh = 0.f;
#pragma unroll
        for (int mt = 0; mt < 4; ++mt)
#pragma unroll
            for (int r = 0; r < 4; ++r) {
                const float xv = xl[(16 * mt + r) * 132];
                const float rg = __builtin_amdgcn_rcpf(1.0f + __expf(-(ga[mt][r] + ba))), ig = __builtin_amdgcn_rcpf(1.0f + __expf(-(gx[mt][r] + bxb)));
                const float la = c8 * rg, t2 = 2.0f * la, av = __expf(la);
                const float poly = -t2 * (1.0f + t2 * (0.5f + t2 * (1.6666667e-1f + t2 * (4.1666667e-2f + t2 * (8.3333333e-3f + t2 * 1.3888889e-3f)))));
                const float om = (t2 > -0.25f) ? poly : (1.0f - av * av);
                const float bxv = __builtin_amdgcn_sqrtf(om) * ig * xv;
                p *= av; hh = av * hh + bxv; Pm[4 * mt + r] = p; hl[4 * mt + r] = hh;
            }
        float IA = p, IH = hh;
        float pA = shl_from(IA, (lane - 16) & 63), pH = shl_from(IH, (lane - 16) & 63); if (fq >= 1) { IH = IA * pH + IH; IA = IA * pA; }
        pA = shl_from(IA, (lane - 32) & 63); pH = shl_from(IH, (lane - 32) & 63); if (fq >= 2) { IH = IA * pH + IH; IA = IA * pA; }
        float EA = shl_from(IA, (lane - 16) & 63), EH = shl_from(IH, (lane - 16) & 63); if (fq == 0) { EA = 1.f; EH = 0.f; }
        const float TA = shl_from(IA, 48 + chl), TH = shl_from(IH, 48 + chl);
        const float hstart = EA * hc + EH;
        hc = TA * hc + TH; Asp *= TA;
        if (PASS == 2) {
#pragma unroll
            for (int mt = 0; mt < 4; ++mt)
#pragma unroll
                for (int r = 0; r < 4; ++r) xl[(16 * mt + r) * 132] = hl[4 * mt + r] + Pm[4 * mt + r] * hstart;
            LDS_BARRIER();
            const f32x4 h00 = *(const LAS f32x4*)(xf + rho0 * 132 + cg8 * 8), h01 = *(const LAS f32x4*)(xf + rho0 * 132 + cg8 * 8 + 4);
            const f32x4 h10 = *(const LAS f32x4*)(xf + rho1 * 132 + cg8 * 8), h11 = *(const LAS f32x4*)(xf + rho1 * 132 + cg8 * 8 + 4);
            u32x4 y0, y1;
            y0.x = cvt_pk_bf16(bf_lo(Gc0.x) * h00[0], bf_hi(Gc0.x) * h00[1]); y0.y = cvt_pk_bf16(bf_lo(Gc0.y) * h00[2], bf_hi(Gc0.y) * h00[3]);
            y0.z = cvt_pk_bf16(bf_lo(Gc0.z) * h01[0], bf_hi(Gc0.z) * h01[1]); y0.w = cvt_pk_bf16(bf_lo(Gc0.w) * h01[2], bf_hi(Gc0.w) * h01[3]);
            y1.x = cvt_pk_bf16(bf_lo(Gc1.x) * h10[0], bf_hi(Gc1.x) * h10[1]); y1.y = cvt_pk_bf16(bf_lo(Gc1.y) * h10[2], bf_hi(Gc1.y) * h10[3]);
            y1.z = cvt_pk_bf16(bf_lo(Gc1.z) * h11[0], bf_hi(Gc1.z) * h11[1]); y1.w = cvt_pk_bf16(bf_lo(Gc1.w) * h11[2], bf_hi(Gc1.w) * h11[3]);
            *(u32x4*)(ybase + (size_t)(ci * 64) * 1024) = y0; *(u32x4*)(ybase + (size_t)(ci * 64 + 1) * 1024) = y1;
        }
    }
#undef SC_LOAD
    if (PASS == 1 && fq == 0) { spanA[(size_t)(b * 8 + sp) * 1024 + ch] = Asp; spanH[(size_t)(b * 8 + sp) * 1024 + ch] = hc; }
    __syncthreads();
}

constexpr int AT_K1 = 0, AT_K2 = 9216, AT_V = 18432, AT_BUF = 36864, AT_Q = 2 * AT_BUF, AT_QW = 8704;
__device__ __forceinline__ int crow(int r, int hi) { return (r & 3) + 8 * (r >> 2) + 4 * hi; }
__device__ __forceinline__ void attn_map(const LAS unsigned char* Kb, const LAS unsigned char* Vb, const LAS unsigned char* Qc, f32x16 (&o)[4], float& lsum, const int q, const int hi) {
    u32x4 pw[4];
    const LAS unsigned char* kq = Kb + q * 144 + hi * 16;
#pragma unroll
    for (int blk = 0; blk < 2; ++blk) {
        f32x16 p;
#pragma unroll
        for (int r = 0; r < 16; ++r) p[r] = 0.f;
        bf16x8 kf[2], qf[2];
#define AT_KQ(ds) do { kf[(ds) & 1] = *(const LAS bf16x8*)(kq + blk * (32 * 144) + (ds) * 32); qf[(ds) & 1] = *(const LAS bf16x8*)(Qc + (ds) * 32); } while (0)
        AT_KQ(0); AT_KQ(1);
        __builtin_amdgcn_sched_barrier(0);
#pragma unroll
        for (int ds = 0; ds < 4; ++ds) { p = __builtin_amdgcn_mfma_f32_32x32x16_bf16(kf[ds & 1], qf[ds & 1], p, 0, 0, 0); if (ds + 2 < 4) AT_KQ(ds + 2); __builtin_amdgcn_sched_barrier(0); }
#undef AT_KQ
        float sa = 0.f;
#pragma unroll
        for (int r = 0; r < 16; ++r) { p[r] = __builtin_amdgcn_exp2f(p[r]); sa += p[r]; }
        lsum += sa;
#pragma unroll
        for (int e = 0; e < 4; ++e) { pw[2 * blk][e] = cvt_pk_bf16(p[2 * e], p[2 * e + 1]); pw[2 * blk + 1][e] = cvt_pk_bf16(p[8 + 2 * e], p[8 + 2 * e + 1]); }
        __builtin_amdgcn_sched_barrier(0);
    }
    {   bf16x8 vf[4];
        const LAS unsigned char* vq = Vb + q * 144 + hi * 16;
#define AT_VREAD(i) do { vf[(i) & 3] = *(const LAS bf16x8*)(vq + ((i) >> 2) * (32 * 144) + ((i) & 3) * 32); } while (0)
        AT_VREAD(0); AT_VREAD(1); AT_VREAD(2); AT_VREAD(3);
        __builtin_amdgcn_sched_barrier(0);
#pragma unroll
        for (int i = 0; i < 16; ++i) {
            o[i >> 2] = __builtin_amdgcn_mfma_f32_32x32x16_bf16(__builtin_bit_cast(bf16x8, pw[i & 3]), vf[i & 3], o[i >> 2], 0, 0, 0);
            if (i + 4 < 16) AT_VREAD(i + 4);
            __builtin_amdgcn_sched_barrier(0);
        }
#undef AT_VREAD
    }
}
__device__ __forceinline__ void attn_unit(CParams& P, LAS unsigned char* lds, int b, int h, int qb, int j, float lam, float linit, const int tid_in) {
    int tid = tid_in; asm volatile("" : "+v"(tid));
    const int lane = tid & 63, w = __builtin_amdgcn_readfirstlane(tid >> 6), q = lane & 31, hi = lane >> 5;
    const bf16_t* Q = (const bf16_t*)(P.ws + WS_QO); bf16_t* O = (bf16_t*)(P.ws + WS_O);
    const bf16_t* Kg = (const bf16_t*)(P.ws + WS_K); const bf16_t* VT = (const bf16_t*)(P.ws + WS_VT);
    const int NT = 4 * qb + 4, mylast = 4 * qb + (w >> 1);
    const int row0 = b * SEQ + qb * 256 + 32 * w;
    LAS unsigned char* Qw = lds + AT_Q + w * AT_QW;
    {
        const bf16_t* qsrc = Q + (size_t)(row0 + (lane >> 4)) * 1024 + h * 128 + (lane & 15) * 8;
        u32x4 qv[8];
#pragma unroll
        for (int i = 0; i < 8; ++i) qv[i] = *(const u32x4*)(qsrc + (size_t)(4 * i) * 1024);
#pragma unroll
        for (int i = 0; i < 8; ++i) *(LAS u32x4*)(Qw + ((lane >> 4) + 4 * i) * 272 + (lane & 15) * 16) = qv[i];
    }
    const LAS unsigned char* Qc0 = Qw + q * 272 + hi * 16;
    f32x16 o1[4], o2[4];
#pragma unroll
    for (int d = 0; d < 4; ++d)
#pragma unroll
        for (int r = 0; r < 16; ++r) { o1[d][r] = 0.f; o2[d][r] = 0.f; }
    float l1 = 0.f, l2 = 0.f;
#define AT_ADDR() \
    const int kr = tid >> 4, kc16 = tid & 15; \
    const unsigned koff = (unsigned)(((b * SEQ + kr) * 1024 + h * 128 + kc16 * 8) * 2);          \
    const int kdst = ((kc16 < 8) ? AT_K1 : AT_K2) + kr * 144 + (kc16 & 7) * 16;              \
    const int dv0 = tid >> 3, kc = tid & 7; \
    const unsigned voff = (unsigned)((((b * 8 + h) * 128 + dv0) * 4096 + kc * 8) * 2);           \
    const int vdst = AT_V + dv0 * 144 + 32 * (kc >> 1) + 8 * (kc & 1);
    u32x4 rk0, rk1, rv0, rv1;
#define AT_LOAD(t) do { const unsigned ko_ = koff + (unsigned)(t) * 131072u, vo_ = voff + (unsigned)(t) * 128u; \
        rk0 = *(const u32x4*)((const char*)Kg + ko_); rk1 = *(const u32x4*)((const char*)Kg + (ko_ + 65536u)); \
        rv0 = *(const u32x4*)((const char*)VT + vo_); rv1 = *(const u32x4*)((const char*)VT + (vo_ + 524288u)); } while (0)
#define AT_WRITE(Bp) do { LAS unsigned char* B_ = (Bp); *(LAS u32x4*)(B_ + kdst) = rk0; *(LAS u32x4*)(B_ + kdst + 32 * 144) = rk1; \
        *(LAS u32x2*)(B_ + vdst) = (u32x2){rv0.x, rv0.y}; *(LAS u32x2*)(B_ + vdst + 16) = (u32x2){rv0.z, rv0.w}; \
        *(LAS u32x2*)(B_ + vdst + 64 * 144) = (u32x2){rv1.x, rv1.y}; *(LAS u32x2*)(B_ + vdst + 64 * 144 + 16) = (u32x2){rv1.z, rv1.w}; } while (0)
    {   AT_ADDR()
        AT_LOAD(0);
        AT_WRITE(lds);
        LDS_BARRIER();
        for (int kt = 0; kt <= mylast; ++kt) {
            { const int tn_ = (kt + 1 < NT) ? kt + 1 : NT - 1; AT_LOAD(tn_); }
            const LAS unsigned char* B_ = lds + (kt & 1) * AT_BUF;
            attn_map(B_ + AT_K1, B_ + AT_V, Qc0, o1, l1, q, hi);
            attn_map(B_ + AT_K2, B_ + AT_V, Qc0 + 128, o2, l2, q, hi);
            AT_WRITE(lds + ((kt + 1) & 1) * AT_BUF);
            LDS_BARRIER();
        }
    }
    { unsigned z_ = 0u; asm volatile("" : "+v"(z_)); tid = (w << 6) + (int)__builtin_amdgcn_mbcnt_hi(~0u, __builtin_amdgcn_mbcnt_lo(~0u, z_)); }
    {   AT_ADDR()
        for (int kt = mylast + 1; kt < NT; ++kt) {
            { const int tn_ = (kt + 1 < NT) ? kt + 1 : NT - 1; AT_LOAD(tn_); }
            AT_WRITE(lds + ((kt + 1) & 1) * AT_BUF);
            LDS_BARRIER();
        }
    }
#undef AT_ADDR
#undef AT_LOAD
#undef AT_WRITE
    asm volatile("" : "+v"(tid));
    const int lane_e = tid & 63, q_e = lane_e & 31, hi_e = lane_e >> 5;
    l1 += shx(l1, 32, lane_e); l2 += shx(l2, 32, lane_e);
    LAS float* wl = (LAS float*)(Qw + 4608);
    if (hi_e == 0) { wl[q_e] = 1.0f / l1; wl[32 + q_e] = -lam / l2; }
    const LAS float* wlh = wl + 4 * hi_e;
    const float* gs = P.in[29] + j * 128;
    float gsv[4];
#pragma unroll
    for (int d = 0; d < 4; ++d) gsv[d] = gs[32 * d + q_e] * (1.0f - linit);
    bf16_t* obase2 = O + (size_t)(row0 + (lane_e >> 4)) * 1024 + h * 128 + (lane_e & 15) * 8;
    LAS unsigned char* stg = Qw;
#pragma unroll
    for (int r4 = 0; r4 < 4; ++r4) {
        f32x4 la, lb;
#pragma unroll
        for (int e = 0; e < 4; ++e) { la[e] = wlh[e + 8 * r4]; lb[e] = wlh[32 + e + 8 * r4]; }
#pragma unroll
        for (int e = 0; e < 4; ++e) {
            float df[4]; float sq = 0.f;
#pragma unroll
            for (int d = 0; d < 4; ++d) { df[d] = o1[d][4 * r4 + e] * la[e] + o2[d][4 * r4 + e] * lb[e]; sq += df[d] * df[d]; }
            sq += shx(sq, 1, lane_e); sq += shx(sq, 2, lane_e); sq += shx(sq, 4, lane_e); sq += shx(sq, 8, lane_e); sq += shx(sq, 16, lane_e);
            const float rinv = __builtin_amdgcn_rsqf(sq * (1.0f / 128.0f) + 1e-5f);
            LAS unsigned short* sr = (LAS unsigned short*)(stg + ((e + 8 * (r4 & 1) + 4 * hi_e) * 288) + q_e * 2);
#pragma unroll
            for (int d = 0; d < 4; ++d) sr[32 * d] = cvt_bf16(df[d] * rinv * gsv[d]);
        }
        if (r4 & 1) {
            LDS_WAIT();
#pragma unroll
            for (int i = 0; i < 4; ++i) {
                const u32x4 v = *(const LAS u32x4*)(stg + ((lane_e >> 4) + 4 * i) * 288 + (lane_e & 15) * 16);
                bf16_t* op = obase2; asm volatile("" : "+v"(op));
                *(u32x4*)(op + (size_t)(16 * (r4 >> 1) + 4 * i) * 1024) = v; }
            LDS_WAIT();
        }
    }
    __syncthreads();
}

#define XB_TMO      128
#define XB_XCNT(j)  (256  + 64 * (j))
#define XB_XSUB(j)  (1280 + 64 * (j))
#define XB_XGEN(j)  (2304 + 64 * (j))
#define XB_TOP      3328
#define XB_TOPGEN   3392
#define XCD_BAR_WORDS 3456
#define XB_SPIN_CAP (1u << 18)

__device__ __forceinline__ unsigned xb_ld(unsigned* p)              { return __hip_atomic_load(p, __ATOMIC_RELAXED, __HIP_MEMORY_SCOPE_AGENT); }
__device__ __forceinline__ unsigned xb_add(unsigned* p, unsigned v) { return __hip_atomic_fetch_add(p, v, __ATOMIC_RELAXED, __HIP_MEMORY_SCOPE_AGENT); }
__device__ __forceinline__ unsigned xb_xcc_id() { return (unsigned)__builtin_amdgcn_s_getreg((3 << 11) | 20) & 0xFu; }
#define XB_SPIN(cond, bar) do { unsigned _sp = 0; while (cond) { __builtin_amdgcn_s_sleep(1); \
    if ((++_sp & 255u) == 0u) { if (xb_ld(&(bar)[XB_TMO])) break; if (_sp > XB_SPIN_CAP) { atomicAdd(&(bar)[XB_TMO], 1u); break; } } } } while (0)

struct XcdBarrier {
    unsigned* bar; unsigned x;
    volatile LAS unsigned* st;
};

__device__ __forceinline__ XcdBarrier xcd_barrier_post(unsigned* bar, volatile LAS unsigned* st) {
    XcdBarrier b; b.bar = bar; b.x = xb_xcc_id(); b.st = st;
    if (threadIdx.x == 0) (void)xb_add(&bar[XB_XCNT(b.x)], 1u);
    return b;
}
__device__ __forceinline__ void xcd_barrier_complete(unsigned* bar, unsigned x, unsigned& nloc, unsigned& nx) {
    const unsigned G = gridDim.x * gridDim.y * gridDim.z;
    unsigned sum, cnt, mine, sp = 0u;
    for (;;) {
        sum = 0u; cnt = 0u; mine = 0u;
#pragma unroll
        for (unsigned j = 0; j < 16; ++j) { const unsigned c = xb_ld(&bar[XB_XCNT(j)]); sum += c; cnt += (c > 0u) ? 1u : 0u; mine = (j == x) ? c : mine; }
        if (sum == G) break;
        __builtin_amdgcn_s_sleep(1);
        if ((++sp & 255u) == 0u) { if (xb_ld(&bar[XB_TMO])) break; if (sp > XB_SPIN_CAP) { atomicAdd(&bar[XB_TMO], 1u); break; } }
    }
    nloc = mine > 0u ? mine : 1u; nx = cnt > 0u ? cnt : 1u;
}

__device__ __forceinline__ void xcd_barrier(const XcdBarrier& b, const bool is_t0) {
    asm volatile("s_waitcnt vmcnt(0)" ::: "memory");
    __syncthreads();
    if (is_t0) {
        unsigned* bar = b.bar;
        __builtin_amdgcn_s_waitcnt(0);
        unsigned nloc = b.st[0], nx = b.st[1];
        if (nloc == 0u) { xcd_barrier_complete(bar, b.x, nloc, nx); b.st[0] = nloc; b.st[1] = nx; }
        const unsigned old = xb_add(&bar[XB_XSUB(b.x)], 1u);
        const unsigned gen = old / nloc;
        if (old + 1u == (gen + 1u) * nloc) {
            __builtin_amdgcn_fence(__ATOMIC_RELEASE, "agent");
            asm volatile("s_waitcnt vmcnt(0)" ::: "memory");
            const unsigned og = xb_add(&bar[XB_TOP], 1u);
            const unsigned tg = og / nx;
            if (og + 1u == (tg + 1u) * nx) xb_add(&bar[XB_TOPGEN], 1u);
            else XB_SPIN(xb_ld(&bar[XB_TOPGEN]) == tg, bar);
            __builtin_amdgcn_fence(__ATOMIC_ACQUIRE, "agent");
            xb_add(&bar[XB_XGEN(b.x)], 1u);
            asm volatile("s_waitcnt vmcnt(0)" ::: "memory");
        } else {
            XB_SPIN(xb_ld(&bar[XB_XGEN(b.x)]) == gen, bar);
            __builtin_amdgcn_fence(__ATOMIC_ACQUIRE, "agent");
            asm volatile("s_waitcnt vmcnt(0)" ::: "memory");
        }
    }
    __syncthreads();
}


__device__ __forceinline__ pg8::RsCache make_rs_cache(LAS unsigned char* lds, const float* ss, int N, const int tid) {
    pg8::StaticOrder S; S.init(MROWS, N, (int)gridDim.x, (int)blockIdx.x); pg8::Unit u0; u0.pm = 0; u0.pn = 0; const bool any = S.next(0, u0);
    LAS float* tab = (LAS float*)(lds + LDS_BYTES - 1024);
    if (any && tid < 256) tab[tid] = pg8::row_rs(ss, u0.pm * 256 + tid);
    __syncthreads();
    return pg8::RsCache{tab, any ? u0.pm : -1, ss};
}
template <class Epi> __device__ __forceinline__ void run_gemm(LAS unsigned char* lds, const bf16_t* A, const bf16_t* Bt, int N, int K, const Epi& E, const int tid) {
    pg8::Gemm g{A, Bt, MROWS, N, K}; pg8::StaticOrder S; S.init(MROWS, N, (int)gridDim.x, (int)blockIdx.x);
    pg8::gemm_phase<Epi, pg8::StaticOrder, true, true>(lds, g, S, E, tid);
}
enum { OP_PRO = 0, OP_UP, OP_DOWN, OP_RECIN, OP_SCAN1, OP_SCAN2, OP_RECOUT, OP_KV, OP_QG, OP_ATTN, OP_WO };
constexpr int N_STEPS = 32;

__global__ void __launch_bounds__(NTHREADS) mega_fwd(Params P0) {
    extern __shared__ __attribute__((aligned(16))) unsigned char lds_raw[];
    LAS unsigned char* lds = (LAS unsigned char*)lds_raw;
    cg::grid_group grid = cg::this_grid();
    volatile LAS unsigned* bar_st = (volatile LAS unsigned*)(lds + LDS_BYTES - 2048);
    if (threadIdx.x < 2) bar_st[threadIdx.x] = 0u;
    __syncthreads();
    XcdBarrier xbar = xcd_barrier_post((unsigned*)(P0.ws + WS_BAR), bar_st);
    const int wave_s = __builtin_amdgcn_readfirstlane(threadIdx.x >> 6);
    auto mk_tid = [&]() -> int { unsigned z = 0u; asm volatile("" : "+v"(z)); return (wave_s << 6) + (int)__builtin_amdgcn_mbcnt_hi(~0u, __builtin_amdgcn_mbcnt_lo(~0u, z)); };
#define MK_TID() mk_tid()
    const int G = gridDim.x, bx = blockIdx.x, vcu = (G % 8 == 0) ? (bx % 8) * (G / 8) + bx / 8 : bx;
    for (int st = P0.ph_lo; st < P0.ph_hi; ++st) {
        int op, layer = 0, f = 0;
        if (st == 0) op = OP_PRO;
        else if (st <= 16) { const int k = (st - 1) & 7; layer = (st - 1) >> 3; f = layer * 2 + (k >= 6);
            op = (k == 0 || k == 6) ? OP_UP : (k == 1 || k == 7) ? OP_DOWN : (k == 2) ? OP_RECIN : (k == 3) ? OP_SCAN1 : (k == 4) ? OP_SCAN2 : OP_RECOUT; }
        else if (st == 17) { op = OP_KV; layer = 2; }
        else { const int q = st - 18, k = q % 7; layer = 2 + q / 7; f = layer * 2 + (k >= 5);
            op = (k == 0 || k == 5) ? OP_UP : (k == 1 || k == 6) ? OP_DOWN : (k == 2) ? OP_QG : (k == 3) ? OP_ATTN : OP_WO; }
        if (st > P0.ph_lo && st != 18) { if (P0.rep_mask & 0x4000) grid.sync(); else xcd_barrier(xbar, MK_TID() == 0); if (P0.rep_mask & 0x8000) { xcd_barrier(xbar, MK_TID() == 0); xcd_barrier(xbar, MK_TID() == 0); } }
        const int a = layer, jl = layer - 2;
#ifndef OPMASK
#define OPMASK 0xFFFF
#endif
#define HAS(o) ((OPMASK >> (o)) & 1)
#ifndef PROBE_REP_MASK
#define PROBE_REP_MASK 0
#endif
        const int nrep = ((P0.rep_mask >> op) & 1) ? 2 : 1;
        for (int rep = 0; rep < nrep; ++rep) {
        if (rep) xcd_barrier(xbar, MK_TID() == 0);
#define STEP_LOCALS() int tid = MK_TID(); asm volatile("" : "+v"(tid)); CParams* Pp = (CParams*)__builtin_amdgcn_kernarg_segment_ptr(); asm volatile("" : "+s"(Pp)); CParams& P = *Pp; \
        unsigned char* ws = P.ws; asm volatile("" : "+s"(ws)); bf16_t* XB = (bf16_t*)(ws + WS_XB); float* ss = (float*)(ws + WS_SS); bf16_t* HB = (bf16_t*)(ws + WS_H); (void)XB; (void)ss; (void)HB; (void)tid;
        switch (op) {
        case OP_PRO: if (HAS(0)) { STEP_LOCALS() prologue(P, lds, vcu, G, tid); } break;
        case OP_UP: if (HAS(1)) { STEP_LOCALS() pg8::EpiSwiglu E{HB, make_rs_cache(lds, ss, 5632, tid)}; run_gemm(lds, XB, (const bf16_t*)(ws + WS_W + (size_t)f * W_FFN_STRIDE), 5632, 1024, E, tid);
            if (f < 7 && G == 256 && rep == 0) {
                if (bx >= 128) { const int lane = tid & 63, wave = __builtin_amdgcn_readfirstlane(tid >> 6); LAS float* scr = (LAS float*)(lds + wave * 16384);
                    for (int it = (bx - 128) * NWAVES + wave; it < 4224; it += 128 * NWAVES) ffn_item(P, f + 1, it, scr, lane); }
            } else if (f < 7 && rep == 0) { const int lane = tid & 63, wave = __builtin_amdgcn_readfirstlane(tid >> 6); LAS float* scr = (LAS float*)(lds + wave * 16384);
                for (int it = vcu * NWAVES + wave; it < 4224; it += G * NWAVES) ffn_item(P, f + 1, it, scr, lane); }
        } break;
        case OP_DOWN: case OP_RECOUT: case OP_WO: if (HAS(2)) { STEP_LOCALS()
            const bf16_t* A = (op == OP_DOWN) ? HB : (op == OP_RECOUT) ? (const bf16_t*)(ws + WS_Y) : (const bf16_t*)(ws + WS_O);
            const bf16_t* Bt = (op == OP_DOWN) ? (const bf16_t*)(ws + WS_W + (size_t)f * W_FFN_STRIDE + W_FFN_DN) : (op == OP_RECOUT) ? (const bf16_t*)(ws + W_REC + (size_t)a * W_REC_STRIDE + W_REC_OUT) : (const bf16_t*)(ws + W_O + (size_t)jl * 2 * MiB);
            pg8::EpiResid E{(st == N_STEPS - 1) ? P.out : nullptr, XB, (unsigned char*)(ws + WS_XL), ss, __uint_as_float((op == OP_DOWN) ? 0x3f000000u : 0x3f800000u)}; run_gemm(lds, A, Bt, 1024, (op == OP_DOWN) ? 2816 : 1024, E, tid); } break;
        case OP_RECIN: if (HAS(3)) { STEP_LOCALS() pg8::EpiRecIn E{(bf16_t*)(ws + WS_GG), (bf16_t*)(ws + WS_REC), make_rs_cache(lds, ss, 2048, tid)}; run_gemm(lds, XB, (const bf16_t*)(ws + W_REC + (size_t)a * W_REC_STRIDE), 2048, 1024, E, tid); } break;
        case OP_SCAN1: if (HAS(4)) { STEP_LOCALS() for (int u = vcu; u < 256; u += G) scan_unit<1>(P, lds, a, u >> 6, (u >> 3) & 7, u & 7, tid); } break;
        case OP_SCAN2: if (HAS(5)) { STEP_LOCALS() for (int u = vcu; u < 256; u += G) scan_unit<2>(P, lds, a, u >> 6, (u >> 3) & 7, u & 7, tid); } break;
        case OP_KV: case OP_QG: if (HAS(7)) { STEP_LOCALS()
            const bool kv = (op == OP_KV);
            pg8::EpiQK E{kv ? (bf16_t*)(ws + WS_K) : (bf16_t*)(ws + WS_QO), (bf16_t*)(ws + WS_VT), make_rs_cache(lds, ss, kv ? 2048 : 1024, tid), kv ? P.in[22] : P.in[26] + jl * 64, (const float*)(ws + WS_COS), (const float*)(ws + WS_SIN), kv ? 1.0f : 0.125f * 1.4426950408889634f};
            run_gemm(lds, XB, kv ? (const bf16_t*)(ws + W_KV) : (const bf16_t*)(ws + W_Q + (size_t)jl * 2 * MiB), kv ? 2048 : 1024, 1024, E, tid); } break;
        case OP_ATTN: if (HAS(9)) { STEP_LOCALS()
            const int tid_a = MK_TID();
            const int lane = tid_a & 63;
            const float q1 = P.in[27][jl * 64 + lane], q2 = P.in[28][jl * 64 + lane], k1 = P.in[23][lane], k2 = P.in[24][lane];
            const float linit = jl ? P.linit[1] : P.linit[0];
            const float lam = __uint_as_float(__builtin_amdgcn_readfirstlane(__float_as_uint(__expf(wave_sum(q1 * k1, lane)) - __expf(wave_sum(q2 * k2, lane)) + linit)));
            for (int pr = vcu; pr < 256; pr += G) { const int bh = pr >> 3, s = pr & 7;
#pragma unroll 1
                for (int uu = 0; uu < 2; ++uu) attn_unit(P, lds, bh >> 3, bh & 7, uu ? s : 15 - s, jl, lam, linit, tid_a); }
        } break;
        }
        }
    }
}

#ifndef MK_PER_STEP
#define MK_PER_STEP 0
#endif
extern "C" void kernel_launch(void* const* d_in, const int* in_sizes, int n_in, void* d_out, int out_size, void* d_ws, size_t ws_size, hipStream_t stream) {
    static int grid = 0;
    if (grid == 0) {
        int dev = 0, cus = 0, per_cu = 0;
        if (n_in != 31 || out_size != MROWS * DM || ws_size < WS_END) { fprintf(stderr, "kernel_launch: unexpected shapes (n_in %d out %d ws %zu)\n", n_in, out_size, ws_size); grid = -1; return; }
        hipGetDevice(&dev); hipDeviceGetAttribute(&cus, hipDeviceAttributeMultiprocessorCount, dev);
        hipFuncSetAttribute((const void*)mega_fwd, hipFuncAttributeMaxDynamicSharedMemorySize, LDS_BYTES);
        hipOccupancyMaxActiveBlocksPerMultiprocessor(&per_cu, (const void*)mega_fwd, NTHREADS, LDS_BYTES);
        (void)hipGetLastError();
        if (per_cu < 1) per_cu = 1;
        grid = cus * 1;
        if (grid <= 0) grid = 256;
    }
    if (grid < 0) return;
    Params p{};
    for (int i = 0; i < 31; ++i) p.in[i] = (const float*)d_in[i];
    p.out = (float*)d_out; p.ws = (unsigned char*)d_ws; p.rep_mask = PROBE_REP_MASK;
    p.linit[0] = (float)(0.8 - 0.6 * std::exp(-0.3 * 2.0)); p.linit[1] = (float)(0.8 - 0.6 * std::exp(-0.3 * 3.0));
    for (int i = 0; i < 32; ++i) p.invfreq[i] = std::pow(10000.0, -(double)(2 * i) / 64.0);
    (void)hipMemsetAsync((char*)d_ws + WS_BAR, 0, 16384, stream);
#if MK_PER_STEP
    for (int st = 0; st < N_STEPS; ++st) { p.ph_lo = st; p.ph_hi = st + 1; hipLaunchKernelGGL(mega_fwd, dim3(grid), dim3(NTHREADS), LDS_BYTES, stream, p); }
#else
    p.ph_lo = 0; p.ph_hi = N_STEPS;
    void* args[] = {&p};
    hipError_t e = hipLaunchCooperativeKernel((const void*)mega_fwd, dim3(grid), dim3(NTHREADS), args, LDS_BYTES, stream);
    if (e != hipSuccess) fprintf(stderr, "cooperative launch failed: %s (grid %d)\n", hipGetErrorString(e), grid);
#endif
}
```

```cpp
#include <hip/hip_runtime.h>
#include <hip/hip_cooperative_groups.h>
#include <cstdio>
#include <cstdint>
#include <cmath>
namespace cg = cooperative_groups;
__device__ __forceinline__ float shx(float v, int k, int lane) { return __int_as_float(__builtin_amdgcn_ds_bpermute((lane ^ k) << 2, __float_as_int(v))); }
__device__ __forceinline__ float shl_from(float v, int src) { return __int_as_float(__builtin_amdgcn_ds_bpermute(src << 2, __float_as_int(v))); }
__device__ __forceinline__ unsigned lo4_enc(float x, float hif, unsigned e) { const float inv = (e >= 12u) ? __uint_as_float((265u - e) << 23) : 0.f; float q = rintf((x - hif) * inv) + 8.f; q = fminf(fmaxf(q, 0.f), 15.f); return (unsigned)q; }
__device__ __forceinline__ float lo4_dec(unsigned nib, unsigned e) { const float sc = (e >= 12u) ? __uint_as_float((e - 11u) << 23) : 0.f; return ((float)nib - 8.f) * sc; }
namespace pg8 {
#define PG8_LAS __attribute__((address_space(3)))
typedef unsigned short bf16_t;
typedef short bf16x8 __attribute__((ext_vector_type(8)));
typedef float f32x4 __attribute__((ext_vector_type(4)));
typedef unsigned u32x4 __attribute__((ext_vector_type(4)));
constexpr int BM = 256, BK = 64, HALF = 128, HTB = HALF * BK * 2  , STAGE_BYTES = 8 * HTB, NXCD = 8, WGM = 8;

__host__ __device__ __forceinline__ int lds_byte(int r, int c) { const int st = (r >> 4) * 2 + (c >> 5), rr = r & 15, cc = c & 31, ob = rr * 64 + cc * 2; return st * 1024 + (ob ^ (((ob >> 9) & 1) << 5)); }
__host__ __device__ __forceinline__ void stage_rc(int b, int& R, int& C) { const int st = b / 1024, sb = b % 1024, swz = sb ^ (((sb >> 9) & 1) << 5); R = (st >> 1) * 16 + swz / 64; C = (st & 1) * 32 + (swz % 64) / 2; }
__host__ __device__ __forceinline__ int perm32(int rho) { const int n = rho >> 4, i = rho & 15; return 8 * (i >> 2) + 4 * n + (i & 3); }

struct Unit { int pm, pn; };
struct Gemm { const bf16_t* A; const bf16_t* Bt; int M, N, K; };

struct StaticOrder {
    int nM, nN, nwg, G, c;
    __host__ __device__ void init(int M, int N, int G_, int c_) { nM = M / BM; nN = N / BM; nwg = nM * nN; G = G_; c = c_; }
    __host__ __device__ bool next(int i, Unit& u) const {
        const long L = (long)i * G + c; if (L >= nwg) return false;
        int wgid = (int)L; { const int q = nwg / NXCD, r = nwg % NXCD, xcd = wgid % NXCD, off = wgid / NXCD; wgid = (xcd < r ? xcd * (q + 1) : r * (q + 1) + (xcd - r) * q) + off; }
        const int nig = WGM * nN, gid = wgid / nig, fm = gid * WGM, gsz = (nM - fm) < WGM ? (nM - fm) : WGM;
        u.pm = fm + ((wgid % nig) % gsz); u.pn = (wgid % nig) / gsz; return true;
    }
    __device__ __forceinline__ void a_ready(const Unit&) const {}
    __device__ __forceinline__ void done(const Unit&) const {}
};
typedef unsigned u32x4 __attribute__((ext_vector_type(4)));
__device__ __forceinline__ unsigned cvt_pk_bf16(float lo, float hi) { unsigned r; asm volatile("v_cvt_pk_bf16_f32 %0, %1, %2" : "=v"(r) : "v"(lo), "v"(hi)); return r; }
__device__ __forceinline__ unsigned short cvt_bf16(float v) { return (unsigned short)(cvt_pk_bf16(v, 0.f) & 0xffffu); }
__device__ __forceinline__ u32x4 pack8(const f32x4 a, const f32x4 b) { u32x4 w; w.x = cvt_pk_bf16(a[0], a[1]); w.y = cvt_pk_bf16(a[2], a[3]); w.z = cvt_pk_bf16(b[0], b[1]); w.w = cvt_pk_bf16(b[2], b[3]); return w; }
__device__ __forceinline__ float row_rs(const float* ss, int row) {
    const f32x4* p = (const f32x4*)(ss + (size_t)row * 16);
    const f32x4 a = p[0], b = p[1], c = p[2], d = p[3];
    const float s = (((a[0] + a[1]) + (a[2] + a[3])) + ((b[0] + b[1]) + (b[2] + b[3]))) + (((c[0] + c[1]) + (c[2] + c[3])) + ((d[0] + d[1]) + (d[2] + d[3])));
    return __builtin_amdgcn_rsqf(s * (1.0f / 1024.0f) + 1e-6f);
}
__device__ __forceinline__ float silu_f(float g) { return g * __builtin_amdgcn_rcpf(1.0f + __builtin_amdgcn_exp2f(-1.4426950408889634f * g)); }
__device__ __forceinline__ float gelu_tanh_f(float v) { const float t = 0.7978845608028654f * (v + 0.044715f * v * v * v); return v * __builtin_amdgcn_rcpf(1.0f + __builtin_amdgcn_exp2f(-2.0f * 1.4426950408889634f * t)); }

struct RsCache { const PG8_LAS float* tab; int pm0; const float* ss;
    __device__ __forceinline__ float get(int pm, int lrow) const { return (pm == pm0) ? tab[lrow] : row_rs(ss, pm * BM + lrow); } };
struct EpiSwiglu {
    static constexpr bool PERM = true, AFTER_DRAIN = false;
    bf16_t* H; RsCache rc;
    typedef float f32x2 __attribute__((ext_vector_type(2)));
    static __device__ __forceinline__ f32x2 sw2(f32x2 g, f32x2 u, float c1, float rs2) {
        const f32x2 t = g * c1; f32x2 e; e.x = __builtin_amdgcn_exp2f(t.x); e.y = __builtin_amdgcn_exp2f(t.y);
        const f32x2 d = e + 1.0f; f32x2 r; r.x = __builtin_amdgcn_rcpf(d.x); r.y = __builtin_amdgcn_rcpf(d.y);
        return (g * u) * (r * rs2);
    }
    __device__ __forceinline__ void operator()(const f32x4 (&acc)[2][2][4][2], const Unit& u, int wr, int wc, int fr, int fq) const {
        const int col0 = u.pn * 128 + wc * 32 + 8 * fq;
        float rsv[2][4];
#pragma unroll
        for (int ai = 0; ai < 2; ++ai)
#pragma unroll
            for (int m = 0; m < 4; ++m) rsv[ai][m] = rc.get(u.pm, ai * HALF + wr * 64 + m * 16 + fr);
#pragma unroll
        for (int ai = 0; ai < 2; ++ai)
#pragma unroll
            for (int m = 0; m < 4; ++m) {
                const int row = u.pm * BM + ai * HALF + wr * 64 + m * 16 + fr; const float rs = rsv[ai][m], c1 = -1.4426950408889634f * rs, rs2 = rs * rs;
                const f32x4 g0 = acc[ai][0][m][0], g1 = acc[ai][0][m][1], u0 = acc[ai][1][m][0], u1 = acc[ai][1][m][1];
                const f32x2 a = sw2((f32x2){g0[0], g0[1]}, (f32x2){u0[0], u0[1]}, c1, rs2), b = sw2((f32x2){g0[2], g0[3]}, (f32x2){u0[2], u0[3]}, c1, rs2);
                const f32x2 c = sw2((f32x2){g1[0], g1[1]}, (f32x2){u1[0], u1[1]}, c1, rs2), d = sw2((f32x2){g1[2], g1[3]}, (f32x2){u1[2], u1[3]}, c1, rs2);
                u32x4 w; w.x = cvt_pk_bf16(a.x, a.y); w.y = cvt_pk_bf16(b.x, b.y); w.z = cvt_pk_bf16(c.x, c.y); w.w = cvt_pk_bf16(d.x, d.y);
                *(u32x4*)(H + (size_t)row * 2816 + col0) = w;
            }
    }
};
struct EpiResid {
    static constexpr bool PERM = true, AFTER_DRAIN = false;
    typedef unsigned u32x2 __attribute__((ext_vector_type(2)));
    float* OUT; bf16_t* XB; unsigned char* XL; float* ss; float alpha;
    __device__ __forceinline__ void operator()(const f32x4 (&acc)[2][2][4][2], const Unit& u, int wr, int wc, int fr, int fq) const {
        const int col0 = u.pn * BM + wc * 32 + 8 * fq;
        const size_t off0 = (size_t)(u.pm * BM + wr * 64 + fr) * 1024 + col0;
#pragma unroll
        for (int ai = 0; ai < 2; ++ai) {
            u32x4 hin[4][2]; unsigned lin[4][2];
#pragma unroll
            for (int m = 0; m < 4; ++m)
#pragma unroll
                for (int bj = 0; bj < 2; ++bj) { const size_t o = off0 + (size_t)(ai * HALF + m * 16) * 1024 + bj * HALF; hin[m][bj] = *(const u32x4*)(XB + o); lin[m][bj] = *(const unsigned*)(XL + (o >> 1)); }
            __builtin_amdgcn_sched_barrier(0);
#pragma unroll
            for (int m = 0; m < 4; ++m) {
                const int row = u.pm * BM + ai * HALF + wr * 64 + m * 16 + fr; float sq = 0.f;
#pragma unroll
                for (int bj = 0; bj < 2; ++bj) {
                    const size_t o = off0 + (size_t)(ai * HALF + m * 16) * 1024 + bj * HALF;
                    const u32x4 h = hin[m][bj]; const unsigned l = lin[m][bj];
                    float xv[8];
#pragma unroll
                    for (int k = 0; k < 8; ++k) { const unsigned wd = h[k >> 1]; const float hif = (k & 1) ? __uint_as_float(wd & 0xffff0000u) : __uint_as_float(wd << 16);
                        const unsigned ex = (k & 1) ? ((wd >> 23) & 0xffu) : ((wd >> 7) & 0xffu); const unsigned by = (l >> (4 * k)) & 0xfu;
                        xv[k] = hif + lo4_dec(by, ex) + acc[ai][bj][m][k >> 2][k & 3] * alpha; }
                    const f32x4 x0 = (f32x4){xv[0], xv[1], xv[2], xv[3]}, x1 = (f32x4){xv[4], xv[5], xv[6], xv[7]};
                    if (OUT) { *(f32x4*)(OUT + o) = x0; *(f32x4*)(OUT + o + 4) = x1; }
                    else {
#pragma unroll
                        for (int k = 0; k < 8; ++k) sq += xv[k] * xv[k];
                        const u32x4 hn = pack8(x0, x1);
                        unsigned ln = 0u;
#pragma unroll
                        for (int k = 0; k < 8; ++k) { const unsigned wd = hn[k >> 1]; const float hif = (k & 1) ? __uint_as_float(wd & 0xffff0000u) : __uint_as_float(wd << 16);
                            const unsigned ex = (k & 1) ? ((wd >> 23) & 0xffu) : ((wd >> 7) & 0xffu); ln |= lo4_enc(xv[k], hif, ex) << (4 * k); }
                        *(u32x4*)(XB + o) = hn; *(unsigned*)(XL + (o >> 1)) = ln;
                    }
                }
                if (!OUT) { { const int ln_ = fr + 16 * fq; sq += shx(sq, 16, ln_); sq += shx(sq, 32, ln_); }
                    if (fq == 0) ss[(size_t)row * 16 + u.pn * 4 + wc] = sq; }
            }
        }
    }
};
struct EpiRecIn {
    static constexpr bool PERM = true, AFTER_DRAIN = false;
    bf16_t* GG; bf16_t* REC; RsCache rc;
    __device__ __forceinline__ void operator()(const f32x4 (&acc)[2][2][4][2], const Unit& u, int wr, int wc, int fr, int fq) const {
        const bool isgate = u.pn < 4; bf16_t* dst = isgate ? GG : REC; const int col0 = (u.pn & 3) * BM + wc * 32 + 8 * fq;
#pragma unroll
        for (int ai = 0; ai < 2; ++ai)
#pragma unroll
            for (int m = 0; m < 4; ++m) {
                const int row = u.pm * BM + ai * HALF + wr * 64 + m * 16 + fr; const float rs = rc.get(u.pm, ai * HALF + wr * 64 + m * 16 + fr);
#pragma unroll
                for (int bj = 0; bj < 2; ++bj) {
                    f32x4 v0 = acc[ai][bj][m][0] * rs, v1 = acc[ai][bj][m][1] * rs;
                    if (isgate) {
#pragma unroll
                        for (int j = 0; j < 4; ++j) { v0[j] = gelu_tanh_f(v0[j]); v1[j] = gelu_tanh_f(v1[j]); }
                    }
                    *(u32x4*)(dst + (size_t)row * 1024 + col0 + bj * HALF) = pack8(v0, v1);
                }
            }
    }
};
struct EpiQK {
    static constexpr bool PERM = true, AFTER_DRAIN = false;
    bf16_t* QK; bf16_t* VT; RsCache rc; const float* gain; const float* cosT; const float* sinT; float oscale;
    __device__ __forceinline__ void operator()(const f32x4 (&acc)[2][2][4][2], const Unit& u, int wr, int wc, int fr, int fq) const {
        if (u.pn < 4) {
            const int hh = u.pn * 4 + wc;
            f32x4 glo[2], ghi[2];
#pragma unroll
            for (int n = 0; n < 2; ++n) { glo[n] = *(const f32x4*)(gain + 8 * fq + 4 * n); ghi[n] = *(const f32x4*)(gain + 32 + 8 * fq + 4 * n); }
#pragma unroll
            for (int ai = 0; ai < 2; ++ai)
#pragma unroll
                for (int m = 0; m < 4; ++m) {
                    const int row = u.pm * BM + ai * HALF + wr * 64 + m * 16 + fr; const float rs = rc.get(u.pm, ai * HALF + wr * 64 + m * 16 + fr); const int pos = row & 4095;
                    f32x4 v[2][2]; float sq = 0.f;
#pragma unroll
                    for (int bj = 0; bj < 2; ++bj)
#pragma unroll
                        for (int n = 0; n < 2; ++n) { v[bj][n] = acc[ai][bj][m][n] * rs; const f32x4 t = v[bj][n]; sq += (t[0] * t[0] + t[1] * t[1]) + (t[2] * t[2] + t[3] * t[3]); }
                    { const int ln_ = fr + 16 * fq; sq += shx(sq, 16, ln_); sq += shx(sq, 32, ln_); }
                    const float rinv = __builtin_amdgcn_rsqf(sq * (1.0f / 64.0f) + 1e-6f);
                    f32x4 olo[2], ohi[2];
#pragma unroll
                    for (int n = 0; n < 2; ++n) {
                        const f32x4 c = *(const f32x4*)(cosT + (size_t)pos * 32 + 8 * fq + 4 * n), s = *(const f32x4*)(sinT + (size_t)pos * 32 + 8 * fq + 4 * n);
                        const f32x4 ylo = v[0][n] * rinv * glo[n], yhi = v[1][n] * rinv * ghi[n];
                        olo[n] = (ylo * c - yhi * s) * oscale; ohi[n] = (yhi * c + ylo * s) * oscale;
                    }
                    bf16_t* dp = QK + (size_t)row * 1024 + hh * 64 + 8 * fq;
                    *(u32x4*)dp = pack8(olo[0], olo[1]); *(u32x4*)(dp + 32) = pack8(ohi[0], ohi[1]);
                }
        } else {
#pragma unroll
            for (int ai = 0; ai < 2; ++ai)
#pragma unroll
                for (int m = 0; m < 4; ++m) {
                    const int row = u.pm * BM + ai * HALF + wr * 64 + m * 16 + fr; const float rs = rc.get(u.pm, ai * HALF + wr * 64 + m * 16 + fr); const int b = row >> 12, s = row & 4095;
#pragma unroll
                    for (int bj = 0; bj < 2; ++bj)
#pragma unroll
                        for (int n = 0; n < 2; ++n)
#pragma unroll
                            for (int j = 0; j < 4; ++j) {
                                const int col = (u.pn - 4) * BM + bj * HALF + wc * 32 + 8 * fq + 4 * n + j;
                                VT[((size_t)(b * 1024 + col)) * 4096 + s] = cvt_bf16(acc[ai][bj][m][n][j] * rs);
                            }
                }
        }
    }
};

template <class Epi, class Sched, bool ALIGN_EPI = false, bool SP2 = false>
__device__ __forceinline__ void gemm_phase(PG8_LAS unsigned char* lds, const Gemm g, const Sched& S, const Epi& E, const int tid) {
    const int wid = __builtin_amdgcn_readfirstlane(tid >> 6), lane = tid & 63, wr = wid >> 2, wc = wid & 3, fr = lane & 15, fq = lane >> 4;
    const int K = g.K, nt = K / BK;
    unsigned voffA[2], voffB[2];
#pragma unroll
    for (int i = 0; i < 2; ++i) { int R, C; stage_rc(tid * 16 + i * 8192, R, C); const int Rb = Epi::PERM ? ((R & ~31) + perm32(R & 31)) : R;
        voffA[i] = (unsigned)(R * K + C) * 2u; voffB[i] = (unsigned)(Rb * K + C) * 2u; }
    const size_t kstep = (size_t)(BK * 2);
    const size_t hstep = (size_t)HALF * K * 2;
    const size_t tstep = 2 * hstep;
    const unsigned ldsw = (unsigned)wid * 1024u;
    const int aoff = lds_byte(wr * 64 + fr, fq * 8), boff = lds_byte(wc * 32 + fr, fq * 8);
#define PG8_SA(b, h) (((b) * 2 + (h)) * HTB)
#define PG8_SB(b, h) ((4 + (b) * 2 + (h)) * HTB)
#define PG8_STAGE(bufoff, gbase, voff) do { _Pragma("unroll") for (int _i = 0; _i < 2; ++_i) \
        __builtin_amdgcn_global_load_lds((const unsigned*)((const char*)(gbase) + (voff)[_i]), (PG8_LAS unsigned*)(lds + (bufoff) + ldsw + _i * 8192), 16, 0, 0); } while (0)
#define PG8_LDA(dst, b, h) do { _Pragma("unroll") for (int m = 0; m < 4; ++m) _Pragma("unroll") for (int k = 0; k < 2; ++k) dst[m][k] = *(const PG8_LAS bf16x8*)(lds + PG8_SA(b, h) + aoff + m * 2048 + k * 1024); } while (0)
#define PG8_LDB(dst, b, h) do { _Pragma("unroll") for (int n = 0; n < 2; ++n) _Pragma("unroll") for (int k = 0; k < 2; ++k) dst[n][k] = *(const PG8_LAS bf16x8*)(lds + PG8_SB(b, h) + boff + n * 2048 + k * 1024); } while (0)
#define PG8_MMA(ai, bj, At, Bt) do { __builtin_amdgcn_s_setprio(1); _Pragma("unroll") for (int m = 0; m < 4; ++m) _Pragma("unroll") for (int n = 0; n < 2; ++n) _Pragma("unroll") for (int k = 0; k < 2; ++k) \
        acc[ai][bj][m][n] = __builtin_amdgcn_mfma_f32_16x16x32_bf16(Bt[n][k], At[m][k], acc[ai][bj][m][n], 0, 0, 0); __builtin_amdgcn_s_setprio(0); } while (0)
#define PG8_WAIT_V(n) asm volatile("s_waitcnt vmcnt(" #n ")" ::: "memory")
#define PG8_WAIT_L(n) asm volatile("s_waitcnt lgkmcnt(" #n ")" ::: "memory")
#define PG8_BAR __builtin_amdgcn_s_barrier()
#define PG8_SCHED __builtin_amdgcn_sched_barrier(0)
    Unit cur, nxt; int ui = 0;
    if (!S.next(0, cur)) return;
    f32x4 acc[2][2][4][2];
#pragma unroll
    for (int a = 0; a < 2; ++a)
#pragma unroll
        for (int b = 0; b < 2; ++b)
#pragma unroll
            for (int m = 0; m < 4; ++m)
#pragma unroll
                for (int n = 0; n < 2; ++n) acc[a][b][m][n] = (f32x4){0.f, 0.f, 0.f, 0.f};
    bf16x8 At[4][2], B0[2][2], B1[2][2];
    const char* cA = (const char*)g.A + (size_t)cur.pm * tstep; const char* cB = (const char*)g.Bt + (size_t)cur.pn * tstep;
    S.a_ready(cur);
    if constexpr (SP2) {
        PG8_STAGE(PG8_SB(0, 0), cB, voffB); PG8_STAGE(PG8_SB(0, 1), cB + hstep, voffB); PG8_STAGE(PG8_SA(0, 0), cA, voffA); PG8_STAGE(PG8_SA(0, 1), cA + hstep, voffA);
        if (wr == 1) PG8_BAR;
        PG8_WAIT_V(2); PG8_BAR;
        PG8_STAGE(PG8_SB(1, 0), cB + kstep, voffB); PG8_STAGE(PG8_SA(1, 0), cA + kstep, voffA); PG8_STAGE(PG8_SB(1, 1), cB + hstep + kstep, voffB);
        PG8_WAIT_V(6); PG8_BAR;
    } else {
        PG8_STAGE(PG8_SB(0, 0), cB, voffB); PG8_STAGE(PG8_SA(0, 0), cA, voffA); PG8_STAGE(PG8_SB(0, 1), cB + hstep, voffB); PG8_STAGE(PG8_SA(0, 1), cA + hstep, voffA);
        if (wr == 1) PG8_BAR;
        PG8_WAIT_V(4); PG8_BAR;
        PG8_STAGE(PG8_SB(1, 0), cB + kstep, voffB); PG8_STAGE(PG8_SA(1, 0), cA + kstep, voffA); PG8_STAGE(PG8_SB(1, 1), cB + hstep + kstep, voffB);
        PG8_WAIT_V(6); PG8_BAR;
    }
    for (;;) {
        const bool has_next = S.next(ui + 1, nxt);
        const char* nA = has_next ? (const char*)g.A + (size_t)nxt.pm * tstep : cA; const char* nB = has_next ? (const char*)g.Bt + (size_t)nxt.pn * tstep : cB;
        for (int t = 0; t < nt; t += 2) {
            const bool last = (t == nt - 2);
            const char* a1 = cA + (size_t)(t + 1) * kstep;
            const char* a2 = last ? nA : cA + (size_t)(t + 2) * kstep; const char* b2 = last ? nB : cB + (size_t)(t + 2) * kstep;
            const char* a3 = a2 + kstep; const char* b3 = b2 + kstep;
            if (last && has_next) S.a_ready(nxt);
            if constexpr (SP2) {
            PG8_LDB(B0, 0, 0); PG8_LDB(B1, 0, 1); PG8_SCHED; PG8_LDA(At, 0, 0); PG8_STAGE(PG8_SA(1, 1), a1 + hstep, voffA);
            PG8_WAIT_V(8); PG8_WAIT_L(0); PG8_BAR; PG8_MMA(0, 0, At, B0); PG8_MMA(0, 1, At, B1); PG8_BAR; PG8_SCHED;
            PG8_LDA(At, 0, 1); PG8_STAGE(PG8_SB(0, 0), b2, voffB); PG8_STAGE(PG8_SB(0, 1), b2 + hstep, voffB); PG8_STAGE(PG8_SA(0, 0), a2, voffA);
            PG8_WAIT_V(8); PG8_WAIT_L(0); PG8_BAR; PG8_MMA(1, 0, At, B0); PG8_MMA(1, 1, At, B1); PG8_BAR; PG8_SCHED;
            PG8_LDB(B0, 1, 0); PG8_LDB(B1, 1, 1); PG8_SCHED; PG8_LDA(At, 1, 0); PG8_STAGE(PG8_SA(0, 1), a2 + hstep, voffA);
            PG8_WAIT_V(8); PG8_WAIT_L(0); PG8_BAR; PG8_MMA(0, 0, At, B0); PG8_MMA(0, 1, At, B1); PG8_BAR; PG8_SCHED;
            PG8_LDA(At, 1, 1); PG8_STAGE(PG8_SB(1, 0), b3, voffB); PG8_STAGE(PG8_SB(1, 1), b3 + hstep, voffB); PG8_STAGE(PG8_SA(1, 0), a3, voffA);
            PG8_WAIT_V(8); PG8_WAIT_L(0); PG8_BAR; PG8_MMA(1, 0, At, B0); PG8_MMA(1, 1, At, B1); PG8_BAR; PG8_SCHED;
            } else {
            PG8_LDB(B0, 0, 0); PG8_SCHED; PG8_LDA(At, 0, 0); PG8_STAGE(PG8_SA(1, 1), a1 + hstep, voffA);
            PG8_WAIT_L(8); PG8_BAR; PG8_WAIT_L(0); PG8_MMA(0, 0, At, B0); PG8_BAR; PG8_SCHED;
            PG8_LDB(B1, 0, 1); PG8_STAGE(PG8_SB(0, 0), b2, voffB);
            PG8_BAR; PG8_WAIT_L(0); PG8_MMA(0, 1, At, B1); PG8_BAR;
            PG8_LDA(At, 0, 1); PG8_STAGE(PG8_SA(0, 0), a2, voffA);
            PG8_BAR; PG8_WAIT_L(0); PG8_MMA(1, 0, At, B0); PG8_BAR; PG8_SCHED;
            PG8_STAGE(PG8_SB(0, 1), b2 + hstep, voffB);
            PG8_WAIT_V(6); PG8_BAR; PG8_MMA(1, 1, At, B1); PG8_BAR;
            PG8_LDB(B0, 1, 0); PG8_SCHED; PG8_LDA(At, 1, 0); PG8_STAGE(PG8_SA(0, 1), a2 + hstep, voffA);
            PG8_WAIT_L(8); PG8_BAR; PG8_WAIT_L(0); PG8_MMA(0, 0, At, B0); PG8_BAR; PG8_SCHED;
            PG8_LDB(B1, 1, 1); PG8_STAGE(PG8_SB(1, 0), b3, voffB);
            PG8_BAR; PG8_WAIT_L(0); PG8_MMA(0, 1, At, B1); PG8_BAR;
            PG8_LDA(At, 1, 1); PG8_STAGE(PG8_SA(1, 0), a3, voffA);
            PG8_BAR; PG8_WAIT_L(0); PG8_MMA(1, 0, At, B0); PG8_BAR; PG8_SCHED;
            PG8_STAGE(PG8_SB(1, 1), b3 + hstep, voffB);
            PG8_WAIT_V(6); PG8_BAR; PG8_MMA(1, 1, At, B1); PG8_BAR;
            }
        }
        if constexpr (ALIGN_EPI) { if (wr == 0) PG8_BAR; }
        if constexpr (!Epi::AFTER_DRAIN) { E(acc, cur, wr, wc, fr, fq); S.done(cur); }
        if (!has_next) break;
#pragma unroll
        for (int a = 0; a < 2; ++a)
#pragma unroll
            for (int b = 0; b < 2; ++b)
#pragma unroll
                for (int m = 0; m < 4; ++m)
#pragma unroll
                    for (int n = 0; n < 2; ++n) acc[a][b][m][n] = (f32x4){0.f, 0.f, 0.f, 0.f};
        cur = nxt; cA = nA; cB = nB; ++ui;
        if constexpr (ALIGN_EPI) { if (wr == 1) PG8_BAR; }
    }
    PG8_WAIT_V(0);
    if constexpr (!ALIGN_EPI) { if (wr == 0) PG8_BAR; }
    PG8_BAR;
    if constexpr (Epi::AFTER_DRAIN) { E.fused(acc, cur, wr, wc, fr, fq, lds, wid, lane); S.done(cur); }
#undef PG8_SA
#undef PG8_SB
#undef PG8_STAGE
#undef PG8_LDA
#undef PG8_LDB
#undef PG8_MMA
#undef PG8_WAIT_V
#undef PG8_WAIT_L
#undef PG8_BAR
#undef PG8_SCHED
}
}
#define LAS __attribute__((address_space(3)))
typedef unsigned short bf16_t;
typedef short bf16x8 __attribute__((ext_vector_type(8)));
typedef short s16x4 __attribute__((ext_vector_type(4)));
typedef float f32x4 __attribute__((ext_vector_type(4)));
typedef float f32x16 __attribute__((ext_vector_type(16)));
typedef unsigned u32x4 __attribute__((ext_vector_type(4)));
typedef unsigned u32x2 __attribute__((ext_vector_type(2)));
using pg8::cvt_pk_bf16; using pg8::cvt_bf16; using pg8::pack8;

constexpr int BATCH = 4, SEQ = 4096, DM = 1024, MROWS = BATCH * SEQ, FF = 2816;
constexpr int NTHREADS = 512, NWAVES = 8;
constexpr int LDS_BYTES = 147456;
constexpr size_t MiB = 1u << 20;
constexpr size_t WS_SS = 0;
constexpr size_t WS_COS = 1 * MiB, WS_SIN = 1 * MiB + 512 * 1024;
constexpr size_t WS_SPAN = 2 * MiB;
constexpr size_t WS_BAR = 3 * MiB;
constexpr size_t WS_W = 4 * MiB;
constexpr size_t W_FFN_STRIDE = 17301504, W_FFN_DN = 11534336;
constexpr size_t W_REC = WS_W + 132 * MiB, W_REC_STRIDE = 6 * MiB + 512 * 1024, W_REC_G = 4 * MiB, W_REC_OUT = 4 * MiB + 512 * 1024;
constexpr size_t W_KV = WS_W + 145 * MiB, W_Q = WS_W + 149 * MiB, W_O = WS_W + 153 * MiB;
constexpr size_t WS_XB = 162 * MiB, WS_K = 194 * MiB, WS_VT = 226 * MiB, WS_H = 258 * MiB;
constexpr size_t WS_GG = WS_H, WS_REC = WS_H + 32 * MiB, WS_Y = WS_K;
constexpr size_t WS_QO = WS_H, WS_ASCR = WS_H + 32 * MiB;
constexpr size_t WS_O = WS_W;
constexpr size_t WS_XL = 346 * MiB;
constexpr size_t WS_END = 378 * MiB;

struct Params { const float* in[31]; float* out; unsigned char* ws; double invfreq[32]; float linit[2]; int ph_lo, ph_hi, rep_mask, pad; };
typedef const __attribute__((address_space(4))) Params CParams;

__device__ __forceinline__ float wave_sum(float v, int lane) {
#pragma unroll
    for (int o = 1; o < 64; o <<= 1) v += shx(v, o, lane);
    return v;
}
#define LDS_WAIT() asm volatile("s_waitcnt lgkmcnt(0)" ::: "memory")
#define LDS_BARRIER() asm volatile("s_waitcnt lgkmcnt(0)\n\ts_barrier" ::: "memory")

__device__ __forceinline__ void tr_item(const float* W, int ldw, const float* gain, bf16_t* WT, int K, int drow0, int k0, int n0, LAS float* scr, int lane) {
    f32x4 tv[8];
    const float* wp = W + (size_t)(k0 + (lane >> 3)) * ldw + n0 + (lane & 7) * 4;
#pragma unroll
    for (int i = 0; i < 8; ++i) tv[i] = __builtin_nontemporal_load((const f32x4*)(wp + (size_t)(8 * i) * ldw));
    if (gain) {
#pragma unroll
        for (int i = 0; i < 8; ++i) tv[i] = tv[i] * gain[k0 + 8 * i + (lane >> 3)];
    }
#pragma unroll
    for (int i = 0; i < 8; ++i) { LAS float* sp_ = scr + (8 * i + (lane >> 3)) * 33 + (lane & 7) * 4; sp_[0] = tv[i][0]; sp_[1] = tv[i][1]; sp_[2] = tv[i][2]; sp_[3] = tv[i][3]; }
    LDS_WAIT(); asm volatile("" ::: "memory");
    const int c = lane & 7;
#pragma unroll
    for (int j = 0; j < 4; ++j) { const int n = (lane >> 3) + 8 * j; const LAS float* s = scr + (8 * c) * 33 + n;
        u32x4 o; o.x = cvt_pk_bf16(s[0 * 33], s[1 * 33]); o.y = cvt_pk_bf16(s[2 * 33], s[3 * 33]); o.z = cvt_pk_bf16(s[4 * 33], s[5 * 33]); o.w = cvt_pk_bf16(s[6 * 33], s[7 * 33]);
        *(u32x4*)(WT + (size_t)(drow0 + n) * K + k0 + 8 * c) = o; }
    LDS_WAIT(); asm volatile("" ::: "memory");
}
__device__ __forceinline__ int headperm_row0(int n0) { const int sb = n0 >> 5, pn = sb >> 3, rem = sb & 7, wc = rem >> 1, bj = rem & 1; return pn * 256 + bj * 128 + wc * 32; }

__device__ __forceinline__ void prologue_item(CParams& P, int it, LAS float* scr, int lane) {
    unsigned char* ws = P.ws;
    if (it < 16 * 1408) {
        const int mi = it / 1408, r = it % 1408, f = mi >> 1, gu = mi & 1, layer = f >> 1, which = f & 1;
        const float* W = (which ? (gu ? P.in[7] : P.in[6]) : (gu ? P.in[3] : P.in[2])) + (size_t)layer * 1024 * 2816;
        const float* g = (which ? P.in[5] : P.in[1]) + layer * 1024;
        const int kb = r / 88, nb = r % 88, n0 = nb * 32;
        tr_item(W, 2816, g, (bf16_t*)(ws + WS_W + (size_t)f * W_FFN_STRIDE), 1024, (n0 >> 7) * 256 + (n0 & 127) + gu * 128, kb * 64, n0, scr, lane); return; }
    it -= 16 * 1408;
    if (it < 8 * 1408) {
        const int f = it / 1408, r = it % 1408, layer = f >> 1, which = f & 1;
        const float* W = (which ? P.in[8] : P.in[4]) + (size_t)layer * 2816 * 1024;
        const int kb = r / 32, nb = r % 32;
        tr_item(W, 1024, nullptr, (bf16_t*)(ws + WS_W + (size_t)f * W_FFN_STRIDE + W_FFN_DN), 2816, nb * 32, kb * 64, nb * 32, scr, lane); return; }
    it -= 8 * 1408;
    if (it < 2 * 1024) {
        const int a = it / 1024, r = it % 1024, kb = r / 64, nb = r % 64;
        tr_item(P.in[10] + (size_t)a * 1024 * 2048, 2048, P.in[9] + a * 1024, (bf16_t*)(ws + W_REC + (size_t)a * W_REC_STRIDE), 1024, nb * 32, kb * 64, nb * 32, scr, lane); return; }
    it -= 2 * 1024;
    if (it < 256) {
        const int mi = it / 8, r = it % 8, a = mi >> 4, g = (mi >> 3) & 1, blk = mi & 7, kb = r / 4, nb = r % 4;
        const float* W = (g ? P.in[15] : P.in[13]) + (size_t)(a * 8 + blk) * 128 * 128;
        tr_item(W, 128, nullptr, (bf16_t*)(ws + W_REC + (size_t)a * W_REC_STRIDE + W_REC_G) + (size_t)(blk * 2 + g) * 128 * 128, 128, nb * 32, kb * 64, nb * 32, scr, lane); return; }
    it -= 256;
    if (it < 2 * 512) {
        const int a = it / 512, r = it % 512, kb = r / 32, nb = r % 32;
        tr_item(P.in[18] + (size_t)a * 1024 * 1024, 1024, nullptr, (bf16_t*)(ws + W_REC + (size_t)a * W_REC_STRIDE + W_REC_OUT), 1024, nb * 32, kb * 64, nb * 32, scr, lane); return; }
    it -= 2 * 512;
    if (it < 2 * 512) {
        const int v = it / 512, r = it % 512, kb = r / 32, nb = r % 32, n0 = nb * 32;
        tr_item(v ? P.in[21] : P.in[20], 1024, P.in[19], (bf16_t*)(ws + W_KV), 1024, v ? 1024 + n0 : headperm_row0(n0), kb * 64, n0, scr, lane); return; }
    it -= 2 * 512;
    if (it < 2 * 512) {
        const int j = it / 512, r = it % 512, kb = r / 32, nb = r % 32, n0 = nb * 32;
        tr_item(P.in[25] + (size_t)j * 1024 * 1024, 1024, P.in[9] + (2 + j) * 1024, (bf16_t*)(ws + W_Q + (size_t)j * 2 * MiB), 1024, headperm_row0(n0), kb * 64, n0, scr, lane); return; }
    it -= 2 * 512;
    {
        const int j = it / 512, r = it % 512, kb = r / 32, nb = r % 32;
        tr_item(P.in[30] + (size_t)j * 1024 * 1024, 1024, nullptr, (bf16_t*)(ws + W_O + (size_t)j * 2 * MiB), 1024, nb * 32, kb * 64, nb * 32, scr, lane); }
}
__device__ __forceinline__ void ffn_item(CParams& P, int f, int j, LAS float* scr, int lane) { prologue_item(P, (j < 2816) ? f * 2816 + j : 16 * 1408 + f * 1408 + (j - 2816), scr, lane); }
constexpr int N_PRO_ITEMS = 16 * 1408 + 8 * 1408 + 2 * 1024 + 256 + 2 * 512 + 2 * 512 + 2 * 512 + 2 * 512;

__device__ __forceinline__ void prologue(CParams& P, LAS unsigned char* lds, int vcu, int G, const int tid) {
    const int lane = tid & 63, wave = __builtin_amdgcn_readfirstlane(tid >> 6);
    LAS float* scr = (LAS float*)(lds + wave * 16384);
    const int gw = vcu * NWAVES + wave, NGW = G * NWAVES;
    for (int it = gw; it < 4224 + (N_PRO_ITEMS - 24 * 1408); it += NGW) { if (it < 4224) ffn_item(P, 0, it, scr, lane); else prologue_item(P, 24 * 1408 + (it - 4224), scr, lane); }
    const float* x = P.in[0]; bf16_t* XB = (bf16_t*)(P.ws + WS_XB); unsigned char* XL = (unsigned char*)(P.ws + WS_XL); float* ss = (float*)(P.ws + WS_SS);
    for (int m = gw; m < MROWS; m += NGW) {
        const f32x4* xr = (const f32x4*)(x + (size_t)m * DM) + lane; u32x2* bo = (u32x2*)(XB + (size_t)m * DM) + lane; unsigned short* lo = (unsigned short*)(XL + (size_t)m * (DM / 2)) + lane;
        float s = 0.f;
#pragma unroll
        for (int j = 0; j < 4; ++j) { const f32x4 v = xr[64 * j]; s += (v[0] * v[0] + v[1] * v[1]) + (v[2] * v[2] + v[3] * v[3]);
            u32x2 w; w.x = cvt_pk_bf16(v[0], v[1]); w.y = cvt_pk_bf16(v[2], v[3]); bo[64 * j] = w;
            const unsigned q0 = lo4_enc(v[0], __uint_as_float(w.x << 16), (w.x >> 7) & 0xffu), q1 = lo4_enc(v[1], __uint_as_float(w.x & 0xffff0000u), (w.x >> 23) & 0xffu);
            const unsigned q2 = lo4_enc(v[2], __uint_as_float(w.y << 16), (w.y >> 7) & 0xffu), q3 = lo4_enc(v[3], __uint_as_float(w.y & 0xffff0000u), (w.y >> 23) & 0xffu);
            lo[64 * j] = (unsigned short)(q0 | (q1 << 4) | (q2 << 8) | (q3 << 12)); }
        s = wave_sum(s, lane);
        if (lane < 16) ss[(size_t)m * 16 + lane] = (lane == 0) ? s : 0.f;
    }
    float* cosT = (float*)(P.ws + WS_COS); float* sinT = (float*)(P.ws + WS_SIN);
    for (int idx = vcu * NTHREADS + tid; idx < SEQ * 32; idx += G * NTHREADS) {
        const int pos = idx >> 5, i = idx & 31; double f = 0.0;
#pragma unroll
        for (int k = 0; k < 32; ++k) f = (i == k) ? P.invfreq[k] : f;
        const double ang = (double)pos * f; const double kq = __builtin_rint(ang * 0.63661977236758134308); const double r = ang - kq * 1.57079632679489661923;
        const float rf = (float)r, rr = rf * rf;
        const float sr = rf * (1.0f + rr * (-1.6666667e-1f + rr * (8.3333333e-3f + rr * (-1.9841270e-4f + rr * 2.7557319e-6f))));
        const float cr = 1.0f + rr * (-0.5f + rr * (4.1666667e-2f + rr * (-1.3888889e-3f + rr * (2.4801587e-5f + rr * -2.7557319e-7f))));
        const int q = ((int)kq) & 3; const float sv = (q == 0) ? sr : (q == 1) ? cr : (q == 2) ? -sr : -cr; const float cv = (q == 0) ? cr : (q == 1) ? -sr : (q == 2) ? -cr : sr;
        cosT[idx] = cv; sinT[idx] = sv;
    }
}

constexpr int SC_XA = 0, SC_X32 = 17408, SC_BUF = 51200;
__device__ __forceinline__ int sc_rho(int t) { return 16 * ((t >> 2) & 3) + 4 * (t >> 4) + (t & 3); }
__device__ __forceinline__ float bf_lo(unsigned u) { return __uint_as_float(u << 16); }
__device__ __forceinline__ float bf_hi(unsigned u) { return __uint_as_float(u & 0xffff0000u); }
template <int PASS> __device__ __forceinline__ void scan_unit(CParams& P, LAS unsigned char* lds, int a, int b, int n, int sp, const int tid) {
    const int lane = tid & 63, w = __builtin_amdgcn_readfirstlane(tid >> 6), chl = lane & 15, fq = lane >> 4;
    const int ch = 128 * n + 16 * w + chl;
    const bf16_t* REC = (const bf16_t*)(P.ws + WS_REC); const bf16_t* GG = (const bf16_t*)(P.ws + WS_GG); bf16_t* Y = (bf16_t*)(P.ws + WS_Y);
    const bf16_t* GW = (const bf16_t*)(P.ws + W_REC + (size_t)a * W_REC_STRIDE + W_REC_G);
    float* spanA = (float*)(P.ws + WS_SPAN); float* spanH = spanA + BATCH * 8 * 1024;
    bf16x8 bfa[4], bfx[4];
#pragma unroll
    for (int ks = 0; ks < 4; ++ks) { bfa[ks] = *(const bf16x8*)(GW + ((size_t)(n * 2 + 0) * 128 + 16 * w + chl) * 128 + 32 * ks + 8 * fq); bfx[ks] = *(const bf16x8*)(GW + ((size_t)(n * 2 + 1) * 128 + 16 * w + chl) * 128 + 32 * ks + 8 * fq); }
    const float ba = P.in[14][a * 1024 + ch], bxb = P.in[16][a * 1024 + ch];
    const float lamv = P.in[17][a * 1024 + ch];
    const float c8 = -8.0f * log1pf(__expf(-lamv));
    float hc = 0.f, Asp = 1.f;
    if (PASS == 2) {
        float A2[7], H2[7];
#pragma unroll
        for (int s2 = 0; s2 < 7; ++s2) { A2[s2] = spanA[(size_t)(b * 8 + s2) * 1024 + ch]; H2[s2] = spanH[(size_t)(b * 8 + s2) * 1024 + ch]; }
#pragma unroll
        for (int s2 = 0; s2 < 7; ++s2) hc = (s2 < sp) ? (A2[s2] * hc + H2[s2]) : hc;
    }
    const int tp = tid >> 4, cg8 = tid & 15;
    const int rho0 = sc_rho(2 * tp), rho1 = sc_rho(2 * tp + 1);
    const float* cwp = P.in[11] + (size_t)a * 4 * 1024 + 128 * n + 8 * cg8; const float* cbp = P.in[12] + a * 1024 + 128 * n + 8 * cg8;
    const bf16_t* rbase = REC + ((size_t)(b * SEQ + sp * 512 + 2 * tp)) * 1024 + 128 * n + 8 * cg8;
    const bf16_t* gbase = GG + ((size_t)(b * SEQ + sp * 512 + 2 * tp)) * 1024 + 128 * n + 8 * cg8;
    bf16_t* ybase = Y + ((size_t)(b * SEQ + sp * 512 + 2 * tp)) * 1024 + 128 * n + 8 * cg8;
    f32x4 cwa[4], cwb[4];
#pragma unroll
    for (int k = 0; k < 4; ++k) { cwa[k] = *(const f32x4*)(cwp + k * 1024); cwb[k] = *(const f32x4*)(cwp + k * 1024 + 4); }
    const f32x4 cb0 = *(const f32x4*)cbp, cb1 = *(const f32x4*)(cbp + 4);
    u32x4 R[5], G0 = (u32x4){0u, 0u, 0u, 0u}, G1 = (u32x4){0u, 0u, 0u, 0u};
#define SC_LOAD(ci_) do { _Pragma("unroll") for (int k = 0; k < 5; ++k) { const int pos = sp * 512 + (ci_) * 64 + 2 * tp - 3 + k; R[k] = (u32x4){0u, 0u, 0u, 0u}; \
            if (pos >= 0) R[k] = *(const u32x4*)(rbase + ((ci_) * 64 - 3 + k) * 1024); } \
        if (PASS == 2) { G0 = *(const u32x4*)(gbase + (ci_) * 64 * 1024); G1 = *(const u32x4*)(gbase + ((ci_) * 64 + 1) * 1024); } } while (0)
    SC_LOAD(0);
    for (int ci = 0; ci < 8; ++ci) {
        LAS unsigned char* buf = lds + (ci & 1) * SC_BUF;
        LAS float* xf = (LAS float*)(buf + SC_X32);
        const u32x4 Gc0 = G0, Gc1 = G1;
        {
            float x0[8], x1[8];
#pragma unroll
            for (int e = 0; e < 4; ++e) { x0[e] = cb0[e]; x0[4 + e] = cb1[e]; x1[e] = cb0[e]; x1[4 + e] = cb1[e]; }
#pragma unroll
            for (int k = 0; k < 4; ++k) {
                const f32x4 wa = cwa[k], wb = cwb[k];
                const u32x4 ra = R[k], rb = R[k + 1];
                x0[0] += wa[0] * bf_lo(ra.x); x0[1] += wa[1] * bf_hi(ra.x); x0[2] += wa[2] * bf_lo(ra.y); x0[3] += wa[3] * bf_hi(ra.y);
                x0[4] += wb[0] * bf_lo(ra.z); x0[5] += wb[1] * bf_hi(ra.z); x0[6] += wb[2] * bf_lo(ra.w); x0[7] += wb[3] * bf_hi(ra.w);
                x1[0] += wa[0] * bf_lo(rb.x); x1[1] += wa[1] * bf_hi(rb.x); x1[2] += wa[2] * bf_lo(rb.y); x1[3] += wa[3] * bf_hi(rb.y);
                x1[4] += wb[0] * bf_lo(rb.z); x1[5] += wb[1] * bf_hi(rb.z); x1[6] += wb[2] * bf_lo(rb.w); x1[7] += wb[3] * bf_hi(rb.w);
            }
            u32x4 p0, p1; p0.x = cvt_pk_bf16(x0[0], x0[1]); p0.y = cvt_pk_bf16(x0[2], x0[3]); p0.z = cvt_pk_bf16(x0[4], x0[5]); p0.w = cvt_pk_bf16(x0[6], x0[7]);
            p1.x = cvt_pk_bf16(x1[0], x1[1]); p1.y = cvt_pk_bf16(x1[2], x1[3]); p1.z = cvt_pk_bf16(x1[4], x1[5]); p1.w = cvt_pk_bf16(x1[6], x1[7]);
            *(LAS u32x4*)(buf + SC_XA + rho0 * 272 + cg8 * 16) = p0; *(LAS u32x4*)(buf + SC_XA + rho1 * 272 + cg8 * 16) = p1;
            *(LAS f32x4*)(xf + rho0 * 132 + cg8 * 8) = (f32x4){x0[0], x0[1], x0[2], x0[3]}; *(LAS f32x4*)(xf + rho0 * 132 + cg8 * 8 + 4) = (f32x4){x0[4], x0[5], x0[6], x0[7]};
            *(LAS f32x4*)(xf + rho1 * 132 + cg8 * 8) = (f32x4){x1[0], x1[1], x1[2], x1[3]}; *(LAS f32x4*)(xf + rho1 * 132 + cg8 * 8 + 4) = (f32x4){x1[4], x1[5], x1[6], x1[7]};
        }
        if (ci + 1 < 8) SC_LOAD(ci + 1);
        LDS_BARRIER();
        f32x4 ga[4], gx[4];
#pragma unroll
        for (int mt = 0; mt < 4; ++mt) { ga[mt] = (f32x4){0.f, 0.f, 0.f, 0.f}; gx[mt] = (f32x4){0.f, 0.f, 0.f, 0.f};
#pragma unroll
            for (int ks = 0; ks < 4; ++ks) { const bf16x8 af = *(const LAS bf16x8*)(buf + SC_XA + (16 * mt + chl) * 272 + (32 * ks + 8 * fq) * 2);
                ga[mt] = __builtin_amdgcn_mfma_f32_16x16x32_bf16(af, bfa[ks], ga[mt], 0, 0, 0); gx[mt] = __builtin_amdgcn_mfma_f32_16x16x32_bf16(af, bfx[ks], gx[mt], 0, 0, 0); } }
        LAS float* xl = xf + (4 * fq) * 132 + 16 * w + chl;
        float Pm[16], hl[16]; float p = 1.f, hh = 0.f;
#pragma unroll
        for (int mt = 0; mt < 4; ++mt)
#pragma unroll
            for (int r = 0; r < 4; ++r) {
                const float xv = xl[(16 * mt + r) * 132];
                const float rg = __builtin_amdgcn_rcpf(1.0f + __expf(-(ga[mt][r] + ba))), ig = __builtin_amdgcn_rcpf(1.0f + __expf(-(gx[mt][r] + bxb)));
                const float la = c8 * rg, t2 = 2.0f * la, av = __expf(la);
                const float poly = -t2 * (1.0f + t2 * (0.5f + t2 * (1.6666667e-1f + t2 * (4.1666667e-2f + t2 * (8.3333333e-3f + t2 * 1.3888889e-3f)))));
                const float om = (t2 > -0.25f) ? poly : (1.0f - av * av);
                const float bxv = __builtin_amdgcn_sqrtf(om) * ig * xv;
                p *= av; hh = av * hh + bxv; Pm[4 * mt + r] = p; hl[4 * mt + r] = hh;
            }
        float IA = p, IH = hh;
        float pA = shl_from(IA, (lane - 16) & 63), pH = shl_from(IH, (lane - 16) & 63); if (fq >= 1) { IH = IA * pH + IH; IA = IA * pA; }
        pA = shl_from(IA, (lane - 32) & 63); pH = shl_from(IH, (lane - 32) & 63); if (fq >= 2) { IH = IA * pH + IH; IA = IA * pA; }
        float EA = shl_from(IA, (lane - 16) & 63), EH = shl_from(IH, (lane - 16) & 63); if (fq == 0) { EA = 1.f; EH = 0.f; }
        const float TA = shl_from(IA, 48 + chl), TH = shl_from(IH, 48 + chl);
        const float hstart = EA * hc + EH;
        hc = TA * hc + TH; Asp *= TA;
        if (PASS == 2) {
#pragma unroll
            for (int mt = 0; mt < 4; ++mt)
#pragma unroll
                for (int r = 0; r < 4; ++r) xl[(16 * mt + r) * 132] = hl[4 * mt + r] + Pm[4 * mt + r] * hstart;
            LDS_BARRIER();
            const f32x4 h00 = *(const LAS f32x4*)(xf + rho0 * 132 + cg8 * 8), h01 = *(const LAS f32x4*)(xf + rho0 * 132 + cg8 * 8 + 4);
            const f32x4 h10 = *(const LAS f32x4*)(xf + rho1 * 132 + cg8 * 8), h11 = *(const LAS f32x4*)(xf + rho1 * 132 + cg8 * 8 + 4);
            u32x4 y0, y1;
            y0.x = cvt_pk_bf16(bf_lo(Gc0.x) * h00[0], bf_hi(Gc0.x) * h00[1]); y0.y = cvt_pk_bf16(bf_lo(Gc0.y) * h00[2], bf_hi(Gc0.y) * h00[3]);
            y0.z = cvt_pk_bf16(bf_lo(Gc0.z) * h01[0], bf_hi(Gc0.z) * h01[1]); y0.w = cvt_pk_bf16(bf_lo(Gc0.w) * h01[2], bf_hi(Gc0.w) * h01[3]);
            y1.x = cvt_pk_bf16(bf_lo(Gc1.x) * h10[0], bf_hi(Gc1.x) * h10[1]); y1.y = cvt_pk_bf16(bf_lo(Gc1.y) * h10[2], bf_hi(Gc1.y) * h10[3]);
            y1.z = cvt_pk_bf16(bf_lo(Gc1.z) * h11[0], bf_hi(Gc1.z) * h11[1]); y1.w = cvt_pk_bf16(bf_lo(Gc1.w) * h11[2], bf_hi(Gc1.w) * h11[3]);
            *(u32x4*)(ybase + (size_t)(ci * 64) * 1024) = y0; *(u32x4*)(ybase + (size_t)(ci * 64 + 1) * 1024) = y1;
        }
    }
#undef SC_LOAD
    if (PASS == 1 && fq == 0) { spanA[(size_t)(b * 8 + sp) * 1024 + ch] = Asp; spanH[(size_t)(b * 8 + sp) * 1024 + ch] = hc; }
    __syncthreads();
}

constexpr int AT_K1 = 0, AT_K2 = 9216, AT_V = 18432, AT_BUF = 36864, AT_Q = 2 * AT_BUF, AT_QW = 8704;
__device__ __forceinline__ int crow(int r, int hi) { return (r & 3) + 8 * (r >> 2) + 4 * hi; }
__device__ __forceinline__ void attn_map(const LAS unsigned char* Kb, const LAS unsigned char* Vb, const LAS unsigned char* Qc, f32x16 (&o)[4], float& lsum, const int q, const int hi) {
    u32x4 pw[4];
    const LAS unsigned char* kq = Kb + q * 144 + hi * 16;
#pragma unroll
    for (int blk = 0; blk < 2; ++blk) {
        f32x16 p;
#pragma unroll
        for (int r = 0; r < 16; ++r) p[r] = 0.f;
        bf16x8 kf[2], qf[2];
#define AT_KQ(ds) do { kf[(ds) & 1] = *(const LAS bf16x8*)(kq + blk * (32 * 144) + (ds) * 32); qf[(ds) & 1] = *(const LAS bf16x8*)(Qc + (ds) * 32); } while (0)
        AT_KQ(0); AT_KQ(1);
        __builtin_amdgcn_sched_barrier(0);
#pragma unroll
        for (int ds = 0; ds < 4; ++ds) { p = __builtin_amdgcn_mfma_f32_32x32x16_bf16(kf[ds & 1], qf[ds & 1], p, 0, 0, 0); if (ds + 2 < 4) AT_KQ(ds + 2); __builtin_amdgcn_sched_barrier(0); }
#undef AT_KQ
        float sa = 0.f;
#pragma unroll
        for (int r = 0; r < 16; ++r) { p[r] = __builtin_amdgcn_exp2f(p[r]); sa += p[r]; }
        lsum += sa;
#pragma unroll
        for (int e = 0; e < 4; ++e) { pw[2 * blk][e] = cvt_pk_bf16(p[2 * e], p[2 * e + 1]); pw[2 * blk + 1][e] = cvt_pk_bf16(p[8 + 2 * e], p[8 + 2 * e + 1]); }
        __builtin_amdgcn_sched_barrier(0);
    }
    {   bf16x8 vf[4];
        const LAS unsigned char* vq = Vb + q * 144 + hi * 16;
#define AT_VREAD(i) do { vf[(i) & 3] = *(const LAS bf16x8*)(vq + ((i) >> 2) * (32 * 144) + ((i) & 3) * 32); } while (0)
        AT_VREAD(0); AT_VREAD(1); AT_VREAD(2); AT_VREAD(3);
        __builtin_amdgcn_sched_barrier(0);
#pragma unroll
        for (int i = 0; i < 16; ++i) {
            o[i >> 2] = __builtin_amdgcn_mfma_f32_32x32x16_bf16(__builtin_bit_cast(bf16x8, pw[i & 3]), vf[i & 3], o[i >> 2], 0, 0, 0);
            if (i + 4 < 16) AT_VREAD(i + 4);
            __builtin_amdgcn_sched_barrier(0);
        }
#undef AT_VREAD
    }
}
__device__ __forceinline__ void attn_unit(CParams& P, LAS unsigned char* lds, int b, int h, int qb, int j, float lam, float linit, const int tid_in) {
    int tid = tid_in; asm volatile("" : "+v"(tid));
    const int lane = tid & 63, w = __builtin_amdgcn_readfirstlane(tid >> 6), q = lane & 31, hi = lane >> 5;
    const bf16_t* Q = (const bf16_t*)(P.ws + WS_QO); bf16_t* O = (bf16_t*)(P.ws + WS_O);
    const bf16_t* Kg = (const bf16_t*)(P.ws + WS_K); const bf16_t* VT = (const bf16_t*)(P.ws + WS_VT);
    const int NT = 4 * qb + 4, mylast = 4 * qb + (w >> 1);
    const int row0 = b * SEQ + qb * 256 + 32 * w;
    LAS unsigned char* Qw = lds + AT_Q + w * AT_QW;
    u32x4 qv[8];
    {   const bf16_t* qsrc = Q + (size_t)(row0 + (lane >> 4)) * 1024 + h * 128 + (lane & 15) * 8;
#pragma unroll
        for (int i = 0; i < 8; ++i) qv[i] = *(const u32x4*)(qsrc + (size_t)(4 * i) * 1024);
    }
    const LAS unsigned char* Qc0 = Qw + q * 272 + hi * 16;
    f32x16 o1[4], o2[4];
#pragma unroll
    for (int d = 0; d < 4; ++d)
#pragma unroll
        for (int r = 0; r < 16; ++r) { o1[d][r] = 0.f; o2[d][r] = 0.f; }
    float l1 = 0.f, l2 = 0.f;
#define AT_ADDR() \
    const int kr = tid >> 4, kc16 = tid & 15; \
    const unsigned koff = (unsigned)(((b * SEQ + kr) * 1024 + h * 128 + kc16 * 8) * 2);          \
    const int kdst = ((kc16 < 8) ? AT_K1 : AT_K2) + kr * 144 + (kc16 & 7) * 16;              \
    const int dv0 = tid >> 3, kc = tid & 7; \
    const unsigned voff = (unsigned)((((b * 8 + h) * 128 + dv0) * 4096 + kc * 8) * 2);           \
    const int vdst = AT_V + dv0 * 144 + 32 * (kc >> 1) + 8 * (kc & 1);
    u32x4 rk0, rk1, rv0, rv1;
#define AT_LOAD(t) do { const unsigned ko_ = koff + (unsigned)(t) * 131072u, vo_ = voff + (unsigned)(t) * 128u; \
        rk0 = *(const u32x4*)((const char*)Kg + ko_); rk1 = *(const u32x4*)((const char*)Kg + (ko_ + 65536u)); \
        rv0 = *(const u32x4*)((const char*)VT + vo_); rv1 = *(const u32x4*)((const char*)VT + (vo_ + 524288u)); } while (0)
#define AT_WRITE(Bp) do { LAS unsigned char* B_ = (Bp); *(LAS u32x4*)(B_ + kdst) = rk0; *(LAS u32x4*)(B_ + kdst + 32 * 144) = rk1; \
        *(LAS u32x2*)(B_ + vdst) = (u32x2){rv0.x, rv0.y}; *(LAS u32x2*)(B_ + vdst + 16) = (u32x2){rv0.z, rv0.w}; \
        *(LAS u32x2*)(B_ + vdst + 64 * 144) = (u32x2){rv1.x, rv1.y}; *(LAS u32x2*)(B_ + vdst + 64 * 144 + 16) = (u32x2){rv1.z, rv1.w}; } while (0)
    {   AT_ADDR()
        AT_LOAD(0);
        __builtin_amdgcn_sched_barrier(0);
#pragma unroll
        for (int i = 0; i < 8; ++i) *(LAS u32x4*)(Qw + ((lane >> 4) + 4 * i) * 272 + (lane & 15) * 16) = qv[i];
        AT_WRITE(lds);
        LDS_BARRIER();
        for (int kt = 0; kt <= mylast; ++kt) {
            { const int tn_ = (kt + 1 < NT) ? kt + 1 : NT - 1; AT_LOAD(tn_); }
            const LAS unsigned char* B_ = lds + (kt & 1) * AT_BUF;
            attn_map(B_ + AT_K1, B_ + AT_V, Qc0, o1, l1, q, hi);
            attn_map(B_ + AT_K2, B_ + AT_V, Qc0 + 128, o2, l2, q, hi);
            AT_WRITE(lds + ((kt + 1) & 1) * AT_BUF);
            LDS_BARRIER();
        }
    }
    { unsigned z_ = 0u; asm volatile("" : "+v"(z_)); tid = (w << 6) + (int)__builtin_amdgcn_mbcnt_hi(~0u, __builtin_amdgcn_mbcnt_lo(~0u, z_)); }
    {   AT_ADDR()
        for (int kt = mylast + 1; kt < NT; ++kt) {
            { const int tn_ = (kt + 1 < NT) ? kt + 1 : NT - 1; AT_LOAD(tn_); }
            AT_WRITE(lds + ((kt + 1) & 1) * AT_BUF);
            LDS_BARRIER();
        }
    }
#undef AT_ADDR
#undef AT_LOAD
#undef AT_WRITE
    asm volatile("" : "+v"(tid));
    const int lane_e = tid & 63, q_e = lane_e & 31, hi_e = lane_e >> 5;
    l1 += shx(l1, 32, lane_e); l2 += shx(l2, 32, lane_e);
    LAS float* wl = (LAS float*)(Qw + 4608);
    if (hi_e == 0) { wl[q_e] = 1.0f / l1; wl[32 + q_e] = -lam / l2; }
    const LAS float* wlh = wl + 4 * hi_e;
    const float* gs = P.in[29] + j * 128;
    float gsv[4];
#pragma unroll
    for (int d = 0; d < 4; ++d) gsv[d] = gs[32 * d + q_e] * (1.0f - linit);
    bf16_t* obase2 = O + (size_t)(row0 + (lane_e >> 4)) * 1024 + h * 128 + (lane_e & 15) * 8;
    LAS unsigned char* stg = Qw;
#pragma unroll
    for (int r4 = 0; r4 < 4; ++r4) {
        f32x4 la, lb;
#pragma unroll
        for (int e = 0; e < 4; ++e) { la[e] = wlh[e + 8 * r4]; lb[e] = wlh[32 + e + 8 * r4]; }
#pragma unroll
        for (int e = 0; e < 4; ++e) {
            float df[4]; float sq = 0.f;
#pragma unroll
            for (int d = 0; d < 4; ++d) { df[d] = o1[d][4 * r4 + e] * la[e] + o2[d][4 * r4 + e] * lb[e]; sq += df[d] * df[d]; }
            sq += shx(sq, 1, lane_e); sq += shx(sq, 2, lane_e); sq += shx(sq, 4, lane_e); sq += shx(sq, 8, lane_e); sq += shx(sq, 16, lane_e);
            const float rinv = __builtin_amdgcn_rsqf(sq * (1.0f / 128.0f) + 1e-5f);
            LAS unsigned short* sr = (LAS unsigned short*)(stg + ((e + 8 * (r4 & 1) + 4 * hi_e) * 288) + q_e * 2);
#pragma unroll
            for (int d = 0; d < 4; ++d) sr[32 * d] = cvt_bf16(df[d] * rinv * gsv[d]);
        }
        if (r4 & 1) {
            LDS_WAIT();
#pragma unroll
            for (int i = 0; i < 4; ++i) {
                const u32x4 v = *(const LAS u32x4*)(stg + ((lane_e >> 4) + 4 * i) * 288 + (lane_e & 15) * 16);
                bf16_t* op = obase2; asm volatile("" : "+v"(op));
                *(u32x4*)(op + (size_t)(16 * (r4 >> 1) + 4 * i) * 1024) = v; }
            LDS_WAIT();
        }
    }
    __syncthreads();
}

#define XB_TMO      128
#define XB_XCNT(j)  (256  + 64 * (j))
#define XB_XSUB(j)  (1280 + 64 * (j))
#define XB_XGEN(j)  (2304 + 64 * (j))
#define XB_TOP      3328
#define XB_TOPGEN   3392
#define XCD_BAR_WORDS 3456
#define XB_SPIN_CAP (1u << 18)

__device__ __forceinline__ unsigned xb_ld(unsigned* p)              { return __hip_atomic_load(p, __ATOMIC_RELAXED, __HIP_MEMORY_SCOPE_AGENT); }
__device__ __forceinline__ unsigned xb_add(unsigned* p, unsigned v) { return __hip_atomic_fetch_add(p, v, __ATOMIC_RELAXED, __HIP_MEMORY_SCOPE_AGENT); }
__device__ __forceinline__ unsigned xb_xcc_id() { return (unsigned)__builtin_amdgcn_s_getreg((3 << 11) | 20) & 0xFu; }
#define XB_SPIN(cond, bar) do { unsigned _sp = 0; while (cond) { __builtin_amdgcn_s_sleep(1); \
    if ((++_sp & 255u) == 0u) { if (xb_ld(&(bar)[XB_TMO])) break; if (_sp > XB_SPIN_CAP) { atomicAdd(&(bar)[XB_TMO], 1u); break; } } } } while (0)

struct XcdBarrier {
    unsigned* bar; unsigned x;
    volatile LAS unsigned* st;
};

__device__ __forceinline__ XcdBarrier xcd_barrier_post(unsigned* bar, volatile LAS unsigned* st) {
    XcdBarrier b; b.bar = bar; b.x = xb_xcc_id(); b.st = st;
    if (threadIdx.x == 0) (void)xb_add(&bar[XB_XCNT(b.x)], 1u);
    return b;
}
__device__ __forceinline__ void xcd_barrier_complete(unsigned* bar, unsigned x, unsigned& nloc, unsigned& nx) {
    const unsigned G = gridDim.x * gridDim.y * gridDim.z;
    unsigned sum, cnt, mine, sp = 0u;
    for (;;) {
        sum = 0u; cnt = 0u; mine = 0u;
#pragma unroll
        for (unsigned j = 0; j < 16; ++j) { const unsigned c = xb_ld(&bar[XB_XCNT(j)]); sum += c; cnt += (c > 0u) ? 1u : 0u; mine = (j == x) ? c : mine; }
        if (sum == G) break;
        __builtin_amdgcn_s_sleep(1);
        if ((++sp & 255u) == 0u) { if (xb_ld(&bar[XB_TMO])) break; if (sp > XB_SPIN_CAP) { atomicAdd(&bar[XB_TMO], 1u); break; } }
    }
    nloc = mine > 0u ? mine : 1u; nx = cnt > 0u ? cnt : 1u;
}

__device__ __forceinline__ void xcd_barrier(const XcdBarrier& b, const bool is_t0) {
    asm volatile("s_waitcnt vmcnt(0)" ::: "memory");
    __syncthreads();
    if (is_t0) {
        unsigned* bar = b.bar;
        __builtin_amdgcn_s_waitcnt(0);
        unsigned nloc = b.st[0], nx = b.st[1];
        if (nloc == 0u) { xcd_barrier_complete(bar, b.x, nloc, nx); b.st[0] = nloc; b.st[1] = nx; }
        const unsigned old = xb_add(&bar[XB_XSUB(b.x)], 1u);
        const unsigned gen = old / nloc;
        if (old + 1u == (gen + 1u) * nloc) {
            __builtin_amdgcn_fence(__ATOMIC_RELEASE, "agent");
            asm volatile("s_waitcnt vmcnt(0)" ::: "memory");
            const unsigned og = xb_add(&bar[XB_TOP], 1u);
            const unsigned tg = og / nx;
            if (og + 1u == (tg + 1u) * nx) xb_add(&bar[XB_TOPGEN], 1u);
            else XB_SPIN(xb_ld(&bar[XB_TOPGEN]) == tg, bar);
            __builtin_amdgcn_fence(__ATOMIC_ACQUIRE, "agent");
            xb_add(&bar[XB_XGEN(b.x)], 1u);
            asm volatile("s_waitcnt vmcnt(0)" ::: "memory");
        } else {
            XB_SPIN(xb_ld(&bar[XB_XGEN(b.x)]) == gen, bar);
            __builtin_amdgcn_fence(__ATOMIC_ACQUIRE, "agent");
            asm volatile("s_waitcnt vmcnt(0)" ::: "memory");
        }
    }
    __syncthreads();
}


__device__ __forceinline__ pg8::RsCache make_rs_cache(LAS unsigned char* lds, const float* ss, int N, const int tid) {
    pg8::StaticOrder S; S.init(MROWS, N, (int)gridDim.x, (int)blockIdx.x); pg8::Unit u0; u0.pm = 0; u0.pn = 0; const bool any = S.next(0, u0);
    LAS float* tab = (LAS float*)(lds + LDS_BYTES - 1024);
    if (any && tid < 256) tab[tid] = pg8::row_rs(ss, u0.pm * 256 + tid);
    __syncthreads();
    return pg8::RsCache{tab, any ? u0.pm : -1, ss};
}
template <class Epi> __device__ __forceinline__ void run_gemm(LAS unsigned char* lds, const bf16_t* A, const bf16_t* Bt, int N, int K, const Epi& E, const int tid) {
    pg8::Gemm g{A, Bt, MROWS, N, K}; pg8::StaticOrder S; S.init(MROWS, N, (int)gridDim.x, (int)blockIdx.x);
    pg8::gemm_phase<Epi, pg8::StaticOrder, true, true>(lds, g, S, E, tid);
}
enum { OP_PRO = 0, OP_UP, OP_DOWN, OP_RECIN, OP_SCAN1, OP_SCAN2, OP_RECOUT, OP_KV, OP_QG, OP_ATTN, OP_WO };
constexpr int N_STEPS = 32;

__global__ void __launch_bounds__(NTHREADS) mega_fwd(Params P0) {
    extern __shared__ __attribute__((aligned(16))) unsigned char lds_raw[];
    LAS unsigned char* lds = (LAS unsigned char*)lds_raw;
    cg::grid_group grid = cg::this_grid();
    volatile LAS unsigned* bar_st = (volatile LAS unsigned*)(lds + LDS_BYTES - 2048);
    if (threadIdx.x < 2) bar_st[threadIdx.x] = 0u;
    __syncthreads();
    XcdBarrier xbar = xcd_barrier_post((unsigned*)(P0.ws + WS_BAR), bar_st);
    const int wave_s = __builtin_amdgcn_readfirstlane(threadIdx.x >> 6);
    auto mk_tid = [&]() -> int { unsigned z = 0u; asm volatile("" : "+v"(z)); return (wave_s << 6) + (int)__builtin_amdgcn_mbcnt_hi(~0u, __builtin_amdgcn_mbcnt_lo(~0u, z)); };
#define MK_TID() mk_tid()
    const int G = gridDim.x, bx = blockIdx.x, vcu = (G % 8 == 0) ? (bx % 8) * (G / 8) + bx / 8 : bx;
    for (int st = P0.ph_lo; st < P0.ph_hi; ++st) {
        int op, layer = 0, f = 0;
        if (st == 0) op = OP_PRO;
        else if (st <= 16) { const int k = (st - 1) & 7; layer = (st - 1) >> 3; f = layer * 2 + (k >= 6);
            op = (k == 0 || k == 6) ? OP_UP : (k == 1 || k == 7) ? OP_DOWN : (k == 2) ? OP_RECIN : (k == 3) ? OP_SCAN1 : (k == 4) ? OP_SCAN2 : OP_RECOUT; }
        else if (st == 17) { op = OP_KV; layer = 2; }
        else { const int q = st - 18, k = q % 7; layer = 2 + q / 7; f = layer * 2 + (k >= 5);
            op = (k == 0 || k == 5) ? OP_UP : (k == 1 || k == 6) ? OP_DOWN : (k == 2) ? OP_QG : (k == 3) ? OP_ATTN : OP_WO; }
        if (st > P0.ph_lo && st != 18) { if (P0.rep_mask & 0x4000) grid.sync(); else xcd_barrier(xbar, MK_TID() == 0); if (P0.rep_mask & 0x8000) { xcd_barrier(xbar, MK_TID() == 0); xcd_barrier(xbar, MK_TID() == 0); } }
        const int a = layer, jl = layer - 2;
#ifndef OPMASK
#define OPMASK 0xFFFF
#endif
#define HAS(o) ((OPMASK >> (o)) & 1)
#ifndef PROBE_REP_MASK
#define PROBE_REP_MASK 0
#endif
        const int nrep = ((P0.rep_mask >> op) & 1) ? 2 : 1;
        for (int rep = 0; rep < nrep; ++rep) {
        if (rep) xcd_barrier(xbar, MK_TID() == 0);
#define STEP_LOCALS() int tid = MK_TID(); asm volatile("" : "+v"(tid)); CParams* Pp = (CParams*)__builtin_amdgcn_kernarg_segment_ptr(); asm volatile("" : "+s"(Pp)); CParams& P = *Pp; \
        unsigned char* ws = P.ws; asm volatile("" : "+s"(ws)); bf16_t* XB = (bf16_t*)(ws + WS_XB); float* ss = (float*)(ws + WS_SS); bf16_t* HB = (bf16_t*)(ws + WS_H); (void)XB; (void)ss; (void)HB; (void)tid;
        switch (op) {
        case OP_PRO: if (HAS(0)) { STEP_LOCALS() prologue(P, lds, vcu, G, tid); } break;
        case OP_UP: if (HAS(1)) { STEP_LOCALS() pg8::EpiSwiglu E{HB, make_rs_cache(lds, ss, 5632, tid)}; run_gemm(lds, XB, (const bf16_t*)(ws + WS_W + (size_t)f * W_FFN_STRIDE), 5632, 1024, E, tid);
            if (f < 7 && G == 256 && rep == 0) {
                if (bx >= 128) { const int lane = tid & 63, wave = __builtin_amdgcn_readfirstlane(tid >> 6); LAS float* scr = (LAS float*)(lds + wave * 16384);
                    for (int it = (bx - 128) * NWAVES + wave; it < 4224; it += 128 * NWAVES) ffn_item(P, f + 1, it, scr, lane); }
            } else if (f < 7 && rep == 0) { const int lane = tid & 63, wave = __builtin_amdgcn_readfirstlane(tid >> 6); LAS float* scr = (LAS float*)(lds + wave * 16384);
                for (int it = vcu * NWAVES + wave; it < 4224; it += G * NWAVES) ffn_item(P, f + 1, it, scr, lane); }
        } break;
        case OP_DOWN: case OP_RECOUT: case OP_WO: if (HAS(2)) { STEP_LOCALS()
            const bf16_t* A = (op == OP_DOWN) ? HB : (op == OP_RECOUT) ? (const bf16_t*)(ws + WS_Y) : (const bf16_t*)(ws + WS_O);
            const bf16_t* Bt = (op == OP_DOWN) ? (const bf16_t*)(ws + WS_W + (size_t)f * W_FFN_STRIDE + W_FFN_DN) : (op == OP_RECOUT) ? (const bf16_t*)(ws + W_REC + (size_t)a * W_REC_STRIDE + W_REC_OUT) : (const bf16_t*)(ws + W_O + (size_t)jl * 2 * MiB);
            pg8::EpiResid E{(st == N_STEPS - 1) ? P.out : nullptr, XB, (unsigned char*)(ws + WS_XL), ss, __uint_as_float((op == OP_DOWN) ? 0x3f000000u : 0x3f800000u)}; run_gemm(lds, A, Bt, 1024, (op == OP_DOWN) ? 2816 : 1024, E, tid); } break;
        case OP_RECIN: if (HAS(3)) { STEP_LOCALS() pg8::EpiRecIn E{(bf16_t*)(ws + WS_GG), (bf16_t*)(ws + WS_REC), make_rs_cache(lds, ss, 2048, tid)}; run_gemm(lds, XB, (const bf16_t*)(ws + W_REC + (size_t)a * W_REC_STRIDE), 2048, 1024, E, tid); } break;
        case OP_SCAN1: if (HAS(4)) { STEP_LOCALS() for (int u = vcu; u < 256; u += G) scan_unit<1>(P, lds, a, u >> 6, (u >> 3) & 7, u & 7, tid); } break;
        case OP_SCAN2: if (HAS(5)) { STEP_LOCALS() for (int u = vcu; u < 256; u += G) scan_unit<2>(P, lds, a, u >> 6, (u >> 3) & 7, u & 7, tid); } break;
        case OP_KV: case OP_QG: if (HAS(7)) { STEP_LOCALS()
            const bool kv = (op == OP_KV);
            pg8::EpiQK E{kv ? (bf16_t*)(ws + WS_K) : (bf16_t*)(ws + WS_QO), (bf16_t*)(ws + WS_VT), make_rs_cache(lds, ss, kv ? 2048 : 1024, tid), kv ? P.in[22] : P.in[26] + jl * 64, (const float*)(ws + WS_COS), (const float*)(ws + WS_SIN), kv ? 1.0f : 0.125f * 1.4426950408889634f};
            run_gemm(lds, XB, kv ? (const bf16_t*)(ws + W_KV) : (const bf16_t*)(ws + W_Q + (size_t)jl * 2 * MiB), kv ? 2048 : 1024, 1024, E, tid); } break;
        case OP_ATTN: if (HAS(9)) { STEP_LOCALS()
            const int tid_a = MK_TID();
            const int lane = tid_a & 63;
            const float q1 = P.in[27][jl * 64 + lane], q2 = P.in[28][jl * 64 + lane], k1 = P.in[23][lane], k2 = P.in[24][lane];
            const float linit = jl ? P.linit[1] : P.linit[0];
            const float lam = __uint_as_float(__builtin_amdgcn_readfirstlane(__float_as_uint(__expf(wave_sum(q1 * k1, lane)) - __expf(wave_sum(q2 * k2, lane)) + linit)));
            for (int pr = vcu; pr < 256; pr += G) { const int bh = pr >> 3, s = pr & 7;
#pragma unroll 1
                for (int uu = 0; uu < 2; ++uu) attn_unit(P, lds, bh >> 3, bh & 7, uu ? s : 15 - s, jl, lam, linit, tid_a); }
        } break;
        }
        }
    }
}

#ifndef MK_PER_STEP
#define MK_PER_STEP 0
#endif
extern "C" void kernel_launch(void* const* d_in, const int* in_sizes, int n_in, void* d_out, int out_size, void* d_ws, size_t ws_size, hipStream_t stream) {
    static int grid = 0;
    if (grid == 0) {
        int dev = 0, cus = 0, per_cu = 0;
        if (n_in != 31 || out_size != MROWS * DM || ws_size < WS_END) { fprintf(stderr, "kernel_launch: unexpected shapes (n_in %d out %d ws %zu)\n", n_in, out_size, ws_size); grid = -1; return; }
        hipGetDevice(&dev); hipDeviceGetAttribute(&cus, hipDeviceAttributeMultiprocessorCount, dev);
        hipFuncSetAttribute((const void*)mega_fwd, hipFuncAttributeMaxDynamicSharedMemorySize, LDS_BYTES);
        hipOccupancyMaxActiveBlocksPerMultiprocessor(&per_cu, (const void*)mega_fwd, NTHREADS, LDS_BYTES);
        (void)hipGetLastError();
        if (per_cu < 1) per_cu = 1;
        grid = cus * 1;
        if (grid <= 0) grid = 256;
    }
    if (grid < 0) return;
    Params p{};
    for (int i = 0; i < 31; ++i) p.in[i] = (const float*)d_in[i];
    p.out = (float*)d_out; p.ws = (unsigned char*)d_ws; p.rep_mask = PROBE_REP_MASK;
    p.linit[0] = (float)(0.8 - 0.6 * std::exp(-0.3 * 2.0)); p.linit[1] = (float)(0.8 - 0.6 * std::exp(-0.3 * 3.0));
    for (int i = 0; i < 32; ++i) p.invfreq[i] = std::pow(10000.0, -(double)(2 * i) / 64.0);
    (void)hipMemsetAsync((char*)d_ws + WS_BAR, 0, 16384, stream);
#if MK_PER_STEP
    for (int st = 0; st < N_STEPS; ++st) { p.ph_lo = st; p.ph_hi = st + 1; hipLaunchKernelGGL(mega_fwd, dim3(grid), dim3(NTHREADS), LDS_BYTES, stream, p); }
#else
    p.ph_lo = 0; p.ph_hi = N_STEPS;
    void* args[] = {&p};
    hipError_t e = hipLaunchCooperativeKernel((const void*)mega_fwd, dim3(grid), dim3(NTHREADS), args, LDS_BYTES, stream);
    if (e != hipSuccess) fprintf(stderr, "cooperative launch failed: %s (grid %d)\n", hipGetErrorString(e), grid);
#endif
}
```

```cpp
#include <hip/hip_runtime.h>
#include <hip/hip_cooperative_groups.h>
#include <cstdio>
#include <cstdint>
#include <cmath>
namespace cg = cooperative_groups;
__device__ __forceinline__ float shx(float v, int k, int lane) { return __int_as_float(__builtin_amdgcn_ds_bpermute((lane ^ k) << 2, __float_as_int(v))); }
__device__ __forceinline__ float shl_from(float v, int src) { return __int_as_float(__builtin_amdgcn_ds_bpermute(src << 2, __float_as_int(v))); }
__device__ __forceinline__ unsigned lo4_enc(float x, float hif, unsigned hb) { unsigned eb = hb & 0x7f800000u; eb = (eb > (12u << 23)) ? eb : (12u << 23);
    const float inv = __uint_as_float((265u << 23) - eb); float q = rintf(fmaf(x - hif, inv, 8.f)); q = fminf(fmaxf(q, 0.f), 15.f); return (unsigned)q; }
__device__ __forceinline__ float lo4_dec(unsigned nib, unsigned hb) { unsigned eb = hb & 0x7f800000u; eb = (eb > (12u << 23)) ? eb : (12u << 23);
    const float sc = __uint_as_float(eb - (11u << 23)); return ((float)nib - 8.f) * sc; }
namespace pg8 {
#define PG8_LAS __attribute__((address_space(3)))
typedef unsigned short bf16_t;
typedef short bf16x8 __attribute__((ext_vector_type(8)));
typedef float f32x4 __attribute__((ext_vector_type(4)));
typedef unsigned u32x4 __attribute__((ext_vector_type(4)));
constexpr int BM = 256, BK = 64, HALF = 128, HTB = HALF * BK * 2  , STAGE_BYTES = 8 * HTB, NXCD = 8, WGM = 8;

__host__ __device__ __forceinline__ int lds_byte(int r, int c) { const int st = (r >> 4) * 2 + (c >> 5), rr = r & 15, cc = c & 31, ob = rr * 64 + cc * 2; return st * 1024 + (ob ^ (((ob >> 9) & 1) << 5)); }
__host__ __device__ __forceinline__ void stage_rc(int b, int& R, int& C) { const int st = b / 1024, sb = b % 1024, swz = sb ^ (((sb >> 9) & 1) << 5); R = (st >> 1) * 16 + swz / 64; C = (st & 1) * 32 + (swz % 64) / 2; }
__host__ __device__ __forceinline__ int perm32(int rho) { const int n = rho >> 4, i = rho & 15; return 8 * (i >> 2) + 4 * n + (i & 3); }

struct Unit { int pm, pn; };
struct Gemm { const bf16_t* A; const bf16_t* Bt; int M, N, K; };

struct StaticOrder {
    int nM, nN, nwg, G, c;
    __host__ __device__ void init(int M, int N, int G_, int c_) { nM = M / BM; nN = N / BM; nwg = nM * nN; G = G_; c = c_; }
    __host__ __device__ bool next(int i, Unit& u) const {
        const long L = (long)i * G + c; if (L >= nwg) return false;
        int wgid = (int)L; { const int q = nwg / NXCD, r = nwg % NXCD, xcd = wgid % NXCD, off = wgid / NXCD; wgid = (xcd < r ? xcd * (q + 1) : r * (q + 1) + (xcd - r) * q) + off; }
        const int nig = WGM * nN, gid = wgid / nig, fm = gid * WGM, gsz = (nM - fm) < WGM ? (nM - fm) : WGM;
        u.pm = fm + ((wgid % nig) % gsz); u.pn = (wgid % nig) / gsz; return true;
    }
    __device__ __forceinline__ void a_ready(const Unit&) const {}
    __device__ __forceinline__ void done(const Unit&) const {}
};
typedef unsigned u32x4 __attribute__((ext_vector_type(4)));
__device__ __forceinline__ unsigned cvt_pk_bf16(float lo, float hi) { unsigned r; asm volatile("v_cvt_pk_bf16_f32 %0, %1, %2" : "=v"(r) : "v"(lo), "v"(hi)); return r; }
__device__ __forceinline__ unsigned short cvt_bf16(float v) { return (unsigned short)(cvt_pk_bf16(v, 0.f) & 0xffffu); }
__device__ __forceinline__ u32x4 pack8(const f32x4 a, const f32x4 b) { u32x4 w; w.x = cvt_pk_bf16(a[0], a[1]); w.y = cvt_pk_bf16(a[2], a[3]); w.z = cvt_pk_bf16(b[0], b[1]); w.w = cvt_pk_bf16(b[2], b[3]); return w; }
__device__ __forceinline__ float row_rs(const float* ss, int row) {
    const f32x4* p = (const f32x4*)(ss + (size_t)row * 16);
    const f32x4 a = p[0], b = p[1], c = p[2], d = p[3];
    const float s = (((a[0] + a[1]) + (a[2] + a[3])) + ((b[0] + b[1]) + (b[2] + b[3]))) + (((c[0] + c[1]) + (c[2] + c[3])) + ((d[0] + d[1]) + (d[2] + d[3])));
    return __builtin_amdgcn_rsqf(s * (1.0f / 1024.0f) + 1e-6f);
}
__device__ __forceinline__ float silu_f(float g) { return g * __builtin_amdgcn_rcpf(1.0f + __builtin_amdgcn_exp2f(-1.4426950408889634f * g)); }
__device__ __forceinline__ float gelu_tanh_f(float v) { const float t = 0.7978845608028654f * (v + 0.044715f * v * v * v); return v * __builtin_amdgcn_rcpf(1.0f + __builtin_amdgcn_exp2f(-2.0f * 1.4426950408889634f * t)); }

struct RsCache { const PG8_LAS float* tab; int pm0; const float* ss;
    __device__ __forceinline__ float get(int pm, int lrow) const { return (pm == pm0) ? tab[lrow] : row_rs(ss, pm * BM + lrow); } };
struct EpiSwiglu {
    static constexpr bool PERM = true, AFTER_DRAIN = false;
    bf16_t* H; RsCache rc;
    typedef float f32x2 __attribute__((ext_vector_type(2)));
    static __device__ __forceinline__ f32x2 sw2(f32x2 g, f32x2 u, float c1, float rs2) {
        const f32x2 t = g * c1; f32x2 e; e.x = __builtin_amdgcn_exp2f(t.x); e.y = __builtin_amdgcn_exp2f(t.y);
        const f32x2 d = e + 1.0f; f32x2 r; r.x = __builtin_amdgcn_rcpf(d.x); r.y = __builtin_amdgcn_rcpf(d.y);
        return (g * u) * (r * rs2);
    }
    __device__ __forceinline__ void operator()(const f32x4 (&acc)[2][2][4][2], const Unit& u, int wr, int wc, int fr, int fq) const {
        const int col0 = u.pn * 128 + wc * 32 + 8 * fq;
        float rsv[2][4];
#pragma unroll
        for (int ai = 0; ai < 2; ++ai)
#pragma unroll
            for (int m = 0; m < 4; ++m) rsv[ai][m] = rc.get(u.pm, ai * HALF + wr * 64 + m * 16 + fr);
#pragma unroll
        for (int ai = 0; ai < 2; ++ai)
#pragma unroll
            for (int m = 0; m < 4; ++m) {
                const int row = u.pm * BM + ai * HALF + wr * 64 + m * 16 + fr; const float rs = rsv[ai][m], c1 = -1.4426950408889634f * rs, rs2 = rs * rs;
                const f32x4 g0 = acc[ai][0][m][0], g1 = acc[ai][0][m][1], u0 = acc[ai][1][m][0], u1 = acc[ai][1][m][1];
                const f32x2 a = sw2((f32x2){g0[0], g0[1]}, (f32x2){u0[0], u0[1]}, c1, rs2), b = sw2((f32x2){g0[2], g0[3]}, (f32x2){u0[2], u0[3]}, c1, rs2);
                const f32x2 c = sw2((f32x2){g1[0], g1[1]}, (f32x2){u1[0], u1[1]}, c1, rs2), d = sw2((f32x2){g1[2], g1[3]}, (f32x2){u1[2], u1[3]}, c1, rs2);
                u32x4 w; w.x = cvt_pk_bf16(a.x, a.y); w.y = cvt_pk_bf16(b.x, b.y); w.z = cvt_pk_bf16(c.x, c.y); w.w = cvt_pk_bf16(d.x, d.y);
                *(u32x4*)(H + (size_t)row * 2816 + col0) = w;
            }
    }
};
struct EpiResid {
    static constexpr bool PERM = true, AFTER_DRAIN = false;
    typedef unsigned u32x2 __attribute__((ext_vector_type(2)));
    float* OUT; bf16_t* XB; unsigned char* XL; float* ss; float alpha;
    __device__ __forceinline__ void operator()(const f32x4 (&acc)[2][2][4][2], const Unit& u, int wr, int wc, int fr, int fq) const {
        const int col0 = u.pn * BM + wc * 32 + 8 * fq;
        const size_t off0 = (size_t)(u.pm * BM + wr * 64 + fr) * 1024 + col0;
#pragma unroll
        for (int ai = 0; ai < 2; ++ai) {
            u32x4 hin[4][2]; unsigned lin[4][2];
#pragma unroll
            for (int m = 0; m < 4; ++m)
#pragma unroll
                for (int bj = 0; bj < 2; ++bj) { const size_t o = off0 + (size_t)(ai * HALF + m * 16) * 1024 + bj * HALF; hin[m][bj] = *(const u32x4*)(XB + o); lin[m][bj] = *(const unsigned*)(XL + (o >> 1)); }
            __builtin_amdgcn_sched_barrier(0);
#pragma unroll
            for (int m = 0; m < 4; ++m) {
                const int row = u.pm * BM + ai * HALF + wr * 64 + m * 16 + fr; float sq = 0.f;
#pragma unroll
                for (int bj = 0; bj < 2; ++bj) {
                    const size_t o = off0 + (size_t)(ai * HALF + m * 16) * 1024 + bj * HALF;
                    const u32x4 h = hin[m][bj]; const unsigned l = lin[m][bj];
                    float xv[8];
#pragma unroll
                    for (int k = 0; k < 8; ++k) { const unsigned wd = h[k >> 1]; const unsigned hb = (k & 1) ? (wd & 0xffff0000u) : (wd << 16); const float hif = __uint_as_float(hb);
                        const unsigned by = (l >> (4 * k)) & 0xfu;
                        xv[k] = hif + lo4_dec(by, hb) + acc[ai][bj][m][k >> 2][k & 3] * alpha; }
                    const f32x4 x0 = (f32x4){xv[0], xv[1], xv[2], xv[3]}, x1 = (f32x4){xv[4], xv[5], xv[6], xv[7]};
                    if (OUT) { *(f32x4*)(OUT + o) = x0; *(f32x4*)(OUT + o + 4) = x1; }
                    else {
#pragma unroll
                        for (int k = 0; k < 8; ++k) sq += xv[k] * xv[k];
                        const u32x4 hn = pack8(x0, x1);
                        unsigned ln = 0u;
#pragma unroll
                        for (int k = 0; k < 8; ++k) { const unsigned wd = hn[k >> 1]; const unsigned hb = (k & 1) ? (wd & 0xffff0000u) : (wd << 16);
                            ln |= lo4_enc(xv[k], __uint_as_float(hb), hb) << (4 * k); }
                        *(u32x4*)(XB + o) = hn; *(unsigned*)(XL + (o >> 1)) = ln;
                    }
                }
                if (!OUT) { { const int ln_ = fr + 16 * fq; sq += shx(sq, 16, ln_); sq += shx(sq, 32, ln_); }
                    if (fq == 0) ss[(size_t)row * 16 + u.pn * 4 + wc] = sq; }
            }
        }
    }
};
struct EpiRecIn {
    static constexpr bool PERM = true, AFTER_DRAIN = false;
    bf16_t* GG; bf16_t* REC; RsCache rc;
    __device__ __forceinline__ void operator()(const f32x4 (&acc)[2][2][4][2], const Unit& u, int wr, int wc, int fr, int fq) const {
        const bool isgate = u.pn < 4; bf16_t* dst = isgate ? GG : REC; const int col0 = (u.pn & 3) * BM + wc * 32 + 8 * fq;
#pragma unroll
        for (int ai = 0; ai < 2; ++ai)
#pragma unroll
            for (int m = 0; m < 4; ++m) {
                const int row = u.pm * BM + ai * HALF + wr * 64 + m * 16 + fr; const float rs = rc.get(u.pm, ai * HALF + wr * 64 + m * 16 + fr);
#pragma unroll
                for (int bj = 0; bj < 2; ++bj) {
                    f32x4 v0 = acc[ai][bj][m][0] * rs, v1 = acc[ai][bj][m][1] * rs;
                    if (isgate) {
#pragma unroll
                        for (int j = 0; j < 4; ++j) { v0[j] = gelu_tanh_f(v0[j]); v1[j] = gelu_tanh_f(v1[j]); }
                    }
                    *(u32x4*)(dst + (size_t)row * 1024 + col0 + bj * HALF) = pack8(v0, v1);
                }
            }
    }
};
struct EpiQK {
    static constexpr bool PERM = true, AFTER_DRAIN = false;
    bf16_t* QK; bf16_t* VT; RsCache rc; const float* gain; const float* cosT; const float* sinT; float oscale;
    __device__ __forceinline__ void operator()(const f32x4 (&acc)[2][2][4][2], const Unit& u, int wr, int wc, int fr, int fq) const {
        if (u.pn < 4) {
            const int hh = u.pn * 4 + wc;
            f32x4 glo[2], ghi[2];
#pragma unroll
            for (int n = 0; n < 2; ++n) { glo[n] = *(const f32x4*)(gain + 8 * fq + 4 * n); ghi[n] = *(const f32x4*)(gain + 32 + 8 * fq + 4 * n); }
#pragma unroll
            for (int ai = 0; ai < 2; ++ai)
#pragma unroll
                for (int m = 0; m < 4; ++m) {
                    const int row = u.pm * BM + ai * HALF + wr * 64 + m * 16 + fr; const float rs = rc.get(u.pm, ai * HALF + wr * 64 + m * 16 + fr); const int pos = row & 4095;
                    f32x4 v[2][2]; float sq = 0.f;
#pragma unroll
                    for (int bj = 0; bj < 2; ++bj)
#pragma unroll
                        for (int n = 0; n < 2; ++n) { v[bj][n] = acc[ai][bj][m][n] * rs; const f32x4 t = v[bj][n]; sq += (t[0] * t[0] + t[1] * t[1]) + (t[2] * t[2] + t[3] * t[3]); }
                    { const int ln_ = fr + 16 * fq; sq += shx(sq, 16, ln_); sq += shx(sq, 32, ln_); }
                    const float rinv = __builtin_amdgcn_rsqf(sq * (1.0f / 64.0f) + 1e-6f);
                    f32x4 olo[2], ohi[2];
#pragma unroll
                    for (int n = 0; n < 2; ++n) {
                        const f32x4 c = *(const f32x4*)(cosT + (size_t)pos * 32 + 8 * fq + 4 * n), s = *(const f32x4*)(sinT + (size_t)pos * 32 + 8 * fq + 4 * n);
                        const f32x4 ylo = v[0][n] * rinv * glo[n], yhi = v[1][n] * rinv * ghi[n];
                        olo[n] = (ylo * c - yhi * s) * oscale; ohi[n] = (yhi * c + ylo * s) * oscale;
                    }
                    bf16_t* dp = QK + (size_t)row * 1024 + hh * 64 + 8 * fq;
                    *(u32x4*)dp = pack8(olo[0], olo[1]); *(u32x4*)(dp + 32) = pack8(ohi[0], ohi[1]);
                }
        } else {
#pragma unroll
            for (int ai = 0; ai < 2; ++ai)
#pragma unroll
                for (int m = 0; m < 4; ++m) {
                    const int row = u.pm * BM + ai * HALF + wr * 64 + m * 16 + fr; const float rs = rc.get(u.pm, ai * HALF + wr * 64 + m * 16 + fr); const int b = row >> 12, s = row & 4095;
#pragma unroll
                    for (int bj = 0; bj < 2; ++bj)
#pragma unroll
                        for (int n = 0; n < 2; ++n)
#pragma unroll
                            for (int j = 0; j < 4; ++j) {
                                const int col = (u.pn - 4) * BM + bj * HALF + wc * 32 + 8 * fq + 4 * n + j;
                                VT[((size_t)(b * 1024 + col)) * 4096 + s] = cvt_bf16(acc[ai][bj][m][n][j] * rs);
                            }
                }
        }
    }
};

template <class Epi, class Sched, bool ALIGN_EPI = false, bool SP2 = false>
__device__ __forceinline__ void gemm_phase(PG8_LAS unsigned char* lds, const Gemm g, const Sched& S, const Epi& E, const int tid) {
    const int wid = __builtin_amdgcn_readfirstlane(tid >> 6), lane = tid & 63, wr = wid >> 2, wc = wid & 3, fr = lane & 15, fq = lane >> 4;
    const int K = g.K, nt = K / BK;
    unsigned voffA[2], voffB[2];
#pragma unroll
    for (int i = 0; i < 2; ++i) { int R, C; stage_rc(tid * 16 + i * 8192, R, C); const int Rb = Epi::PERM ? ((R & ~31) + perm32(R & 31)) : R;
        voffA[i] = (unsigned)(R * K + C) * 2u; voffB[i] = (unsigned)(Rb * K + C) * 2u; }
    const size_t kstep = (size_t)(BK * 2);
    const size_t hstep = (size_t)HALF * K * 2;
    const size_t tstep = 2 * hstep;
    const unsigned ldsw = (unsigned)wid * 1024u;
    const int aoff = lds_byte(wr * 64 + fr, fq * 8), boff = lds_byte(wc * 32 + fr, fq * 8);
#define PG8_SA(b, h) (((b) * 2 + (h)) * HTB)
#define PG8_SB(b, h) ((4 + (b) * 2 + (h)) * HTB)
#define PG8_STAGE(bufoff, gbase, voff) do { _Pragma("unroll") for (int _i = 0; _i < 2; ++_i) \
        __builtin_amdgcn_global_load_lds((const unsigned*)((const char*)(gbase) + (voff)[_i]), (PG8_LAS unsigned*)(lds + (bufoff) + ldsw + _i * 8192), 16, 0, 0); } while (0)
#define PG8_LDA(dst, b, h) do { _Pragma("unroll") for (int m = 0; m < 4; ++m) _Pragma("unroll") for (int k = 0; k < 2; ++k) dst[m][k] = *(const PG8_LAS bf16x8*)(lds + PG8_SA(b, h) + aoff + m * 2048 + k * 1024); } while (0)
#define PG8_LDB(dst, b, h) do { _Pragma("unroll") for (int n = 0; n < 2; ++n) _Pragma("unroll") for (int k = 0; k < 2; ++k) dst[n][k] = *(const PG8_LAS bf16x8*)(lds + PG8_SB(b, h) + boff + n * 2048 + k * 1024); } while (0)
#define PG8_MMA(ai, bj, At, Bt) do { __builtin_amdgcn_s_setprio(1); _Pragma("unroll") for (int m = 0; m < 4; ++m) _Pragma("unroll") for (int n = 0; n < 2; ++n) _Pragma("unroll") for (int k = 0; k < 2; ++k) \
        acc[ai][bj][m][n] = __builtin_amdgcn_mfma_f32_16x16x32_bf16(Bt[n][k], At[m][k], acc[ai][bj][m][n], 0, 0, 0); __builtin_amdgcn_s_setprio(0); } while (0)
#define PG8_WAIT_V(n) asm volatile("s_waitcnt vmcnt(" #n ")" ::: "memory")
#define PG8_WAIT_L(n) asm volatile("s_waitcnt lgkmcnt(" #n ")" ::: "memory")
#define PG8_BAR __builtin_amdgcn_s_barrier()
#define PG8_SCHED __builtin_amdgcn_sched_barrier(0)
    Unit cur, nxt; int ui = 0;
    if (!S.next(0, cur)) return;
    f32x4 acc[2][2][4][2];
#pragma unroll
    for (int a = 0; a < 2; ++a)
#pragma unroll
        for (int b = 0; b < 2; ++b)
#pragma unroll
            for (int m = 0; m < 4; ++m)
#pragma unroll
                for (int n = 0; n < 2; ++n) acc[a][b][m][n] = (f32x4){0.f, 0.f, 0.f, 0.f};
    bf16x8 At[4][2], B0[2][2], B1[2][2];
    const char* cA = (const char*)g.A + (size_t)cur.pm * tstep; const char* cB = (const char*)g.Bt + (size_t)cur.pn * tstep;
    S.a_ready(cur);
    if constexpr (SP2) {
        PG8_STAGE(PG8_SB(0, 0), cB, voffB); PG8_STAGE(PG8_SB(0, 1), cB + hstep, voffB); PG8_STAGE(PG8_SA(0, 0), cA, voffA); PG8_STAGE(PG8_SA(0, 1), cA + hstep, voffA);
        if (wr == 1) PG8_BAR;
        PG8_WAIT_V(2); PG8_BAR;
        PG8_STAGE(PG8_SB(1, 0), cB + kstep, voffB); PG8_STAGE(PG8_SA(1, 0), cA + kstep, voffA); PG8_STAGE(PG8_SB(1, 1), cB + hstep + kstep, voffB);
        PG8_WAIT_V(6); PG8_BAR;
    } else {
        PG8_STAGE(PG8_SB(0, 0), cB, voffB); PG8_STAGE(PG8_SA(0, 0), cA, voffA); PG8_STAGE(PG8_SB(0, 1), cB + hstep, voffB); PG8_STAGE(PG8_SA(0, 1), cA + hstep, voffA);
        if (wr == 1) PG8_BAR;
        PG8_WAIT_V(4); PG8_BAR;
        PG8_STAGE(PG8_SB(1, 0), cB + kstep, voffB); PG8_STAGE(PG8_SA(1, 0), cA + kstep, voffA); PG8_STAGE(PG8_SB(1, 1), cB + hstep + kstep, voffB);
        PG8_WAIT_V(6); PG8_BAR;
    }
    for (;;) {
        const bool has_next = S.next(ui + 1, nxt);
        const char* nA = has_next ? (const char*)g.A + (size_t)nxt.pm * tstep : cA; const char* nB = has_next ? (const char*)g.Bt + (size_t)nxt.pn * tstep : cB;
        for (int t = 0; t < nt; t += 2) {
            const bool last = (t == nt - 2);
            const char* a1 = cA + (size_t)(t + 1) * kstep;
            const char* a2 = last ? nA : cA + (size_t)(t + 2) * kstep; const char* b2 = last ? nB : cB + (size_t)(t + 2) * kstep;
            const char* a3 = a2 + kstep; const char* b3 = b2 + kstep;
            if (last && has_next) S.a_ready(nxt);
            if constexpr (SP2) {
            PG8_LDB(B0, 0, 0); PG8_LDB(B1, 0, 1); PG8_SCHED; PG8_LDA(At, 0, 0); PG8_STAGE(PG8_SA(1, 1), a1 + hstep, voffA);
            PG8_WAIT_V(8); PG8_WAIT_L(0); PG8_BAR; PG8_MMA(0, 0, At, B0); PG8_MMA(0, 1, At, B1); PG8_BAR; PG8_SCHED;
            PG8_LDA(At, 0, 1); PG8_STAGE(PG8_SB(0, 0), b2, voffB); PG8_STAGE(PG8_SB(0, 1), b2 + hstep, voffB); PG8_STAGE(PG8_SA(0, 0), a2, voffA);
            PG8_WAIT_V(8); PG8_WAIT_L(0); PG8_BAR; PG8_MMA(1, 0, At, B0); PG8_MMA(1, 1, At, B1); PG8_BAR; PG8_SCHED;
            PG8_LDB(B0, 1, 0); PG8_LDB(B1, 1, 1); PG8_SCHED; PG8_LDA(At, 1, 0); PG8_STAGE(PG8_SA(0, 1), a2 + hstep, voffA);
            PG8_WAIT_V(8); PG8_WAIT_L(0); PG8_BAR; PG8_MMA(0, 0, At, B0); PG8_MMA(0, 1, At, B1); PG8_BAR; PG8_SCHED;
            PG8_LDA(At, 1, 1); PG8_STAGE(PG8_SB(1, 0), b3, voffB); PG8_STAGE(PG8_SB(1, 1), b3 + hstep, voffB); PG8_STAGE(PG8_SA(1, 0), a3, voffA);
            PG8_WAIT_V(8); PG8_WAIT_L(0); PG8_BAR; PG8_MMA(1, 0, At, B0); PG8_MMA(1, 1, At, B1); PG8_BAR; PG8_SCHED;
            } else {
            PG8_LDB(B0, 0, 0); PG8_SCHED; PG8_LDA(At, 0, 0); PG8_STAGE(PG8_SA(1, 1), a1 + hstep, voffA);
            PG8_WAIT_L(8); PG8_BAR; PG8_WAIT_L(0); PG8_MMA(0, 0, At, B0); PG8_BAR; PG8_SCHED;
            PG8_LDB(B1, 0, 1); PG8_STAGE(PG8_SB(0, 0), b2, voffB);
            PG8_BAR; PG8_WAIT_L(0); PG8_MMA(0, 1, At, B1); PG8_BAR;
            PG8_LDA(At, 0, 1); PG8_STAGE(PG8_SA(0, 0), a2, voffA);
            PG8_BAR; PG8_WAIT_L(0); PG8_MMA(1, 0, At, B0); PG8_BAR; PG8_SCHED;
            PG8_STAGE(PG8_SB(0, 1), b2 + hstep, voffB);
            PG8_WAIT_V(6); PG8_BAR; PG8_MMA(1, 1, At, B1); PG8_BAR;
            PG8_LDB(B0, 1, 0); PG8_SCHED; PG8_LDA(At, 1, 0); PG8_STAGE(PG8_SA(0, 1), a2 + hstep, voffA);
            PG8_WAIT_L(8); PG8_BAR; PG8_WAIT_L(0); PG8_MMA(0, 0, At, B0); PG8_BAR; PG8_SCHED;
            PG8_LDB(B1, 1, 1); PG8_STAGE(PG8_SB(1, 0), b3, voffB);
            PG8_BAR; PG8_WAIT_L(0); PG8_MMA(0, 1, At, B1); PG8_BAR;
            PG8_LDA(At, 1, 1); PG8_STAGE(PG8_SA(1, 0), a3, voffA);
            PG8_BAR; PG8_WAIT_L(0); PG8_MMA(1, 0, At, B0); PG8_BAR; PG8_SCHED;
            PG8_STAGE(PG8_SB(1, 1), b3 + hstep, voffB);
            PG8_WAIT_V(6); PG8_BAR; PG8_MMA(1, 1, At, B1); PG8_BAR;
            }
        }
        if constexpr (ALIGN_EPI) { if (wr == 0) PG8_BAR; }
        if constexpr (!Epi::AFTER_DRAIN) { E(acc, cur, wr, wc, fr, fq); S.done(cur); }
        if (!has_next) break;
#pragma unroll
        for (int a = 0; a < 2; ++a)
#pragma unroll
            for (int b = 0; b < 2; ++b)
#pragma unroll
                for (int m = 0; m < 4; ++m)
#pragma unroll
                    for (int n = 0; n < 2; ++n) acc[a][b][m][n] = (f32x4){0.f, 0.f, 0.f, 0.f};
        cur = nxt; cA = nA; cB = nB; ++ui;
        if constexpr (ALIGN_EPI) { if (wr == 1) PG8_BAR; }
    }
    PG8_WAIT_V(0);
    if constexpr (!ALIGN_EPI) { if (wr == 0) PG8_BAR; }
    PG8_BAR;
    if constexpr (Epi::AFTER_DRAIN) { E.fused(acc, cur, wr, wc, fr, fq, lds, wid, lane); S.done(cur); }
#undef PG8_SA
#undef PG8_SB
#undef PG8_STAGE
#undef PG8_LDA
#undef PG8_LDB
#undef PG8_MMA
#undef PG8_WAIT_V
#undef PG8_WAIT_L
#undef PG8_BAR
#undef PG8_SCHED
}
}
#define LAS __attribute__((address_space(3)))
typedef unsigned short bf16_t;
typedef short bf16x8 __attribute__((ext_vector_type(8)));
typedef short s16x4 __attribute__((ext_vector_type(4)));
typedef float f32x4 __attribute__((ext_vector_type(4)));
typedef float f32x16 __attribute__((ext_vector_type(16)));
typedef unsigned u32x4 __attribute__((ext_vector_type(4)));
typedef unsigned u32x2 __attribute__((ext_vector_type(2)));
using pg8::cvt_pk_bf16; using pg8::cvt_bf16; using pg8::pack8;

constexpr int BATCH = 4, SEQ = 4096, DM = 1024, MROWS = BATCH * SEQ, FF = 2816;
constexpr int NTHREADS = 512, NWAVES = 8;
constexpr int LDS_BYTES = 147456;
constexpr size_t MiB = 1u << 20;
constexpr size_t WS_SS = 0;
constexpr size_t WS_COS = 1 * MiB, WS_SIN = 1 * MiB + 512 * 1024;
constexpr size_t WS_SPAN = 2 * MiB;
constexpr size_t WS_BAR = 3 * MiB;
constexpr size_t WS_W = 4 * MiB;
constexpr size_t W_FFN_STRIDE = 17301504, W_FFN_DN = 11534336;
constexpr size_t W_REC = WS_W + 132 * MiB, W_REC_STRIDE = 6 * MiB + 512 * 1024, W_REC_G = 4 * MiB, W_REC_OUT = 4 * MiB + 512 * 1024;
constexpr size_t W_KV = WS_W + 145 * MiB, W_Q = WS_W + 149 * MiB, W_O = WS_W + 153 * MiB;
constexpr size_t WS_XB = 162 * MiB, WS_K = 194 * MiB, WS_VT = 226 * MiB, WS_H = 258 * MiB;
constexpr size_t WS_GG = WS_H, WS_REC = WS_H + 32 * MiB, WS_Y = WS_K;
constexpr size_t WS_QO = WS_H, WS_ASCR = WS_H + 32 * MiB;
constexpr size_t WS_O = WS_W;
constexpr size_t WS_XL = 346 * MiB;
constexpr size_t WS_END = 378 * MiB;

struct Params { const float* in[31]; float* out; unsigned char* ws; double invfreq[32]; float linit[2]; int ph_lo, ph_hi, rep_mask, pad; };
typedef const __attribute__((address_space(4))) Params CParams;

__device__ __forceinline__ float wave_sum(float v, int lane) {
#pragma unroll
    for (int o = 1; o < 64; o <<= 1) v += shx(v, o, lane);
    return v;
}
#define LDS_WAIT() asm volatile("s_waitcnt lgkmcnt(0)" ::: "memory")
#define LDS_BARRIER() asm volatile("s_waitcnt lgkmcnt(0)\n\ts_barrier" ::: "memory")

__device__ __forceinline__ void tr_item(const float* W, int ldw, const float* gain, bf16_t* WT, int K, int drow0, int k0, int n0, LAS float* scr, int lane) {
    f32x4 tv[8];
    const float* wp = W + (size_t)(k0 + (lane >> 3)) * ldw + n0 + (lane & 7) * 4;
#pragma unroll
    for (int i = 0; i < 8; ++i) tv[i] = __builtin_nontemporal_load((const f32x4*)(wp + (size_t)(8 * i) * ldw));
    if (gain) {
#pragma unroll
        for (int i = 0; i < 8; ++i) tv[i] = tv[i] * gain[k0 + 8 * i + (lane >> 3)];
    }
#pragma unroll
    for (int i = 0; i < 8; ++i) { LAS float* sp_ = scr + (8 * i + (lane >> 3)) * 33 + (lane & 7) * 4; sp_[0] = tv[i][0]; sp_[1] = tv[i][1]; sp_[2] = tv[i][2]; sp_[3] = tv[i][3]; }
    LDS_WAIT(); asm volatile("" ::: "memory");
    const int c = lane & 7;
#pragma unroll
    for (int j = 0; j < 4; ++j) { const int n = (lane >> 3) + 8 * j; const LAS float* s = scr + (8 * c) * 33 + n;
        u32x4 o; o.x = cvt_pk_bf16(s[0 * 33], s[1 * 33]); o.y = cvt_pk_bf16(s[2 * 33], s[3 * 33]); o.z = cvt_pk_bf16(s[4 * 33], s[5 * 33]); o.w = cvt_pk_bf16(s[6 * 33], s[7 * 33]);
        *(u32x4*)(WT + (size_t)(drow0 + n) * K + k0 + 8 * c) = o; }
    LDS_WAIT(); asm volatile("" ::: "memory");
}
__device__ __forceinline__ int headperm_row0(int n0) { const int sb = n0 >> 5, pn = sb >> 3, rem = sb & 7, wc = rem >> 1, bj = rem & 1; return pn * 256 + bj * 128 + wc * 32; }

__device__ __forceinline__ void prologue_item(CParams& P, int it, LAS float* scr, int lane) {
    unsigned char* ws = P.ws;
    if (it < 16 * 1408) {
        const int mi = it / 1408, r = it % 1408, f = mi >> 1, gu = mi & 1, layer = f >> 1, which = f & 1;
        const float* W = (which ? (gu ? P.in[7] : P.in[6]) : (gu ? P.in[3] : P.in[2])) + (size_t)layer * 1024 * 2816;
        const float* g = (which ? P.in[5] : P.in[1]) + layer * 1024;
        const int kb = r / 88, nb = r % 88, n0 = nb * 32;
        tr_item(W, 2816, g, (bf16_t*)(ws + WS_W + (size_t)f * W_FFN_STRIDE), 1024, (n0 >> 7) * 256 + (n0 & 127) + gu * 128, kb * 64, n0, scr, lane); return; }
    it -= 16 * 1408;
    if (it < 8 * 1408) {
        const int f = it / 1408, r = it % 1408, layer = f >> 1, which = f & 1;
        const float* W = (which ? P.in[8] : P.in[4]) + (size_t)layer * 2816 * 1024;
        const int kb = r / 32, nb = r % 32;
        tr_item(W, 1024, nullptr, (bf16_t*)(ws + WS_W + (size_t)f * W_FFN_STRIDE + W_FFN_DN), 2816, nb * 32, kb * 64, nb * 32, scr, lane); return; }
    it -= 8 * 1408;
    if (it < 2 * 1024) {
        const int a = it / 1024, r = it % 1024, kb = r / 64, nb = r % 64;
        tr_item(P.in[10] + (size_t)a * 1024 * 2048, 2048, P.in[9] + a * 1024, (bf16_t*)(ws + W_REC + (size_t)a * W_REC_STRIDE), 1024, nb * 32, kb * 64, nb * 32, scr, lane); return; }
    it -= 2 * 1024;
    if (it < 256) {
        const int mi = it / 8, r = it % 8, a = mi >> 4, g = (mi >> 3) & 1, blk = mi & 7, kb = r / 4, nb = r % 4;
        const float* W = (g ? P.in[15] : P.in[13]) + (size_t)(a * 8 + blk) * 128 * 128;
        tr_item(W, 128, nullptr, (bf16_t*)(ws + W_REC + (size_t)a * W_REC_STRIDE + W_REC_G) + (size_t)(blk * 2 + g) * 128 * 128, 128, nb * 32, kb * 64, nb * 32, scr, lane); return; }
    it -= 256;
    if (it < 2 * 512) {
        const int a = it / 512, r = it % 512, kb = r / 32, nb = r % 32;
        tr_item(P.in[18] + (size_t)a * 1024 * 1024, 1024, nullptr, (bf16_t*)(ws + W_REC + (size_t)a * W_REC_STRIDE + W_REC_OUT), 1024, nb * 32, kb * 64, nb * 32, scr, lane); return; }
    it -= 2 * 512;
    if (it < 2 * 512) {
        const int v = it / 512, r = it % 512, kb = r / 32, nb = r % 32, n0 = nb * 32;
        tr_item(v ? P.in[21] : P.in[20], 1024, P.in[19], (bf16_t*)(ws + W_KV), 1024, v ? 1024 + n0 : headperm_row0(n0), kb * 64, n0, scr, lane); return; }
    it -= 2 * 512;
    if (it < 2 * 512) {
        const int j = it / 512, r = it % 512, kb = r / 32, nb = r % 32, n0 = nb * 32;
        tr_item(P.in[25] + (size_t)j * 1024 * 1024, 1024, P.in[9] + (2 + j) * 1024, (bf16_t*)(ws + W_Q + (size_t)j * 2 * MiB), 1024, headperm_row0(n0), kb * 64, n0, scr, lane); return; }
    it -= 2 * 512;
    {
        const int j = it / 512, r = it % 512, kb = r / 32, nb = r % 32;
        tr_item(P.in[30] + (size_t)j * 1024 * 1024, 1024, nullptr, (bf16_t*)(ws + W_O + (size_t)j * 2 * MiB), 1024, nb * 32, kb * 64, nb * 32, scr, lane); }
}
__device__ __forceinline__ void ffn_item(CParams& P, int f, int j, LAS float* scr, int lane) { prologue_item(P, (j < 2816) ? f * 2816 + j : 16 * 1408 + f * 1408 + (j - 2816), scr, lane); }
constexpr int N_PRO_ITEMS = 16 * 1408 + 8 * 1408 + 2 * 1024 + 256 + 2 * 512 + 2 * 512 + 2 * 512 + 2 * 512;

__device__ __forceinline__ void prologue(CParams& P, LAS unsigned char* lds, int vcu, int G, const int tid) {
    const int lane = tid & 63, wave = __builtin_amdgcn_readfirstlane(tid >> 6);
    LAS float* scr = (LAS float*)(lds + wave * 16384);
    const int gw = vcu * NWAVES + wave, NGW = G * NWAVES;
    for (int it = gw; it < 4224 + (N_PRO_ITEMS - 24 * 1408); it += NGW) { if (it < 4224) ffn_item(P, 0, it, scr, lane); else prologue_item(P, 24 * 1408 + (it - 4224), scr, lane); }
    const float* x = P.in[0]; bf16_t* XB = (bf16_t*)(P.ws + WS_XB); unsigned char* XL = (unsigned char*)(P.ws + WS_XL); float* ss = (float*)(P.ws + WS_SS);
    for (int m = gw; m < MROWS; m += NGW) {
        const f32x4* xr = (const f32x4*)(x + (size_t)m * DM) + lane; u32x2* bo = (u32x2*)(XB + (size_t)m * DM) + lane; unsigned short* lo = (unsigned short*)(XL + (size_t)m * (DM / 2)) + lane;
        float s = 0.f;
#pragma unroll
        for (int j = 0; j < 4; ++j) { const f32x4 v = xr[64 * j]; s += (v[0] * v[0] + v[1] * v[1]) + (v[2] * v[2] + v[3] * v[3]);
            u32x2 w; w.x = cvt_pk_bf16(v[0], v[1]); w.y = cvt_pk_bf16(v[2], v[3]); bo[64 * j] = w;
            const unsigned q0 = lo4_enc(v[0], __uint_as_float(w.x << 16), w.x << 16), q1 = lo4_enc(v[1], __uint_as_float(w.x & 0xffff0000u), w.x & 0xffff0000u);
            const unsigned q2 = lo4_enc(v[2], __uint_as_float(w.y << 16), w.y << 16), q3 = lo4_enc(v[3], __uint_as_float(w.y & 0xffff0000u), w.y & 0xffff0000u);
            lo[64 * j] = (unsigned short)(q0 | (q1 << 4) | (q2 << 8) | (q3 << 12)); }
        s = wave_sum(s, lane);
        if (lane < 16) ss[(size_t)m * 16 + lane] = (lane == 0) ? s : 0.f;
    }
    float* cosT = (float*)(P.ws + WS_COS); float* sinT = (float*)(P.ws + WS_SIN);
    for (int idx = vcu * NTHREADS + tid; idx < SEQ * 32; idx += G * NTHREADS) {
        const int pos = idx >> 5, i = idx & 31; double f = 0.0;
#pragma unroll
        for (int k = 0; k < 32; ++k) f = (i == k) ? P.invfreq[k] : f;
        const double ang = (double)pos * f; const double kq = __builtin_rint(ang * 0.63661977236758134308); const double r = ang - kq * 1.57079632679489661923;
        const float rf = (float)r, rr = rf * rf;
        const float sr = rf * (1.0f + rr * (-1.6666667e-1f + rr * (8.3333333e-3f + rr * (-1.9841270e-4f + rr * 2.7557319e-6f))));
        const float cr = 1.0f + rr * (-0.5f + rr * (4.1666667e-2f + rr * (-1.3888889e-3f + rr * (2.4801587e-5f + rr * -2.7557319e-7f))));
        const int q = ((int)kq) & 3; const float sv = (q == 0) ? sr : (q == 1) ? cr : (q == 2) ? -sr : -cr; const float cv = (q == 0) ? cr : (q == 1) ? -sr : (q == 2) ? -cr : sr;
        cosT[idx] = cv; sinT[idx] = sv;
    }
}

constexpr int SC_XA = 0, SC_X32 = 17408, SC_BUF = 51200;
__device__ __forceinline__ int sc_rho(int t) { return 16 * ((t >> 2) & 3) + 4 * (t >> 4) + (t & 3); }
__device__ __forceinline__ float bf_lo(unsigned u) { return __uint_as_float(u << 16); }
__device__ __forceinline__ float bf_hi(unsigned u) { return __uint_as_float(u & 0xffff0000u); }
template <int PASS> __device__ __forceinline__ void scan_unit(CParams& P, LAS unsigned char* lds, int a, int b, int n, int sp, const int tid) {
    const int lane = tid & 63, w = __builtin_amdgcn_readfirstlane(tid >> 6), chl = lane & 15, fq = lane >> 4;
    const int ch = 128 * n + 16 * w + chl;
    const bf16_t* REC = (const bf16_t*)(P.ws + WS_REC); const bf16_t* GG = (const bf16_t*)(P.ws + WS_GG); bf16_t* Y = (bf16_t*)(P.ws + WS_Y);
    const bf16_t* GW = (const bf16_t*)(P.ws + W_REC + (size_t)a * W_REC_STRIDE + W_REC_G);
    float* spanA = (float*)(P.ws + WS_SPAN); float* spanH = spanA + BATCH * 8 * 1024;
    bf16x8 bfa[4], bfx[4];
#pragma unroll
    for (int ks = 0; ks < 4; ++ks) { bfa[ks] = *(const bf16x8*)(GW + ((size_t)(n * 2 + 0) * 128 + 16 * w + chl) * 128 + 32 * ks + 8 * fq); bfx[ks] = *(const bf16x8*)(GW + ((size_t)(n * 2 + 1) * 128 + 16 * w + chl) * 128 + 32 * ks + 8 * fq); }
    const float ba = P.in[14][a * 1024 + ch], bxb = P.in[16][a * 1024 + ch];
    const float lamv = P.in[17][a * 1024 + ch];
    const float c8 = -8.0f * log1pf(__expf(-lamv));
    float hc = 0.f, Asp = 1.f;
    if (PASS == 2) {
        float A2[7], H2[7];
#pragma unroll
        for (int s2 = 0; s2 < 7; ++s2) { A2[s2] = spanA[(size_t)(b * 8 + s2) * 1024 + ch]; H2[s2] = spanH[(size_t)(b * 8 + s2) * 1024 + ch]; }
#pragma unroll
        for (int s2 = 0; s2 < 7; ++s2) hc = (s2 < sp) ? (A2[s2] * hc + H2[s2]) : hc;
    }
    const int tp = tid >> 4, cg8 = tid & 15;
    const int rho0 = sc_rho(2 * tp), rho1 = sc_rho(2 * tp + 1);
    const float* cwp = P.in[11] + (size_t)a * 4 * 1024 + 128 * n + 8 * cg8; const float* cbp = P.in[12] + a * 1024 + 128 * n + 8 * cg8;
    const bf16_t* rbase = REC + ((size_t)(b * SEQ + sp * 512 + 2 * tp)) * 1024 + 128 * n + 8 * cg8;
    const bf16_t* gbase = GG + ((size_t)(b * SEQ + sp * 512 + 2 * tp)) * 1024 + 128 * n + 8 * cg8;
    bf16_t* ybase = Y + ((size_t)(b * SEQ + sp * 512 + 2 * tp)) * 1024 + 128 * n + 8 * cg8;
    f32x4 cwa[4], cwb[4];
#pragma unroll
    for (int k = 0; k < 4; ++k) { cwa[k] = *(const f32x4*)(cwp + k * 1024); cwb[k] = *(const f32x4*)(cwp + k * 1024 + 4); }
    const f32x4 cb0 = *(const f32x4*)cbp, cb1 = *(const f32x4*)(cbp + 4);
    u32x4 R[5], G0 = (u32x4){0u, 0u, 0u, 0u}, G1 = (u32x4){0u, 0u, 0u, 0u};
#define SC_LOAD(ci_) do { _Pragma("unroll") for (int k = 0; k < 5; ++k) { const int pos = sp * 512 + (ci_) * 64 + 2 * tp - 3 + k; R[k] = (u32x4){0u, 0u, 0u, 0u}; \
            if (pos >= 0) R[k] = *(const u32x4*)(rbase + ((ci_) * 64 - 3 + k) * 1024); } \
        if (PASS == 2) { G0 = *(const u32x4*)(gbase + (ci_) * 64 * 1024); G1 = *(const u32x4*)(gbase + ((ci_) * 64 + 1) * 1024); } } while (0)
    SC_LOAD(0);
    for (int ci = 0; ci < 8; ++ci) {
        LAS unsigned char* buf = lds + (ci & 1) * SC_BUF;
        LAS float* xf = (LAS float*)(buf + SC_X32);
        const u32x4 Gc0 = G0, Gc1 = G1;
        {
            float x0[8], x1[8];
#pragma unroll
            for (int e = 0; e < 4; ++e) { x0[e] = cb0[e]; x0[4 + e] = cb1[e]; x1[e] = cb0[e]; x1[4 + e] = cb1[e]; }
#pragma unroll
            for (int k = 0; k < 4; ++k) {
                const f32x4 wa = cwa[k], wb = cwb[k];
                const u32x4 ra = R[k], rb = R[k + 1];
                x0[0] += wa[0] * bf_lo(ra.x); x0[1] += wa[1] * bf_hi(ra.x); x0[2] += wa[2] * bf_lo(ra.y); x0[3] += wa[3] * bf_hi(ra.y);
                x0[4] += wb[0] * bf_lo(ra.z); x0[5] += wb[1] * bf_hi(ra.z); x0[6] += wb[2] * bf_lo(ra.w); x0[7] += wb[3] * bf_hi(ra.w);
                x1[0] += wa[0] * bf_lo(rb.x); x1[1] += wa[1] * bf_hi(rb.x); x1[2] += wa[2] * bf_lo(rb.y); x1[3] += wa[3] * bf_hi(rb.y);
                x1[4] += wb[0] * bf_lo(rb.z); x1[5] += wb[1] * bf_hi(rb.z); x1[6] += wb[2] * bf_lo(rb.w); x1[7] += wb[3] * bf_hi(rb.w);
            }
            u32x4 p0, p1; p0.x = cvt_pk_bf16(x0[0], x0[1]); p0.y = cvt_pk_bf16(x0[2], x0[3]); p0.z = cvt_pk_bf16(x0[4], x0[5]); p0.w = cvt_pk_bf16(x0[6], x0[7]);
            p1.x = cvt_pk_bf16(x1[0], x1[1]); p1.y = cvt_pk_bf16(x1[2], x1[3]); p1.z = cvt_pk_bf16(x1[4], x1[5]); p1.w = cvt_pk_bf16(x1[6], x1[7]);
            *(LAS u32x4*)(buf + SC_XA + rho0 * 272 + cg8 * 16) = p0; *(LAS u32x4*)(buf + SC_XA + rho1 * 272 + cg8 * 16) = p1;
            *(LAS f32x4*)(xf + rho0 * 132 + cg8 * 8) = (f32x4){x0[0], x0[1], x0[2], x0[3]}; *(LAS f32x4*)(xf + rho0 * 132 + cg8 * 8 + 4) = (f32x4){x0[4], x0[5], x0[6], x0[7]};
            *(LAS f32x4*)(xf + rho1 * 132 + cg8 * 8) = (f32x4){x1[0], x1[1], x1[2], x1[3]}; *(LAS f32x4*)(xf + rho1 * 132 + cg8 * 8 + 4) = (f32x4){x1[4], x1[5], x1[6], x1[7]};
        }
        if (ci + 1 < 8) SC_LOAD(ci + 1);
        LDS_BARRIER();
        f32x4 ga[4], gx[4];
#pragma unroll
        for (int mt = 0; mt < 4; ++mt) { ga[mt] = (f32x4){0.f, 0.f, 0.f, 0.f}; gx[mt] = (f32x4){0.f, 0.f, 0.f, 0.f};
#pragma unroll
            for (int ks = 0; ks < 4; ++ks) { const bf16x8 af = *(const LAS bf16x8*)(buf + SC_XA + (16 * mt + chl) * 272 + (32 * ks + 8 * fq) * 2);
                ga[mt] = __builtin_amdgcn_mfma_f32_16x16x32_bf16(af, bfa[ks], ga[mt], 0, 0, 0); gx[mt] = __builtin_amdgcn_mfma_f32_16x16x32_bf16(af, bfx[ks], gx[mt], 0, 0, 0); } }
        LAS float* xl = xf + (4 * fq) * 132 + 16 * w + chl;
        float Pm[16], hl[16]; float p = 1.f, hh = 0.f;
#pragma unroll
        for (int mt = 0; mt < 4; ++mt)
#pragma unroll
            for (int r = 0; r < 4; ++r) {
                const float xv = xl[(16 * mt + r) * 132];
                const float rg = __builtin_amdgcn_rcpf(1.0f + __expf(-(ga[mt][r] + ba))), ig = __builtin_amdgcn_rcpf(1.0f + __expf(-(gx[mt][r] + bxb)));
                const float la = c8 * rg, t2 = 2.0f * la, av = __expf(la);
                const float poly = -t2 * (1.0f + t2 * (0.5f + t2 * (1.6666667e-1f + t2 * (4.1666667e-2f + t2 * (8.3333333e-3f + t2 * 1.3888889e-3f)))));
                const float om = (t2 > -0.25f) ? poly : (1.0f - av * av);
                const float bxv = __builtin_amdgcn_sqrtf(om) * ig * xv;
                p *= av; hh = av * hh + bxv; Pm[4 * mt + r] = p; hl[4 * mt + r] = hh;
            }
        float IA = p, IH = hh;
        float pA = shl_from(IA, (lane - 16) & 63), pH = shl_from(IH, (lane - 16) & 63); if (fq >= 1) { IH = IA * pH + IH; IA = IA * pA; }
        pA = shl_from(IA, (lane - 32) & 63); pH = shl_from(IH, (lane - 32) & 63); if (fq >= 2) { IH = IA * pH + IH; IA = IA * pA; }
        float EA = shl_from(IA, (lane - 16) & 63), EH = shl_from(IH, (lane - 16) & 63); if (fq == 0) { EA = 1.f; EH = 0.f; }
        const float TA = shl_from(IA, 48 + chl), TH = shl_from(IH, 48 + chl);
        const float hstart = EA * hc + EH;
        hc = TA * hc + TH; Asp *= TA;
        if (PASS == 2) {
#pragma unroll
            for (int mt = 0; mt < 4; ++mt)
#pragma unroll
                for (int r = 0; r < 4; ++r) xl[(16 * mt + r) * 132] = hl[4 * mt + r] + Pm[4 * mt + r] * hstart;
            LDS_BARRIER();
            const f32x4 h00 = *(const LAS f32x4*)(xf + rho0 * 132 + cg8 * 8), h01 = *(const LAS f32x4*)(xf + rho0 * 132 + cg8 * 8 + 4);
            const f32x4 h10 = *(const LAS f32x4*)(xf + rho1 * 132 + cg8 * 8), h11 = *(const LAS f32x4*)(xf + rho1 * 132 + cg8 * 8 + 4);
            u32x4 y0, y1;
            y0.x = cvt_pk_bf16(bf_lo(Gc0.x) * h00[0], bf_hi(Gc0.x) * h00[1]); y0.y = cvt_pk_bf16(bf_lo(Gc0.y) * h00[2], bf_hi(Gc0.y) * h00[3]);
            y0.z = cvt_pk_bf16(bf_lo(Gc0.z) * h01[0], bf_hi(Gc0.z) * h01[1]); y0.w = cvt_pk_bf16(bf_lo(Gc0.w) * h01[2], bf_hi(Gc0.w) * h01[3]);
            y1.x = cvt_pk_bf16(bf_lo(Gc1.x) * h10[0], bf_hi(Gc1.x) * h10[1]); y1.y = cvt_pk_bf16(bf_lo(Gc1.y) * h10[2], bf_hi(Gc1.y) * h10[3]);
            y1.z = cvt_pk_bf16(bf_lo(Gc1.z) * h11[0], bf_hi(Gc1.z) * h11[1]); y1.w = cvt_pk_bf16(bf_lo(Gc1.w) * h11[2], bf_hi(Gc1.w) * h11[3]);
            *(u32x4*)(ybase + (size_t)(ci * 64) * 1024) = y0; *(u32x4*)(ybase + (size_t)(ci * 64 + 1) * 1024) = y1;
        }
    }
#undef SC_LOAD
    if (PASS == 1 && fq == 0) { spanA[(size_t)(b * 8 + sp) * 1024 + ch] = Asp; spanH[(size_t)(b * 8 + sp) * 1024 + ch] = hc; }
    __syncthreads();
}

constexpr int AT_K1 = 0, AT_K2 = 9216, AT_V = 18432, AT_BUF = 36864, AT_Q = 2 * AT_BUF, AT_QW = 8704;
__device__ __forceinline__ int crow(int r, int hi) { return (r & 3) + 8 * (r >> 2) + 4 * hi; }
__device__ __forceinline__ void attn_map(const LAS unsigned char* Kb, const LAS unsigned char* Vb, const LAS unsigned char* Qc, f32x16 (&o)[4], float& lsum, const int q, const int hi) {
    u32x4 pw[4];
    const LAS unsigned char* kq = Kb + q * 144 + hi * 16;
#pragma unroll
    for (int blk = 0; blk < 2; ++blk) {
        f32x16 p;
#pragma unroll
        for (int r = 0; r < 16; ++r) p[r] = 0.f;
        bf16x8 kf[2], qf[2];
#define AT_KQ(ds) do { kf[(ds) & 1] = *(const LAS bf16x8*)(kq + blk * (32 * 144) + (ds) * 32); qf[(ds) & 1] = *(const LAS bf16x8*)(Qc + (ds) * 32); } while (0)
        AT_KQ(0); AT_KQ(1);
        __builtin_amdgcn_sched_barrier(0);
#pragma unroll
        for (int ds = 0; ds < 4; ++ds) { p = __builtin_amdgcn_mfma_f32_32x32x16_bf16(kf[ds & 1], qf[ds & 1], p, 0, 0, 0); if (ds + 2 < 4) AT_KQ(ds + 2); __builtin_amdgcn_sched_barrier(0); }
#undef AT_KQ
        float sa = 0.f;
#pragma unroll
        for (int r = 0; r < 16; ++r) { p[r] = __builtin_amdgcn_exp2f(p[r]); sa += p[r]; }
        lsum += sa;
#pragma unroll
        for (int e = 0; e < 4; ++e) { pw[2 * blk][e] = cvt_pk_bf16(p[2 * e], p[2 * e + 1]); pw[2 * blk + 1][e] = cvt_pk_bf16(p[8 + 2 * e], p[8 + 2 * e + 1]); }
        __builtin_amdgcn_sched_barrier(0);
    }
    {   bf16x8 vf[4];
        const LAS unsigned char* vq = Vb + q * 144 + hi * 16;
#define AT_VREAD(i) do { vf[(i) & 3] = *(const LAS bf16x8*)(vq + ((i) >> 2) * (32 * 144) + ((i) & 3) * 32); } while (0)
        AT_VREAD(0); AT_VREAD(1); AT_VREAD(2); AT_VREAD(3);
        __builtin_amdgcn_sched_barrier(0);
#pragma unroll
        for (int i = 0; i < 16; ++i) {
            o[i >> 2] = __builtin_amdgcn_mfma_f32_32x32x16_bf16(__builtin_bit_cast(bf16x8, pw[i & 3]), vf[i & 3], o[i >> 2], 0, 0, 0);
            if (i + 4 < 16) AT_VREAD(i + 4);
            __builtin_amdgcn_sched_barrier(0);
        }
#undef AT_VREAD
    }
}
__device__ __forceinline__ void attn_unit(CParams& P, LAS unsigned char* lds, int b, int h, int qb, int j, float lam, float linit, const int tid_in) {
    int tid = tid_in; asm volatile("" : "+v"(tid));
    const int lane = tid & 63, w = __builtin_amdgcn_readfirstlane(tid >> 6), q = lane & 31, hi = lane >> 5;
    const bf16_t* Q = (const bf16_t*)(P.ws + WS_QO); bf16_t* O = (bf16_t*)(P.ws + WS_O);
    const bf16_t* Kg = (const bf16_t*)(P.ws + WS_K); const bf16_t* VT = (const bf16_t*)(P.ws + WS_VT);
    const int NT = 4 * qb + 4, mylast = 4 * qb + (w >> 1);
    const int row0 = b * SEQ + qb * 256 + 32 * w;
    LAS unsigned char* Qw = lds + AT_Q + w * AT_QW;
    u32x4 qv[8];
    {   const bf16_t* qsrc = Q + (size_t)(row0 + (lane >> 4)) * 1024 + h * 128 + (lane & 15) * 8;
#pragma unroll
        for (int i = 0; i < 8; ++i) qv[i] = *(const u32x4*)(qsrc + (size_t)(4 * i) * 1024);
    }
    const LAS unsigned char* Qc0 = Qw + q * 272 + hi * 16;
    f32x16 o1[4], o2[4];
#pragma unroll
    for (int d = 0; d < 4; ++d)
#pragma unroll
        for (int r = 0; r < 16; ++r) { o1[d][r] = 0.f; o2[d][r] = 0.f; }
    float l1 = 0.f, l2 = 0.f;
#define AT_ADDR() \
    const int kr = tid >> 4, kc16 = tid & 15; \
    const unsigned koff = (unsigned)(((b * SEQ + kr) * 1024 + h * 128 + kc16 * 8) * 2);          \
    const int kdst = ((kc16 < 8) ? AT_K1 : AT_K2) + kr * 144 + (kc16 & 7) * 16;              \
    const int dv0 = tid >> 3, kc = tid & 7; \
    const unsigned voff = (unsigned)((((b * 8 + h) * 128 + dv0) * 4096 + kc * 8) * 2);           \
    const int vdst = AT_V + dv0 * 144 + 32 * (kc >> 1) + 8 * (kc & 1);
    u32x4 rk0, rk1, rv0, rv1;
#define AT_LOAD(t) do { const unsigned ko_ = koff + (unsigned)(t) * 131072u, vo_ = voff + (unsigned)(t) * 128u; \
        rk0 = *(const u32x4*)((const char*)Kg + ko_); rk1 = *(const u32x4*)((const char*)Kg + (ko_ + 65536u)); \
        rv0 = *(const u32x4*)((const char*)VT + vo_); rv1 = *(const u32x4*)((const char*)VT + (vo_ + 524288u)); } while (0)
#define AT_WRITE(Bp) do { LAS unsigned char* B_ = (Bp); *(LAS u32x4*)(B_ + kdst) = rk0; *(LAS u32x4*)(B_ + kdst + 32 * 144) = rk1; \
        *(LAS u32x2*)(B_ + vdst) = (u32x2){rv0.x, rv0.y}; *(LAS u32x2*)(B_ + vdst + 16) = (u32x2){rv0.z, rv0.w}; \
        *(LAS u32x2*)(B_ + vdst + 64 * 144) = (u32x2){rv1.x, rv1.y}; *(LAS u32x2*)(B_ + vdst + 64 * 144 + 16) = (u32x2){rv1.z, rv1.w}; } while (0)
    {   AT_ADDR()
        AT_LOAD(0);
        __builtin_amdgcn_sched_barrier(0);
#pragma unroll
        for (int i = 0; i < 8; ++i) *(LAS u32x4*)(Qw + ((lane >> 4) + 4 * i) * 272 + (lane & 15) * 16) = qv[i];
        AT_WRITE(lds);
        LDS_BARRIER();
        for (int kt = 0; kt <= mylast; ++kt) {
            { const int tn_ = (kt + 1 < NT) ? kt + 1 : NT - 1; AT_LOAD(tn_); }
            const LAS unsigned char* B_ = lds + (kt & 1) * AT_BUF;
            attn_map(B_ + AT_K1, B_ + AT_V, Qc0, o1, l1, q, hi);
            attn_map(B_ + AT_K2, B_ + AT_V, Qc0 + 128, o2, l2, q, hi);
            AT_WRITE(lds + ((kt + 1) & 1) * AT_BUF);
            LDS_BARRIER();
        }
    }
    { unsigned z_ = 0u; asm volatile("" : "+v"(z_)); tid = (w << 6) + (int)__builtin_amdgcn_mbcnt_hi(~0u, __builtin_amdgcn_mbcnt_lo(~0u, z_)); }
    {   AT_ADDR()
        for (int kt = mylast + 1; kt < NT; ++kt) {
            { const int tn_ = (kt + 1 < NT) ? kt + 1 : NT - 1; AT_LOAD(tn_); }
            AT_WRITE(lds + ((kt + 1) & 1) * AT_BUF);
            LDS_BARRIER();
        }
    }
#undef AT_ADDR
#undef AT_LOAD
#undef AT_WRITE
    asm volatile("" : "+v"(tid));
    const int lane_e = tid & 63, q_e = lane_e & 31, hi_e = lane_e >> 5;
    l1 += shx(l1, 32, lane_e); l2 += shx(l2, 32, lane_e);
    LAS float* wl = (LAS float*)(Qw + 4608);
    if (hi_e == 0) { wl[q_e] = 1.0f / l1; wl[32 + q_e] = -lam / l2; }
    const LAS float* wlh = wl + 4 * hi_e;
    const float* gs = P.in[29] + j * 128;
    float gsv[4];
#pragma unroll
    for (int d = 0; d < 4; ++d) gsv[d] = gs[32 * d + q_e] * (1.0f - linit);
    bf16_t* obase2 = O + (size_t)(row0 + (lane_e >> 4)) * 1024 + h * 128 + (lane_e & 15) * 8;
    LAS unsigned char* stg = Qw;
#pragma unroll
    for (int r4 = 0; r4 < 4; ++r4) {
        f32x4 la, lb;
#pragma unroll
        for (int e = 0; e < 4; ++e) { la[e] = wlh[e + 8 * r4]; lb[e] = wlh[32 + e + 8 * r4]; }
#pragma unroll
        for (int e = 0; e < 4; ++e) {
            float df[4]; float sq = 0.f;
#pragma unroll
            for (int d = 0; d < 4; ++d) { df[d] = o1[d][4 * r4 + e] * la[e] + o2[d][4 * r4 + e] * lb[e]; sq += df[d] * df[d]; }
            sq += shx(sq, 1, lane_e); sq += shx(sq, 2, lane_e); sq += shx(sq, 4, lane_e); sq += shx(sq, 8, lane_e); sq += shx(sq, 16, lane_e);
            const float rinv = __builtin_amdgcn_rsqf(sq * (1.0f / 128.0f) + 1e-5f);
            LAS unsigned short* sr = (LAS unsigned short*)(stg + ((e + 8 * (r4 & 1) + 4 * hi_e) * 288) + q_e * 2);
#pragma unroll
            for (int d = 0; d < 4; ++d) sr[32 * d] = cvt_bf16(df[d] * rinv * gsv[d]);
        }
        if (r4 & 1) {
            LDS_WAIT();
#pragma unroll
            for (int i = 0; i < 4; ++i) {
                const u32x4 v = *(const LAS u32x4*)(stg + ((lane_e >> 4) + 4 * i) * 288 + (lane_e & 15) * 16);
                bf16_t* op = obase2; asm volatile("" : "+v"(op));
                *(u32x4*)(op + (size_t)(16 * (r4 >> 1) + 4 * i) * 1024) = v; }
            LDS_WAIT();
        }
    }
    __syncthreads();
}

#define XB_TMO      128
#define XB_XCNT(j)  (256  + 64 * (j))
#define XB_XSUB(j)  (1280 + 64 * (j))
#define XB_XGEN(j)  (2304 + 64 * (j))
#define XB_TOP      3328
#define XB_TOPGEN   3392
#define XCD_BAR_WORDS 3456
#define XB_SPIN_CAP (1u << 18)

__device__ __forceinline__ unsigned xb_ld(unsigned* p)              { return __hip_atomic_load(p, __ATOMIC_RELAXED, __HIP_MEMORY_SCOPE_AGENT); }
__device__ __forceinline__ unsigned xb_add(unsigned* p, unsigned v) { return __hip_atomic_fetch_add(p, v, __ATOMIC_RELAXED, __HIP_MEMORY_SCOPE_AGENT); }
__device__ __forceinline__ unsigned xb_xcc_id() { return (unsigned)__builtin_amdgcn_s_getreg((3 << 11) | 20) & 0xFu; }
#define XB_SPIN(cond, bar) do { unsigned _sp = 0; while (cond) { __builtin_amdgcn_s_sleep(1); \
    if ((++_sp & 255u) == 0u) { if (xb_ld(&(bar)[XB_TMO])) break; if (_sp > XB_SPIN_CAP) { atomicAdd(&(bar)[XB_TMO], 1u); break; } } } } while (0)

struct XcdBarrier {
    unsigned* bar; unsigned x;
    volatile LAS unsigned* st;
};

__device__ __forceinline__ XcdBarrier xcd_barrier_post(unsigned* bar, volatile LAS unsigned* st) {
    XcdBarrier b; b.bar = bar; b.x = xb_xcc_id(); b.st = st;
    if (threadIdx.x == 0) (void)xb_add(&bar[XB_XCNT(b.x)], 1u);
    return b;
}
__device__ __forceinline__ void xcd_barrier_complete(unsigned* bar, unsigned x, unsigned& nloc, unsigned& nx) {
    const unsigned G = gridDim.x * gridDim.y * gridDim.z;
    unsigned sum, cnt, mine, sp = 0u;
    for (;;) {
        sum = 0u; cnt = 0u; mine = 0u;
#pragma unroll
        for (unsigned j = 0; j < 16; ++j) { const unsigned c = xb_ld(&bar[XB_XCNT(j)]); sum += c; cnt += (c > 0u) ? 1u : 0u; mine = (j == x) ? c : mine; }
        if (sum == G) break;
        __builtin_amdgcn_s_sleep(1);
        if ((++sp & 255u) == 0u) { if (xb_ld(&bar[XB_TMO])) break; if (sp > XB_SPIN_CAP) { atomicAdd(&bar[XB_TMO], 1u); break; } }
    }
    nloc = mine > 0u ? mine : 1u; nx = cnt > 0u ? cnt : 1u;
}

__device__ __forceinline__ void xcd_barrier(const XcdBarrier& b, const bool is_t0) {
    asm volatile("s_waitcnt vmcnt(0)" ::: "memory");
    __syncthreads();
    if (is_t0) {
        unsigned* bar = b.bar;
        __builtin_amdgcn_s_waitcnt(0);
        unsigned nloc = b.st[0], nx = b.st[1];
        if (nloc == 0u) { xcd_barrier_complete(bar, b.x, nloc, nx); b.st[0] = nloc; b.st[1] = nx; }
        const unsigned old = xb_add(&bar[XB_XSUB(b.x)], 1u);
        const unsigned gen = old / nloc;
        if (old + 1u == (gen + 1u) * nloc) {
            __builtin_amdgcn_fence(__ATOMIC_RELEASE, "agent");
            asm volatile("s_waitcnt vmcnt(0)" ::: "memory");
            const unsigned og = xb_add(&bar[XB_TOP], 1u);
            const unsigned tg = og / nx;
            if (og + 1u == (tg + 1u) * nx) xb_add(&bar[XB_TOPGEN], 1u);
            else XB_SPIN(xb_ld(&bar[XB_TOPGEN]) == tg, bar);
            __builtin_amdgcn_fence(__ATOMIC_ACQUIRE, "agent");
            xb_add(&bar[XB_XGEN(b.x)], 1u);
            asm volatile("s_waitcnt vmcnt(0)" ::: "memory");
        } else {
            XB_SPIN(xb_ld(&bar[XB_XGEN(b.x)]) == gen, bar);
            __builtin_amdgcn_fence(__ATOMIC_ACQUIRE, "agent");
            asm volatile("s_waitcnt vmcnt(0)" ::: "memory");
        }
    }
    __syncthreads();
}


__device__ __forceinline__ pg8::RsCache make_rs_cache(LAS unsigned char* lds, const float* ss, int N, const int tid) {
    pg8::StaticOrder S; S.init(MROWS, N, (int)gridDim.x, (int)blockIdx.x); pg8::Unit u0; u0.pm = 0; u0.pn = 0; const bool any = S.next(0, u0);
    LAS float* tab = (LAS float*)(lds + LDS_BYTES - 1024);
    if (any && tid < 256) tab[tid] = pg8::row_rs(ss, u0.pm * 256 + tid);
    __syncthreads();
    return pg8::RsCache{tab, any ? u0.pm : -1, ss};
}
template <class Epi> __device__ __forceinline__ void run_gemm(LAS unsigned char* lds, const bf16_t* A, const bf16_t* Bt, int N, int K, const Epi& E, const int tid) {
    pg8::Gemm g{A, Bt, MROWS, N, K}; pg8::StaticOrder S; S.init(MROWS, N, (int)gridDim.x, (int)blockIdx.x);
    pg8::gemm_phase<Epi, pg8::StaticOrder, true, true>(lds, g, S, E, tid);
}
enum { OP_PRO = 0, OP_UP, OP_DOWN, OP_RECIN, OP_SCAN1, OP_SCAN2, OP_RECOUT, OP_KV, OP_QG, OP_ATTN, OP_WO };
constexpr int N_STEPS = 32;

__global__ void __launch_bounds__(NTHREADS) mega_fwd(Params P0) {
    extern __shared__ __attribute__((aligned(16))) unsigned char lds_raw[];
    LAS unsigned char* lds = (LAS unsigned char*)lds_raw;
    cg::grid_group grid = cg::this_grid();
    volatile LAS unsigned* bar_st = (volatile LAS unsigned*)(lds + LDS_BYTES - 2048);
    if (threadIdx.x < 2) bar_st[threadIdx.x] = 0u;
    __syncthreads();
    XcdBarrier xbar = xcd_barrier_post((unsigned*)(P0.ws + WS_BAR), bar_st);
    const int wave_s = __builtin_amdgcn_readfirstlane(threadIdx.x >> 6);
    auto mk_tid = [&]() -> int { unsigned z = 0u; asm volatile("" : "+v"(z)); return (wave_s << 6) + (int)__builtin_amdgcn_mbcnt_hi(~0u, __builtin_amdgcn_mbcnt_lo(~0u, z)); };
#define MK_TID() mk_tid()
    const int G = gridDim.x, bx = blockIdx.x, vcu = (G % 8 == 0) ? (bx % 8) * (G / 8) + bx / 8 : bx;
    for (int st = P0.ph_lo; st < P0.ph_hi; ++st) {
        int op, layer = 0, f = 0;
        if (st == 0) op = OP_PRO;
        else if (st <= 16) { const int k = (st - 1) & 7; layer = (st - 1) >> 3; f = layer * 2 + (k >= 6);
            op = (k == 0 || k == 6) ? OP_UP : (k == 1 || k == 7) ? OP_DOWN : (k == 2) ? OP_RECIN : (k == 3) ? OP_SCAN1 : (k == 4) ? OP_SCAN2 : OP_RECOUT; }
        else if (st == 17) { op = OP_KV; layer = 2; }
        else { const int q = st - 18, k = q % 7; layer = 2 + q / 7; f = layer * 2 + (k >= 5);
            op = (k == 0 || k == 5) ? OP_UP : (k == 1 || k == 6) ? OP_DOWN : (k == 2) ? OP_QG : (k == 3) ? OP_ATTN : OP_WO; }
        if (st > P0.ph_lo && st != 18) { if (P0.rep_mask & 0x4000) grid.sync(); else xcd_barrier(xbar, MK_TID() == 0); if (P0.rep_mask & 0x8000) { xcd_barrier(xbar, MK_TID() == 0); xcd_barrier(xbar, MK_TID() == 0); } }
        const int a = layer, jl = layer - 2;
#ifndef OPMASK
#define OPMASK 0xFFFF
#endif
#define HAS(o) ((OPMASK >> (o)) & 1)
#ifndef PROBE_REP_MASK
#define PROBE_REP_MASK 0
#endif
        const int nrep = ((P0.rep_mask >> op) & 1) ? 2 : 1;
        for (int rep = 0; rep < nrep; ++rep) {
        if (rep) xcd_barrier(xbar, MK_TID() == 0);
#define STEP_LOCALS() int tid = MK_TID(); asm volatile("" : "+v"(tid)); CParams* Pp = (CParams*)__builtin_amdgcn_kernarg_segment_ptr(); asm volatile("" : "+s"(Pp)); CParams& P = *Pp; \
        unsigned char* ws = P.ws; asm volatile("" : "+s"(ws)); bf16_t* XB = (bf16_t*)(ws + WS_XB); float* ss = (float*)(ws + WS_SS); bf16_t* HB = (bf16_t*)(ws + WS_H); (void)XB; (void)ss; (void)HB; (void)tid;
        switch (op) {
        case OP_PRO: if (HAS(0)) { STEP_LOCALS() prologue(P, lds, vcu, G, tid); } break;
        case OP_UP: if (HAS(1)) { STEP_LOCALS() pg8::EpiSwiglu E{HB, make_rs_cache(lds, ss, 5632, tid)}; run_gemm(lds, XB, (const bf16_t*)(ws + WS_W + (size_t)f * W_FFN_STRIDE), 5632, 1024, E, tid);
            if (f < 7 && G == 256 && rep == 0) {
                if (bx >= 128) { const int lane = tid & 63, wave = __builtin_amdgcn_readfirstlane(tid >> 6); LAS float* scr = (LAS float*)(lds + wave * 16384);
                    for (int it = (bx - 128) * NWAVES + wave; it < 4224; it += 128 * NWAVES) ffn_item(P, f + 1, it, scr, lane); }
            } else if (f < 7 && rep == 0) { const int lane = tid & 63, wave = __builtin_amdgcn_readfirstlane(tid >> 6); LAS float* scr = (LAS float*)(lds + wave * 16384);
                for (int it = vcu * NWAVES + wave; it < 4224; it += G * NWAVES) ffn_item(P, f + 1, it, scr, lane); }
        } break;
        case OP_DOWN: case OP_RECOUT: case OP_WO: if (HAS(2)) { STEP_LOCALS()
            const bf16_t* A = (op == OP_DOWN) ? HB : (op == OP_RECOUT) ? (const bf16_t*)(ws + WS_Y) : (const bf16_t*)(ws + WS_O);
            const bf16_t* Bt = (op == OP_DOWN) ? (const bf16_t*)(ws + WS_W + (size_t)f * W_FFN_STRIDE + W_FFN_DN) : (op == OP_RECOUT) ? (const bf16_t*)(ws + W_REC + (size_t)a * W_REC_STRIDE + W_REC_OUT) : (const bf16_t*)(ws + W_O + (size_t)jl * 2 * MiB);
            pg8::EpiResid E{(st == N_STEPS - 1) ? P.out : nullptr, XB, (unsigned char*)(ws + WS_XL), ss, __uint_as_float((op == OP_DOWN) ? 0x3f000000u : 0x3f800000u)}; run_gemm(lds, A, Bt, 1024, (op == OP_DOWN) ? 2816 : 1024, E, tid); } break;
        case OP_RECIN: if (HAS(3)) { STEP_LOCALS() pg8::EpiRecIn E{(bf16_t*)(ws + WS_GG), (bf16_t*)(ws + WS_REC), make_rs_cache(lds, ss, 2048, tid)}; run_gemm(lds, XB, (const bf16_t*)(ws + W_REC + (size_t)a * W_REC_STRIDE), 2048, 1024, E, tid); } break;
        case OP_SCAN1: if (HAS(4)) { STEP_LOCALS() for (int u = vcu; u < 256; u += G) scan_unit<1>(P, lds, a, u >> 6, (u >> 3) & 7, u & 7, tid); } break;
        case OP_SCAN2: if (HAS(5)) { STEP_LOCALS() for (int u = vcu; u < 256; u += G) scan_unit<2>(P, lds, a, u >> 6, (u >> 3) & 7, u & 7, tid); } break;
        case OP_KV: case OP_QG: if (HAS(7)) { STEP_LOCALS()
            const bool kv = (op == OP_KV);
            pg8::EpiQK E{kv ? (bf16_t*)(ws + WS_K) : (bf16_t*)(ws + WS_QO), (bf16_t*)(ws + WS_VT), make_rs_cache(lds, ss, kv ? 2048 : 1024, tid), kv ? P.in[22] : P.in[26] + jl * 64, (const float*)(ws + WS_COS), (const float*)(ws + WS_SIN), kv ? 1.0f : 0.125f * 1.4426950408889634f};
            run_gemm(lds, XB, kv ? (const bf16_t*)(ws + W_KV) : (const bf16_t*)(ws + W_Q + (size_t)jl * 2 * MiB), kv ? 2048 : 1024, 1024, E, tid); } break;
        case OP_ATTN: if (HAS(9)) { STEP_LOCALS()
            const int tid_a = MK_TID();
            const int lane = tid_a & 63;
            const float q1 = P.in[27][jl * 64 + lane], q2 = P.in[28][jl * 64 + lane], k1 = P.in[23][lane], k2 = P.in[24][lane];
            const float linit = jl ? P.linit[1] : P.linit[0];
            const float lam = __uint_as_float(__builtin_amdgcn_readfirstlane(__float_as_uint(__expf(wave_sum(q1 * k1, lane)) - __expf(wave_sum(q2 * k2, lane)) + linit)));
            for (int pr = vcu; pr < 256; pr += G) { const int bh = pr >> 3, s = pr & 7;
#pragma unroll 1
                for (int uu = 0; uu < 2; ++uu) attn_unit(P, lds, bh >> 3, bh & 7, uu ? s : 15 - s, jl, lam, linit, tid_a); }
        } break;
        }
        }
    }
}

#ifndef MK_PER_STEP
#define MK_PER_STEP 0
#endif
extern "C" void kernel_launch(void* const* d_in, const int* in_sizes, int n_in, void* d_out, int out_size, void* d_ws, size_t ws_size, hipStream_t stream) {
    static int grid = 0;
    if (grid == 0) {
        int dev = 0, cus = 0, per_cu = 0;
        if (n_in != 31 || out_size != MROWS * DM || ws_size < WS_END) { fprintf(stderr, "kernel_launch: unexpected shapes (n_in %d out %d ws %zu)\n", n_in, out_size, ws_size); grid = -1; return; }
        hipGetDevice(&dev); hipDeviceGetAttribute(&cus, hipDeviceAttributeMultiprocessorCount, dev);
        hipFuncSetAttribute((const void*)mega_fwd, hipFuncAttributeMaxDynamicSharedMemorySize, LDS_BYTES);
        hipOccupancyMaxActiveBlocksPerMultiprocessor(&per_cu, (const void*)mega_fwd, NTHREADS, LDS_BYTES);
        (void)hipGetLastError();
        if (per_cu < 1) per_cu = 1;
        grid = cus * 1;
        if (grid <= 0) grid = 256;
    }
    if (grid < 0) return;
    Params p{};
    for (int i = 0; i < 31; ++i) p.in[i] = (const float*)d_in[i];
    p.out = (float*)d_out; p.ws = (unsigned char*)d_ws; p.rep_mask = PROBE_REP_MASK;
    p.linit[0] = (float)(0.8 - 0.6 * std::exp(-0.3 * 2.0)); p.linit[1] = (float)(0.8 - 0.6 * std::exp(-0.3 * 3.0));
    for (int i = 0; i < 32; ++i) p.invfreq[i] = std::pow(10000.0, -(double)(2 * i) / 64.0);
    (void)hipMemsetAsync((char*)d_ws + WS_BAR, 0, 16384, stream);
#if MK_PER_STEP
    for (int st = 0; st < N_STEPS; ++st) { p.ph_lo = st; p.ph_hi = st + 1; hipLaunchKernelGGL(mega_fwd, dim3(grid), dim3(NTHREADS), LDS_BYTES, stream, p); }
#else
    p.ph_lo = 0; p.ph_hi = N_STEPS;
    void* args[] = {&p};
    hipError_t e = hipLaunchCooperativeKernel((const void*)mega_fwd, dim3(grid), dim3(NTHREADS), args, LDS_BYTES, stream);
    if (e != hipSuccess) fprintf(stderr, "cooperative launch failed: %s (grid %d)\n", hipGetErrorString(e), grid);
#endif
}
```
